# Optimizing an MI355X kernel written in HIP

```python
import jax, jax.numpy as jnp
from jax import lax
import numpy as np


D_MODEL = 1024
BATCH = 16
SEQ = 2048
DEPTH = 2

GRID_W = 64
CTX_LEN = 256
D_MIX = D_MODEL
EPS = 1e-6

A_GROUPS = 4
A_WIDTH = D_MIX // 2
A_GROUP_DIM = A_WIDTH // A_GROUPS
CHUNK_A = 128
ROWS_PER_CHUNK = CHUNK_A // GRID_W

B_HEADS = 4
B_WIDTH = D_MIX - A_WIDTH
B_DV = B_WIDTH // B_HEADS
B_DK = B_DV // 2
B_KEY_WIDTH = B_HEADS * B_DK
GATE_RANK = 16
GATE_TAU = 16.0
CHUNK_B = 64

N_GROUPS = 8
EXPERTS_PER_GROUP = 8
N_EXPERTS = N_GROUPS * EXPERTS_PER_GROUP
TOP_K = 2
D_EXPERT = D_MODEL // 2
MOE_BLOCK = 128

OFF_AU = 0
OFF_AV = OFF_AU + A_WIDTH
OFF_BQ = OFF_AV + A_WIDTH
OFF_BR = OFF_BQ + B_KEY_WIDTH
OFF_BK = OFF_BR + B_WIDTH
OFF_BV = OFF_BK + B_KEY_WIDTH
OFF_BG = OFF_BV + B_WIDTH
D_IN = OFF_BG + 2 * GATE_RANK

kernel_name = 'hymba_gmlp_gla_hmoe_dit'


def rmsnorm(x, g):
    xf = x.astype(jnp.float32)
    y = xf * lax.rsqrt(jnp.mean(xf * xf, axis=-1, keepdims=True) + EPS)
    return (y * g.astype(jnp.float32)).astype(x.dtype)


def modulate(h, shift, scale):
    return h * (1 + scale) + shift


def spatial_gating(zu, zv, n_chunks, ln_g, ln_b, w_sp, b_sp):
    Bn, T, _ = zu.shape
    u = jax.nn.gelu(zu)
    v = jax.nn.gelu(zv).reshape(Bn, n_chunks, CHUNK_A, A_GROUPS, A_GROUP_DIM).astype(jnp.float32)
    mu = jnp.mean(v, axis=-1, keepdims=True)
    var = jnp.mean(jnp.square(v - mu), axis=-1, keepdims=True)
    v = ((v - mu) * lax.rsqrt(var + EPS)).astype(zv.dtype)
    v = v * ln_g.reshape(A_GROUPS, A_GROUP_DIM) + ln_b.reshape(A_GROUPS, A_GROUP_DIM)
    s = jnp.einsum('gpq,bnqgc->bnpgc', w_sp, v) + b_sp.T[:, :, None]
    return u * s.reshape(Bn, T, A_WIDTH)


def heads(z, d):
    Bn, T, W = z.shape
    return z.reshape(Bn, T, W // d, d).transpose(0, 2, 1, 3).astype(jnp.float32)


def flip(t):
    return jnp.flip(t, axis=2)


def gla_logdecay(zg, w_up, b_up):
    Bn, T, _ = zg.shape
    logit = (zg @ w_up + b_up).astype(jnp.float32)
    la = jax.nn.log_sigmoid(logit) / GATE_TAU
    return la.reshape(Bn, T, B_HEADS, B_DK).transpose(0, 2, 1, 3)


def gla_inputs(zkvg, w_gate_up, b_gate):
    Bn, T, _ = zkvg.shape
    k = heads(zkvg[..., :B_KEY_WIDTH], B_DK)
    v = heads(zkvg[..., B_KEY_WIDTH:B_KEY_WIDTH + B_WIDTH], B_DV)
    zg = zkvg[..., B_KEY_WIDTH + B_WIDTH:].reshape(Bn, T, 2, GATE_RANK)
    la_f = gla_logdecay(zg[:, :, 0], w_gate_up[0], b_gate[0])
    la_b = gla_logdecay(zg[:, :, 1], w_gate_up[1], b_gate[1])
    return k, v, la_f, la_b


def to_chunks(t):
    Bn, H, T, d = t.shape
    return t.reshape(Bn, H, T // CHUNK_B, CHUNK_B, d)


def gla_states(k, v, la, s0):
    kc, vc, lc = to_chunks(k), to_chunks(v), to_chunks(la)
    b = jnp.cumsum(lc, axis=3)
    b_last = b[..., -1:, :]
    kv = jnp.einsum('bhncd,bhnce->bhnde', kc * jnp.exp(b_last - b), vc)
    decay = jnp.exp(b_last[..., 0, :])

    def step(s, inp):
        dec, kvn = inp
        return dec[..., None] * s + kvn, s

    s_final, s_prev = lax.scan(step, s0, (jnp.moveaxis(decay, 2, 0), jnp.moveaxis(kv, 2, 0)))
    return jnp.moveaxis(s_prev, 0, 2), s_final, b


def gla_direction(q, k, v, la, s0):
    s_prev, s_final, b = gla_states(k, v, la, s0)
    qc, kc, vc = to_chunks(q), to_chunks(k), to_chunks(v)
    qe = qc * jnp.exp(b)
    ke = kc * jnp.exp(-b)
    att = jnp.einsum('bhnid,bhnjd->bhnij', qe, ke)
    mask = jnp.tril(jnp.ones((CHUNK_B, CHUNK_B), dtype=bool))
    att = jnp.where(mask, att, 0.0)
    o = jnp.einsum('bhnij,bhnje->bhnie', att, vc) + jnp.einsum('bhnid,bhnde->bhnie', qe, s_prev)
    Bn, H, T, _ = q.shape
    return o.reshape(Bn, H, T, B_DV), s_final


def gla_bidir(q, k, v, la_f, la_b, s0_f, s0_b):
    o_f, s_f = gla_direction(q, k, v, la_f, s0_f)
    o_b, s_b = gla_direction(flip(q), flip(k), flip(v), flip(la_b), s0_b)
    return o_f + flip(o_b), s_f, s_b


def gla_merge(o, r, g_gla):
    o = o.transpose(0, 2, 1, 3)
    o = o * lax.rsqrt(jnp.mean(o * o, axis=-1, keepdims=True) + EPS) * g_gla.reshape(B_HEADS, B_DV).astype(jnp.float32)
    Bn, T = o.shape[0], o.shape[1]
    return o.reshape(Bn, T, B_WIDTH).astype(r.dtype) * jax.nn.silu(r)


def hier_moe(t, wrg, brg, wre, bre, w1, w3, w2):
    T, D = t.shape
    pg = jax.nn.softmax((t @ wrg + brg).astype(jnp.float32), axis=-1)
    p_top, g_idx = lax.top_k(pg, 1)
    le = (t @ wre + bre).astype(jnp.float32).reshape(T, N_GROUPS, EXPERTS_PER_GROUP)
    le_sel = jnp.take_along_axis(le, g_idx[:, :, None], axis=1)[:, 0]
    l_top, e_local = lax.top_k(le_sel, TOP_K)
    gate = p_top * jax.nn.softmax(l_top, axis=-1)
    expert = g_idx * EXPERTS_PER_GROUP + e_local
    M = T * TOP_K
    e_flat = expert.reshape(-1)
    tok_flat = jnp.repeat(jnp.arange(T, dtype=jnp.int32), TOP_K)
    gate_flat = gate.reshape(-1)
    order = jnp.argsort(e_flat)
    e_sorted = e_flat[order]
    counts = jnp.bincount(e_flat, length=N_EXPERTS)
    starts = jnp.cumsum(counts) - counts
    padded = (counts + MOE_BLOCK - 1) // MOE_BLOCK * MOE_BLOCK
    pad_ends = jnp.cumsum(padded)
    pad_starts = pad_ends - padded
    dest = pad_starts[e_sorted] + jnp.arange(M, dtype=jnp.int32) - starts[e_sorted]
    n_blocks = (M + N_EXPERTS * (MOE_BLOCK - 1) + MOE_BLOCK - 1) // MOE_BLOCK
    P = n_blocks * MOE_BLOCK
    buf_tok = jnp.full((P,), T, dtype=jnp.int32).at[dest].set(tok_flat[order])
    buf_gate = jnp.zeros((P,), jnp.float32).at[dest].set(gate_flat[order])
    block_start = jnp.arange(n_blocks, dtype=jnp.int32) * MOE_BLOCK
    block_expert = jnp.minimum(jnp.searchsorted(pad_ends, block_start, side='right'), N_EXPERTS - 1)
    t_pad = jnp.concatenate([t, jnp.zeros((1, D), t.dtype)], axis=0)
    xb = t_pad[buf_tok].reshape(n_blocks, MOE_BLOCK, D)

    def expert_block(args):
        xblk, e = args
        hblk = jax.nn.silu(xblk @ w1[e]) * (xblk @ w3[e])
        return hblk @ w2[e]

    yb = lax.map(expert_block, (xb, block_expert)).reshape(P, D)
    yb = yb * buf_gate[:, None].astype(yb.dtype)
    return jax.ops.segment_sum(yb, buf_tok, num_segments=T + 1)[:T]


def setup_inputs(seed: int = 0) -> dict:
    key = jax.random.key(seed)
    ks = jax.random.split(key, 32)
    L, D = DEPTH, D_MODEL
    nrm = lambda k, shape, s: jax.random.normal(k, shape, jnp.float32) * s
    return {
        'x': nrm(ks[0], (BATCH, SEQ, D), 1.0),
        'c': nrm(ks[1], (BATCH, D), 1.0),
        'ctx': nrm(ks[2], (BATCH, CTX_LEN, D), 1.0),
        'c_ctx': nrm(ks[3], (D,), 1.0),
        'w_mod': nrm(ks[4], (L, D, 6 * D), 0.5 * D ** -0.5),
        'b_mod': nrm(ks[5], (L, 6 * D), 0.01),
        'g_norm1': 1.0 + nrm(ks[6], (L, D), 0.01),
        'w_in': nrm(ks[7], (L, D, D_IN), D ** -0.5),
        'ln_v_g': 1.0 + nrm(ks[8], (L, A_WIDTH), 0.01),
        'ln_v_b': nrm(ks[9], (L, A_WIDTH), 0.01),
        'w_sp': nrm(ks[10], (L, A_GROUPS, CHUNK_A, CHUNK_A), CHUNK_A ** -0.5),
        'b_sp': 1.0 + nrm(ks[11], (L, A_GROUPS, CHUNK_A), 0.01),
        'w_gate_up': nrm(ks[12], (L, 2, GATE_RANK, B_KEY_WIDTH), GATE_RANK ** -0.5),
        'b_gate': nrm(ks[13], (L, 2, B_KEY_WIDTH), 0.01),
        'g_gla': 1.0 + nrm(ks[14], (L, B_WIDTH), 0.01),
        'w_out': nrm(ks[15], (L, D_MIX, D), D_MIX ** -0.5),
        'g_norm2': 1.0 + nrm(ks[16], (L, D), 0.01),
        'w_router_g': nrm(ks[17], (L, D, N_GROUPS), D ** -0.5),
        'b_router_g': nrm(ks[18], (L, N_GROUPS), 0.01),
        'w_router_e': nrm(ks[19], (L, D, N_EXPERTS), D ** -0.5),
        'b_router_e': nrm(ks[20], (L, N_EXPERTS), 0.01),
        'w1': nrm(ks[21], (L, N_EXPERTS, D, D_EXPERT), D ** -0.5),
        'w3': nrm(ks[22], (L, N_EXPERTS, D, D_EXPERT), D ** -0.5),
        'w2': nrm(ks[23], (L, N_EXPERTS, D_EXPERT, D), D_EXPERT ** -0.5),
        'g_final': 1.0 + nrm(ks[24], (D,), 0.01),
    }


def reference(x, c, ctx, c_ctx, w_mod, b_mod, g_norm1, w_in, ln_v_g, ln_v_b, w_sp, b_sp,
              w_gate_up, b_gate, g_gla, w_out, g_norm2, w_router_g, b_router_g,
              w_router_e, b_router_e, w1, w3, w2, g_final):
    Bn, S, D = x.shape
    Lc = ctx.shape[1]
    ROWS = S // GRID_W
    n_chunks_lat = ROWS // ROWS_PER_CHUNK
    n_chunks_ctx = Lc // CHUNK_A
    zero_state = jnp.zeros((Bn, B_HEADS, B_DK, B_DV), jnp.float32)
    h = x
    cx = ctx
    for l in range(DEPTH):
        last = l == DEPTH - 1
        m = jax.nn.silu(c) @ w_mod[l] + b_mod[l]
        sh1, sc1, g1, sh2, sc2, g2 = jnp.split(m[:, None, :], 6, axis=-1)
        mc = jax.nn.silu(c_ctx) @ w_mod[l] + b_mod[l]
        csh1, csc1, cg1, csh2, csc2, cg2 = jnp.split(mc, 6, axis=-1)

        hn = modulate(rmsnorm(h, g_norm1[l]), sh1, sc1)
        cn = modulate(rmsnorm(cx, g_norm1[l]), csh1, csc1)
        z = hn @ w_in[l]

        if last:
            zc_kvg = cn @ w_in[l][:, OFF_BK:]
            kc, vc, laf_c, lab_c = gla_inputs(zc_kvg, w_gate_up[l], b_gate[l])
            _, s_ctx_f, _ = gla_states(kc, vc, laf_c, zero_state)
            _, s_ctx_b, _ = gla_states(flip(kc), flip(vc), flip(lab_c), zero_state)
        else:
            zc = cn @ w_in[l]
            kc, vc, laf_c, lab_c = gla_inputs(zc[..., OFF_BK:], w_gate_up[l], b_gate[l])
            qc = heads(zc[..., OFF_BQ:OFF_BR], B_DK) * B_DK ** -0.5
            oc, s_ctx_f, s_ctx_b = gla_bidir(qc, kc, vc, laf_c, lab_c, zero_state, zero_state)
            bc_out = gla_merge(oc, zc[..., OFF_BR:OFF_BK], g_gla[l])
            ac_out = spatial_gating(zc[..., OFF_AU:OFF_AV], zc[..., OFF_AV:OFF_BQ], n_chunks_ctx,
                                    ln_v_g[l], ln_v_b[l], w_sp[l], b_sp[l])
            mix_c = jnp.concatenate([ac_out, bc_out], axis=-1) @ w_out[l]
            cx = cx + cg1 * mix_c

        a_out = spatial_gating(z[..., OFF_AU:OFF_AV], z[..., OFF_AV:OFF_BQ], n_chunks_lat,
                               ln_v_g[l], ln_v_b[l], w_sp[l], b_sp[l])
        q = heads(z[..., OFF_BQ:OFF_BR], B_DK) * B_DK ** -0.5
        k, v, la_f, la_b = gla_inputs(z[..., OFF_BK:], w_gate_up[l], b_gate[l])
        o, _, _ = gla_bidir(q, k, v, la_f, la_b, s_ctx_f, s_ctx_b)
        b_out = gla_merge(o, z[..., OFF_BR:OFF_BK], g_gla[l])
        mix = jnp.concatenate([a_out, b_out], axis=-1) @ w_out[l]
        h = h + g1 * mix

        hn2 = modulate(rmsnorm(h, g_norm2[l]), sh2, sc2).reshape(Bn * S, D)
        moe_args = (w_router_g[l], b_router_g[l], w_router_e[l], b_router_e[l], w1[l], w3[l], w2[l])
        if last:
            y = hier_moe(hn2, *moe_args)
            h = h + g2 * y.reshape(Bn, S, D)
        else:
            cn2 = modulate(rmsnorm(cx, g_norm2[l]), csh2, csc2).reshape(Bn * Lc, D)
            y = hier_moe(jnp.concatenate([hn2, cn2], axis=0), *moe_args)
            h = h + g2 * y[:Bn * S].reshape(Bn, S, D)
            cx = cx + cg2 * y[Bn * S:].reshape(Bn, Lc, D)
    return rmsnorm(h, g_final)
```

```cpp
#include <hip/hip_runtime.h>
#include <hip/hip_cooperative_groups.h>
#include <cstdio>
#include <cstdint>
namespace cg = cooperative_groups;

#ifndef ONE_LAUNCH
#define ONE_LAUNCH 0
#endif

#define DEV __device__ __forceinline__
typedef unsigned short bf16_t;
typedef float f32x4 __attribute__((ext_vector_type(4)));
typedef unsigned u32x2 __attribute__((ext_vector_type(2)));
typedef unsigned u32x4 __attribute__((ext_vector_type(4)));

constexpr int D = 1024, NB = 16, SEQ = 2048, CTXL = 256;
constexpr int TL = NB * SEQ, TC = NB * CTXL, TA = TL + TC;
constexpr int DIN = 2592, OFF_AU = 0, OFF_AV = 512, OFF_BQ = 1024, OFF_BR = 1280, OFF_BK = 1792, OFF_BV = 2048, OFF_BG = 2560;
constexpr int NE = 64, DE = 512, LCAP = 2 * TA;
constexpr float EPS = 1e-6f;

constexpr size_t MiB = 1u << 20;
constexpr size_t WS_CTL = 0, WS_MOD = 1 * MiB, WS_H = 210 * MiB, WS_HN = 354 * MiB, WS_Z = 426 * MiB, WS_MIX = 609 * MiB,
                 WS_KV = 681 * MiB, WS_LIST = 825 * MiB, WS_GATE = 843 * MiB, WS_END = 844 * MiB;
static_assert(WS_H + (size_t)TA * D * 4 <= WS_HN && WS_HN + (size_t)TA * D * 2 <= WS_Z && WS_Z + (size_t)TA * DIN * 2 <= WS_MIX &&
              WS_MIX + (size_t)TA * D * 2 <= WS_KV && WS_KV + (size_t)2 * TA * 512 * 4 <= WS_LIST && WS_LIST + (size_t)NE * LCAP * 4 <= WS_GATE, "ws map");

struct KArgs { const float* in[25]; float* out; unsigned char* ws; int ph_lo, ph_hi; };
enum { I_X = 0, I_C, I_CTX, I_CCTX, I_WMOD, I_BMOD, I_GN1, I_WIN, I_LNG, I_LNB, I_WSP, I_BSP, I_WGU, I_BG, I_GGLA, I_WOUT, I_GN2, I_WRG, I_BRG, I_WRE, I_BRE, I_W1, I_W3, I_W2, I_GF };

DEV float bf2f(bf16_t v) { return __uint_as_float((unsigned)v << 16); }
DEV bf16_t f2bf(float f) { unsigned u = __float_as_uint(f); u += 0x7fffu + ((u >> 16) & 1u); return (bf16_t)(u >> 16); }
DEV unsigned pk2(float lo, float hi) { return (unsigned)f2bf(lo) | ((unsigned)f2bf(hi) << 16); }
DEV float silu_f(float x) { return x / (1.f + __expf(-x)); }
DEV float gelu_f(float x) { const float u = 0.7978845608028654f * (x + 0.044715f * x * x * x); const float t = 1.f - 2.f / (1.f + __expf(2.f * u)); return 0.5f * x * (1.f + t); }
DEV float logsigmoid_f(float x) { return fminf(x, 0.f) - log1pf(__expf(-fabsf(x))); }
DEV float wave_sum(float v) {
#pragma unroll
    for (int o = 1; o < 64; o <<= 1) v += __shfl_xor(v, o);
    return v;
}
DEV int mod_index(int row) { return row < TL ? (row >> 11) : 16; }

DEV void ph_prep(const KArgs& a, unsigned char* lds) {
    const int tid = threadIdx.x, lane = tid & 63, wid = tid >> 6;
    unsigned* cnt = (unsigned*)(a.ws + WS_CTL);
    if (blockIdx.x == 0 && tid < 2 * NE) cnt[tid] = 0u;
    float* slab = (float*)lds + wid * 17 * 64;
    float* red = (float*)lds + 4 * 17 * 64;
    float* mod = (float*)(a.ws + WS_MOD);
    const float* c = a.in[I_C]; const float* cctx = a.in[I_CCTX];
    for (int item = blockIdx.x; item < 2 * 96; item += gridDim.x) {
        const int l = item / 96, j0 = (item % 96) * 64, j = j0 + lane;
        const float* W = a.in[I_WMOD] + (size_t)l * D * 6144;
        float acc[17];
#pragma unroll
        for (int i = 0; i < 17; ++i) acc[i] = 0.f;
        for (int ks = 0; ks < 4; ++ks) {
            const int kb = wid * 256 + ks * 64;
#pragma unroll
            for (int bi = 0; bi < 17; ++bi) { const float x = (bi < 16) ? c[bi * D + kb + lane] : cctx[kb + lane]; slab[bi * 64 + lane] = silu_f(x); }
            __syncthreads();
            for (int kk = 0; kk < 64; ++kk) {
                const float w = W[(size_t)(kb + kk) * 6144 + j];
#pragma unroll
                for (int bi = 0; bi < 17; ++bi) acc[bi] += slab[bi * 64 + kk] * w;
            }
            __syncthreads();
        }
#pragma unroll
        for (int bi = 0; bi < 17; ++bi) red[(wid * 17 + bi) * 64 + lane] = acc[bi];
        __syncthreads();
        for (int idx = tid; idx < 17 * 64; idx += 256) {
            const int bi = idx >> 6, ln = idx & 63;
            const float s = red[(0 * 17 + bi) * 64 + ln] + red[(1 * 17 + bi) * 64 + ln] + red[(2 * 17 + bi) * 64 + ln] + red[(3 * 17 + bi) * 64 + ln] + a.in[I_BMOD][l * 6144 + j0 + ln];
            mod[(size_t)(l * 17 + bi) * 6144 + j0 + ln] = s;
        }
        __syncthreads();
    }
}

DEV void ph_norm(const KArgs& a, int layer, int which  , bool combine, int comb_layer, bool from_input, int nrows) {
    const int tid = threadIdx.x, lane = tid & 63, wid = tid >> 6;
    float* hws = (float*)(a.ws + WS_H);
    bf16_t* hn = (bf16_t*)(a.ws + WS_HN);
    const bf16_t* ys = (const bf16_t*)(a.ws + WS_KV);
    const float* mod = (const float*)(a.ws + WS_MOD);
    const float* g = which == 0 ? a.in[I_GN1] + layer * D : (which == 1 ? a.in[I_GN2] + layer * D : a.in[I_GF]);
    const int nw = gridDim.x * 4;
    for (int r = blockIdx.x * 4 + wid; r < nrows; r += nw) {
        const int bi = mod_index(r);
        const float* src = from_input ? (r < TL ? a.in[I_X] + (size_t)r * D : a.in[I_CTX] + (size_t)(r - TL) * D) : hws + (size_t)r * D;
        f32x4 v[4];
#pragma unroll
        for (int j = 0; j < 4; ++j) v[j] = *(const f32x4*)(src + (lane + 64 * j) * 4);
        if (combine) {
            const float* g2 = mod + (size_t)(comb_layer * 17 + bi) * 6144 + 5 * D;
#pragma unroll
            for (int j = 0; j < 4; ++j) {
                const int k = (lane + 64 * j) * 4;
                const u32x2 y0 = *(const u32x2*)(ys + (size_t)(2 * r) * D + k), y1 = *(const u32x2*)(ys + (size_t)(2 * r + 1) * D + k);
                const f32x4 gg = *(const f32x4*)(g2 + k);
                v[j].x += gg.x * (__uint_as_float(y0.x << 16) + __uint_as_float(y1.x << 16));
                v[j].y += gg.y * (__uint_as_float(y0.x & 0xffff0000u) + __uint_as_float(y1.x & 0xffff0000u));
                v[j].z += gg.z * (__uint_as_float(y0.y << 16) + __uint_as_float(y1.y << 16));
                v[j].w += gg.w * (__uint_as_float(y0.y & 0xffff0000u) + __uint_as_float(y1.y & 0xffff0000u));
                if (which != 2) *(f32x4*)(hws + (size_t)r * D + k) = v[j];
            }
        }
        float ss = 0.f;
#pragma unroll
        for (int j = 0; j < 4; ++j) ss += v[j].x * v[j].x + v[j].y * v[j].y + v[j].z * v[j].z + v[j].w * v[j].w;
        const float rstd = rsqrtf(wave_sum(ss) * (1.f / D) + EPS);
        if (which == 2) {
#pragma unroll
            for (int j = 0; j < 4; ++j) { const int k = (lane + 64 * j) * 4; const f32x4 gg = *(const f32x4*)(g + k); f32x4 o = v[j] * rstd * gg; *(f32x4*)(a.out + (size_t)r * D + k) = o; }
        } else {
            const float* sh = mod + (size_t)(layer * 17 + bi) * 6144 + (which == 0 ? 0 : 3 * D);
            const float* sc = sh + D;
#pragma unroll
            for (int j = 0; j < 4; ++j) {
                const int k = (lane + 64 * j) * 4;
                const f32x4 gg = *(const f32x4*)(g + k), s1 = *(const f32x4*)(sc + k), s0 = *(const f32x4*)(sh + k);
                const f32x4 o = v[j] * rstd * gg * (1.f + s1) + s0;
                u32x2 w; w.x = pk2(o.x, o.y); w.y = pk2(o.z, o.w);
                *(u32x2*)(hn + (size_t)r * D + k) = w;
            }
        }
    }
}

template <class ARow, class Epi>
DEV void gemm_naive_tile(float* lds, int K, ARow arow, const float* W, int ldw, int col0, int ncols, Epi epi) {
    const int tid = threadIdx.x, ty = tid >> 4, tx = tid & 15;
    float* sA = lds;
    float* sB = lds + 16 * 68;
    const int ar = tid >> 2, kq = (tid & 3) * 4;
    const bf16_t* ap = arow(ar);
    const int kr = tid >> 4, c4 = (tid & 15) * 4;
    const bool cok = (col0 + c4) < ncols;
    float acc[4][4];
#pragma unroll
    for (int i = 0; i < 4; ++i)
#pragma unroll
        for (int j = 0; j < 4; ++j) acc[i][j] = 0.f;
    for (int k0 = 0; k0 < K; k0 += 16) {
        const u32x2 av = *(const u32x2*)(ap + k0 + kq);
        f32x4 wv = {0.f, 0.f, 0.f, 0.f};
        if (cok) wv = *(const f32x4*)(W + (size_t)(k0 + kr) * ldw + col0 + c4);
        sA[(kq + 0) * 68 + ar] = __uint_as_float(av.x << 16);
        sA[(kq + 1) * 68 + ar] = __uint_as_float(av.x & 0xffff0000u);
        sA[(kq + 2) * 68 + ar] = __uint_as_float(av.y << 16);
        sA[(kq + 3) * 68 + ar] = __uint_as_float(av.y & 0xffff0000u);
        *(f32x4*)(sB + kr * 64 + c4) = wv;
        __syncthreads();
#pragma unroll 4
        for (int k = 0; k < 16; ++k) {
            const f32x4 a4 = *(const f32x4*)(sA + k * 68 + ty * 4), b4 = *(const f32x4*)(sB + k * 64 + tx * 4);
            const float aa[4] = {a4.x, a4.y, a4.z, a4.w}, bb[4] = {b4.x, b4.y, b4.z, b4.w};
#pragma unroll
            for (int i = 0; i < 4; ++i)
#pragma unroll
                for (int j = 0; j < 4; ++j) acc[i][j] += aa[i] * bb[j];
        }
        __syncthreads();
    }
#pragma unroll
    for (int i = 0; i < 4; ++i)
#pragma unroll
        for (int j = 0; j < 4; ++j) { const int col = col0 + tx * 4 + j; if (col < ncols) epi(ty * 4 + i, col, acc[i][j]); }
}

DEV void ph_inproj(const KArgs& a, int layer, int nrows, unsigned char* lds) {
    const bf16_t* hn = (const bf16_t*)(a.ws + WS_HN);
    bf16_t* z = (bf16_t*)(a.ws + WS_Z);
    const float* W = a.in[I_WIN] + (size_t)layer * D * DIN;
    const int ntn = (DIN + 63) / 64, ntiles = (nrows / 64) * ntn;
    for (int t = blockIdx.x; t < ntiles; t += gridDim.x) {
        const int mt = t / ntn, nt = t % ntn, row0 = mt * 64;
        gemm_naive_tile((float*)lds, D, [&](int r) { return hn + (size_t)(row0 + r) * D; }, W, DIN, nt * 64, DIN,
                        [&](int r, int col, float v) { z[(size_t)(row0 + r) * DIN + col] = f2bf(v); });
    }
}

DEV void ph_outproj(const KArgs& a, int layer, int nrows, unsigned char* lds) {
    const bf16_t* mix = (const bf16_t*)(a.ws + WS_MIX);
    float* hws = (float*)(a.ws + WS_H);
    const float* mod = (const float*)(a.ws + WS_MOD);
    const float* W = a.in[I_WOUT] + (size_t)layer * D * D;
    const int ntn = D / 64, ntiles = (nrows / 64) * ntn;
    for (int t = blockIdx.x; t < ntiles; t += gridDim.x) {
        const int mt = t / ntn, nt = t % ntn, row0 = mt * 64;
        gemm_naive_tile((float*)lds, D, [&](int r) { return mix + (size_t)(row0 + r) * D; }, W, D, nt * 64, D,
                        [&](int r, int col, float v) {
                            const int row = row0 + r; const int bi = mod_index(row);
                            const float g1 = mod[(size_t)(layer * 17 + bi) * 6144 + 2 * D + col];
                            const float res = layer == 0 ? (row < TL ? a.in[I_X][(size_t)row * D + col] : a.in[I_CTX][(size_t)(row - TL) * D + col]) : hws[(size_t)row * D + col];
                            hws[(size_t)row * D + col] = res + g1 * v;
                        });
    }
}

DEV void ph_spatial(const KArgs& a, int layer, int nrows, unsigned char* lds) {
    const int tid = threadIdx.x;
    const bf16_t* z = (const bf16_t*)(a.ws + WS_Z);
    bf16_t* mix = (bf16_t*)(a.ws + WS_MIX);
    float* vs = (float*)lds;
    const int nitems = (nrows / 128) * 4;
    for (int item = blockIdx.x; item < nitems; item += gridDim.x) {
        const int ci = item >> 2, g = item & 3, row0 = ci * 128;
        const int hw = tid >> 5, l32 = tid & 31;
        const f32x4 lg = *(const f32x4*)(a.in[I_LNG] + layer * 512 + g * 128 + l32 * 4), lb = *(const f32x4*)(a.in[I_LNB] + layer * 512 + g * 128 + l32 * 4);
#pragma unroll 1
        for (int pass = 0; pass < 16; ++pass) {
            const int tok = pass * 8 + hw;
            const u32x2 raw = *(const u32x2*)(z + (size_t)(row0 + tok) * DIN + OFF_AV + g * 128 + l32 * 4);
            f32x4 x; x.x = gelu_f(__uint_as_float(raw.x << 16)); x.y = gelu_f(__uint_as_float(raw.x & 0xffff0000u)); x.z = gelu_f(__uint_as_float(raw.y << 16)); x.w = gelu_f(__uint_as_float(raw.y & 0xffff0000u));
            float s = x.x + x.y + x.z + x.w;
#pragma unroll
            for (int o = 1; o < 32; o <<= 1) s += __shfl_xor(s, o);
            const float mu = s * (1.f / 128.f);
            const f32x4 d = x - mu;
            float q = d.x * d.x + d.y * d.y + d.z * d.z + d.w * d.w;
#pragma unroll
            for (int o = 1; o < 32; o <<= 1) q += __shfl_xor(q, o);
            const float rs = rsqrtf(q * (1.f / 128.f) + EPS);
            const f32x4 y = d * rs * lg + lb;
            *(f32x4*)(vs + tok * 128 + l32 * 4) = y;
        }
        __syncthreads();
        const int p = tid >> 1;
        const float* wrow = a.in[I_WSP] + ((size_t)(layer * 4 + g) * 128 + p) * 128;
        const float bs = a.in[I_BSP][(layer * 4 + g) * 128 + p];
#pragma unroll 1
        for (int half = 0; half < 2; ++half) {
            const int c0 = (tid & 1) * 64 + half * 32;
            f32x4 acc[8];
#pragma unroll
            for (int i = 0; i < 8; ++i) acc[i] = (f32x4){0.f, 0.f, 0.f, 0.f};
#pragma unroll 2
            for (int q = 0; q < 128; ++q) {
                const float w = wrow[q];
#pragma unroll
                for (int i = 0; i < 8; ++i) acc[i] += w * *(const f32x4*)(vs + q * 128 + c0 + i * 4);
            }
            const bf16_t* zu = z + (size_t)(row0 + p) * DIN + OFF_AU + g * 128 + c0;
            bf16_t* mo = mix + (size_t)(row0 + p) * D + g * 128 + c0;
#pragma unroll
            for (int i = 0; i < 8; ++i) {
                const u32x2 raw = *(const u32x2*)(zu + i * 4);
                const float u0 = gelu_f(__uint_as_float(raw.x << 16)), u1 = gelu_f(__uint_as_float(raw.x & 0xffff0000u)), u2 = gelu_f(__uint_as_float(raw.y << 16)), u3 = gelu_f(__uint_as_float(raw.y & 0xffff0000u));
                u32x2 w; w.x = pk2(u0 * (acc[i].x + bs), u1 * (acc[i].y + bs)); w.y = pk2(u2 * (acc[i].z + bs), u3 * (acc[i].w + bs));
                *(u32x2*)(mo + i * 4) = w;
            }
        }
        __syncthreads();
    }
}

DEV void ph_gla_naive(const KArgs& a, int layer, unsigned char* lds) {
    const int tid = threadIdx.x;
    const bf16_t* z = (const bf16_t*)(a.ws + WS_Z);
    float* odir = (float*)(a.ws + WS_KV);
    float* sq = (float*)lds;
    float* sk = sq + 16 * 64;
    float* sal = sk + 16 * 64;
    float* sv = sal + 16 * 64;
    float* sor = sv + 16 * 128;
    float* swu = sor + 2 * 16 * 128;
    float* sbg = swu + 16 * 64;
    for (int item = blockIdx.x; item < NB * 4 * 2; item += gridDim.x) {
        const int dir = item & 1, h = (item >> 1) & 3, b = item >> 3;
        const int e = tid & 127, dh = tid >> 7;
        for (int i = tid; i < 16 * 64; i += 256) swu[i] = a.in[I_WGU][((size_t)(layer * 2 + dir) * 16 + (i >> 6)) * 256 + h * 64 + (i & 63)];
        if (tid < 64) sbg[tid] = a.in[I_BG][(layer * 2 + dir) * 256 + h * 64 + tid];
        float S[32];
#pragma unroll
        for (int i = 0; i < 32; ++i) S[i] = 0.f;
        __syncthreads();
        for (int bt = 0; bt < (CTXL + SEQ) / 16; ++bt) {
            const int i = tid >> 4, sub = tid & 15;
            int rowi;
            { const int p = bt * 16 + i; if (p < CTXL) { const int j = dir ? (CTXL - 1 - p) : p; rowi = TL + b * CTXL + j; } else { const int s = p - CTXL; const int pos = dir ? (SEQ - 1 - s) : s; rowi = b * SEQ + pos; } }
            const bf16_t* zr = z + (size_t)rowi * DIN;
            {
                const u32x2 qv = *(const u32x2*)(zr + OFF_BQ + h * 64 + sub * 4), kv = *(const u32x2*)(zr + OFF_BK + h * 64 + sub * 4);
                float* dq = sq + i * 64 + sub * 4; float* dk = sk + i * 64 + sub * 4;
                dq[0] = 0.125f * __uint_as_float(qv.x << 16); dq[1] = 0.125f * __uint_as_float(qv.x & 0xffff0000u); dq[2] = 0.125f * __uint_as_float(qv.y << 16); dq[3] = 0.125f * __uint_as_float(qv.y & 0xffff0000u);
                dk[0] = __uint_as_float(kv.x << 16); dk[1] = __uint_as_float(kv.x & 0xffff0000u); dk[2] = __uint_as_float(kv.y << 16); dk[3] = __uint_as_float(kv.y & 0xffff0000u);
                const u32x4 vv = *(const u32x4*)(zr + OFF_BV + h * 128 + sub * 8);
                float* dv = sv + i * 128 + sub * 8;
                dv[0] = __uint_as_float(vv.x << 16); dv[1] = __uint_as_float(vv.x & 0xffff0000u); dv[2] = __uint_as_float(vv.y << 16); dv[3] = __uint_as_float(vv.y & 0xffff0000u);
                dv[4] = __uint_as_float(vv.z << 16); dv[5] = __uint_as_float(vv.z & 0xffff0000u); dv[6] = __uint_as_float(vv.w << 16); dv[7] = __uint_as_float(vv.w & 0xffff0000u);
                const u32x4 g0 = *(const u32x4*)(zr + OFF_BG + dir * 16), g1 = *(const u32x4*)(zr + OFF_BG + dir * 16 + 8);
                float zg[16];
                zg[0] = __uint_as_float(g0.x << 16); zg[1] = __uint_as_float(g0.x & 0xffff0000u); zg[2] = __uint_as_float(g0.y << 16); zg[3] = __uint_as_float(g0.y & 0xffff0000u);
                zg[4] = __uint_as_float(g0.z << 16); zg[5] = __uint_as_float(g0.z & 0xffff0000u); zg[6] = __uint_as_float(g0.w << 16); zg[7] = __uint_as_float(g0.w & 0xffff0000u);
                zg[8] = __uint_as_float(g1.x << 16); zg[9] = __uint_as_float(g1.x & 0xffff0000u); zg[10] = __uint_as_float(g1.y << 16); zg[11] = __uint_as_float(g1.y & 0xffff0000u);
                zg[12] = __uint_as_float(g1.z << 16); zg[13] = __uint_as_float(g1.z & 0xffff0000u); zg[14] = __uint_as_float(g1.w << 16); zg[15] = __uint_as_float(g1.w & 0xffff0000u);
#pragma unroll
                for (int dd = 0; dd < 4; ++dd) {
                    const int d = sub * 4 + dd; float lgt = sbg[d];
#pragma unroll
                    for (int r = 0; r < 16; ++r) lgt += zg[r] * swu[r * 64 + d];
                    sal[i * 64 + d] = __expf(logsigmoid_f(lgt) * (1.f / 16.f));
                }
            }
            __syncthreads();
#pragma unroll 1
            for (int t = 0; t < 16; ++t) {
                const float vt = sv[t * 128 + e];
                float acc = 0.f;
#pragma unroll
                for (int d4 = 0; d4 < 8; ++d4) {
                    const f32x4 al = *(const f32x4*)(sal + t * 64 + dh * 32 + d4 * 4), kk = *(const f32x4*)(sk + t * 64 + dh * 32 + d4 * 4), qq = *(const f32x4*)(sq + t * 64 + dh * 32 + d4 * 4);
                    S[d4 * 4 + 0] = al.x * S[d4 * 4 + 0] + kk.x * vt; acc += qq.x * S[d4 * 4 + 0];
                    S[d4 * 4 + 1] = al.y * S[d4 * 4 + 1] + kk.y * vt; acc += qq.y * S[d4 * 4 + 1];
                    S[d4 * 4 + 2] = al.z * S[d4 * 4 + 2] + kk.z * vt; acc += qq.z * S[d4 * 4 + 2];
                    S[d4 * 4 + 3] = al.w * S[d4 * 4 + 3] + kk.w * vt; acc += qq.w * S[d4 * 4 + 3];
                }
                sor[(dh * 16 + t) * 128 + e] = acc;
            }
            __syncthreads();
            {
                const int t = tid >> 4;
                int rowt;
                { const int p = bt * 16 + t; if (p < CTXL) { const int j = dir ? (CTXL - 1 - p) : p; rowt = TL + b * CTXL + j; } else { const int s = p - CTXL; const int pos = dir ? (SEQ - 1 - s) : s; rowt = b * SEQ + pos; } }
                const int e0 = (tid & 15) * 8;
                const f32x4 x0 = *(const f32x4*)(sor + t * 128 + e0), x1 = *(const f32x4*)(sor + t * 128 + e0 + 4), y0 = *(const f32x4*)(sor + (16 + t) * 128 + e0), y1 = *(const f32x4*)(sor + (16 + t) * 128 + e0 + 4);
                float* op = odir + ((size_t)dir * TA + rowt) * 512 + h * 128 + e0;
                *(f32x4*)op = x0 + y0; *(f32x4*)(op + 4) = x1 + y1;
            }
            __syncthreads();
        }
    }
}

DEV void ph_gla_merge(const KArgs& a, int layer, int nrows) {
    const int tid = threadIdx.x, lane = tid & 63, wid = tid >> 6;
    const bf16_t* z = (const bf16_t*)(a.ws + WS_Z);
    const float* odir = (const float*)(a.ws + WS_KV);
    bf16_t* mix = (bf16_t*)(a.ws + WS_MIX);
    const int nw = gridDim.x * 4;
    for (int r = blockIdx.x * 4 + wid; r < nrows; r += nw) {
        const int ch = lane * 8;
        const float* of = odir + (size_t)r * 512 + ch; const float* ob = odir + ((size_t)TA + r) * 512 + ch;
        const f32x4 f0 = *(const f32x4*)of, f1 = *(const f32x4*)(of + 4), b0 = *(const f32x4*)ob, b1 = *(const f32x4*)(ob + 4);
        const f32x4 o0 = f0 + b0, o1 = f1 + b1;
        float ss = o0.x * o0.x + o0.y * o0.y + o0.z * o0.z + o0.w * o0.w + o1.x * o1.x + o1.y * o1.y + o1.z * o1.z + o1.w * o1.w;
#pragma unroll
        for (int o = 1; o < 16; o <<= 1) ss += __shfl_xor(ss, o);
        const float rstd = rsqrtf(ss * (1.f / 128.f) + EPS);
        const f32x4 g0 = *(const f32x4*)(a.in[I_GGLA] + layer * 512 + ch), g1 = *(const f32x4*)(a.in[I_GGLA] + layer * 512 + ch + 4);
        const u32x4 rr = *(const u32x4*)(z + (size_t)r * DIN + OFF_BR + ch);
        const float r0 = silu_f(__uint_as_float(rr.x << 16)), r1 = silu_f(__uint_as_float(rr.x & 0xffff0000u)), r2 = silu_f(__uint_as_float(rr.y << 16)), r3 = silu_f(__uint_as_float(rr.y & 0xffff0000u));
        const float r4 = silu_f(__uint_as_float(rr.z << 16)), r5 = silu_f(__uint_as_float(rr.z & 0xffff0000u)), r6 = silu_f(__uint_as_float(rr.w << 16)), r7 = silu_f(__uint_as_float(rr.w & 0xffff0000u));
        u32x4 w;
        w.x = pk2(o0.x * rstd * g0.x * r0, o0.y * rstd * g0.y * r1); w.y = pk2(o0.z * rstd * g0.z * r2, o0.w * rstd * g0.w * r3);
        w.z = pk2(o1.x * rstd * g1.x * r4, o1.y * rstd * g1.y * r5); w.w = pk2(o1.z * rstd * g1.z * r6, o1.w * rstd * g1.w * r7);
        *(u32x4*)(mix + (size_t)r * D + 512 + ch) = w;
    }
}

DEV void ph_router(const KArgs& a, int layer, int nrows, unsigned char* lds) {
    const int tid = threadIdx.x, lane = tid & 63, wid = tid >> 6;
    const bf16_t* hn = (const bf16_t*)(a.ws + WS_HN);
    unsigned* cnt = (unsigned*)(a.ws + WS_CTL) + layer * NE;
    unsigned* list = (unsigned*)(a.ws + WS_LIST);
    float* gate = (float*)(a.ws + WS_GATE);
    float* xs = (float*)lds + wid * 1104;
    float* lgs = xs + 1024;
    const float* wre = a.in[I_WRE] + (size_t)layer * D * 64; const float* wrg = a.in[I_WRG] + (size_t)layer * D * 8;
    const int nw = gridDim.x * 4, iters = (nrows + nw - 1) / nw;
    for (int it = 0; it < iters; ++it) {
        const int r = it * nw + blockIdx.x * 4 + wid;
        const bool valid = r < nrows;
        if (valid) {
            const u32x4 p0 = *(const u32x4*)(hn + (size_t)r * D + lane * 16), p1 = *(const u32x4*)(hn + (size_t)r * D + lane * 16 + 8);
            float* d = xs + lane * 16;
            d[0] = __uint_as_float(p0.x << 16); d[1] = __uint_as_float(p0.x & 0xffff0000u); d[2] = __uint_as_float(p0.y << 16); d[3] = __uint_as_float(p0.y & 0xffff0000u);
            d[4] = __uint_as_float(p0.z << 16); d[5] = __uint_as_float(p0.z & 0xffff0000u); d[6] = __uint_as_float(p0.w << 16); d[7] = __uint_as_float(p0.w & 0xffff0000u);
            d[8] = __uint_as_float(p1.x << 16); d[9] = __uint_as_float(p1.x & 0xffff0000u); d[10] = __uint_as_float(p1.y << 16); d[11] = __uint_as_float(p1.y & 0xffff0000u);
            d[12] = __uint_as_float(p1.z << 16); d[13] = __uint_as_float(p1.z & 0xffff0000u); d[14] = __uint_as_float(p1.w << 16); d[15] = __uint_as_float(p1.w & 0xffff0000u);
        }
        __syncthreads();
        if (valid) {
            float ae = 0.f, ag = 0.f;
            for (int k = 0; k < D; ++k) { const float x = xs[k]; ae += x * wre[k * 64 + lane]; if (lane < 8) ag += x * wrg[k * 8 + lane]; }
            lgs[8 + lane] = ae + a.in[I_BRE][layer * 64 + lane];
            if (lane < 8) lgs[lane] = ag + a.in[I_BRG][layer * 8 + lane];
        }
        __syncthreads();
        if (valid && lane == 0) {
            float m = lgs[0]; int gi = 0;
            for (int j = 1; j < 8; ++j) if (lgs[j] > m) { m = lgs[j]; gi = j; }
            float sum = 0.f;
            for (int j = 0; j < 8; ++j) sum += __expf(lgs[j] - m);
            const float ptop = 1.f / sum;
            const float* le = lgs + 8 + gi * 8;
            float l1 = le[0]; int i1 = 0;
            for (int j = 1; j < 8; ++j) if (le[j] > l1) { l1 = le[j]; i1 = j; }
            float l2 = -3.0e38f; int i2 = 0;
            for (int j = 0; j < 8; ++j) if (j != i1 && le[j] > l2) { l2 = le[j]; i2 = j; }
            const float e2 = __expf(l2 - l1), w1 = 1.f / (1.f + e2), w2 = e2 / (1.f + e2);
            const int ex1 = gi * 8 + i1, ex2 = gi * 8 + i2;
            const unsigned p1 = atomicAdd(cnt + ex1, 1u), p2 = atomicAdd(cnt + ex2, 1u);
            list[(size_t)ex1 * LCAP + p1] = (unsigned)(2 * r); list[(size_t)ex2 * LCAP + p2] = (unsigned)(2 * r + 1);
            gate[2 * r] = ptop * w1; gate[2 * r + 1] = ptop * w2;
        }
        __syncthreads();
    }
}

DEV void ph_moe(const KArgs& a, int layer, int sub, unsigned char* lds) {
    const int tid = threadIdx.x;
    const unsigned* cnt = (const unsigned*)(a.ws + WS_CTL) + layer * NE;
    const unsigned* list = (const unsigned*)(a.ws + WS_LIST);
    const float* gate = (const float*)(a.ws + WS_GATE);
    const bf16_t* hn = (const bf16_t*)(a.ws + WS_HN);
    bf16_t* Hm = (bf16_t*)(a.ws + WS_Z);
    float* a1t = (float*)(a.ws + WS_KV);
    bf16_t* ys = (bf16_t*)(a.ws + WS_KV);
    int* soff = (int*)(lds + 60 * 1024);
    int* stoff = soff + 80;
    const int ntn = sub == 2 ? 16 : 8;
    if (tid == 0) { int o = 0, t = 0; for (int e = 0; e < NE; ++e) { const int c = (int)cnt[e]; soff[e] = o; stoff[e] = t; o += c; t += ((c + 63) / 64) * ntn; } soff[NE] = o; stoff[NE] = t; }
    __syncthreads();
    const int ntiles = stoff[NE];
    for (int t = blockIdx.x; t < ntiles; t += gridDim.x) {
        int e = 0;
        for (int j = 1; j < NE; ++j) if (stoff[j] <= t) e = j;
        const int local = t - stoff[e], mt = local / ntn, nt = local % ntn, c = (int)cnt[e], ro = soff[e], p0 = mt * 64;
        const unsigned* le = list + (size_t)e * LCAP;
        if (sub < 2) {
            const float* W = a.in[sub == 0 ? I_W1 : I_W3] + ((size_t)layer * NE + e) * D * DE;
            gemm_naive_tile((float*)lds, D, [&](int r) { const int p = p0 + r; const unsigned slot = le[p < c ? p : 0]; return hn + (size_t)(slot >> 1) * D; }, W, DE, nt * 64, DE,
                            [&](int r, int col, float v) {
                                const int p = p0 + r; if (p >= c) return;
                                const size_t idx = (size_t)(ro + p) * DE + col;
                                if (sub == 0) a1t[idx] = v; else Hm[idx] = f2bf(silu_f(a1t[idx]) * v);
                            });
        } else {
            const float* W = a.in[I_W2] + ((size_t)layer * NE + e) * DE * D;
            gemm_naive_tile((float*)lds, DE, [&](int r) { const int p = p0 + r; return Hm + (size_t)(ro + (p < c ? p : 0)) * DE; }, W, D, nt * 64, D,
                            [&](int r, int col, float v) {
                                const int p = p0 + r; if (p >= c) return;
                                const unsigned slot = le[p];
                                ys[(size_t)slot * D + col] = f2bf(gate[slot] * v);
                            });
        }
    }
}

constexpr int NPH_LAYER = 11, NPH = 1 + 2 * NPH_LAYER + 1;
__global__ void __launch_bounds__(256, 2) mega(KArgs a) {
    __shared__ __attribute__((aligned(16))) unsigned char lds[65536];
    cg::grid_group grid = cg::this_grid();
    const int lo = a.ph_lo, hi = a.ph_hi;
#define PHASE(k, call) do { const int k_ = (k); if (lo <= k_ && k_ < hi) { call; if (k_ + 1 < hi) grid.sync(); } } while (0)
    PHASE(0, ph_prep(a, lds));
#pragma unroll 1
    for (int l = 0; l < 2; ++l) {
        const int base = 1 + l * NPH_LAYER;
        const int nrows = l == 0 ? TA : TL;
        PHASE(base + 0, ph_norm(a, l, 0, l > 0, l - 1, l == 0, TA));
        PHASE(base + 1, ph_inproj(a, l, TA, lds));
        PHASE(base + 2, ph_spatial(a, l, nrows, lds));
        PHASE(base + 3, ph_gla_naive(a, l, lds));
        PHASE(base + 4, ph_gla_merge(a, l, nrows));
        PHASE(base + 5, ph_outproj(a, l, nrows, lds));
        PHASE(base + 6, ph_norm(a, l, 1, false, 0, false, nrows));
        PHASE(base + 7, ph_router(a, l, nrows, lds));
        PHASE(base + 8, ph_moe(a, l, 0, lds));
        PHASE(base + 9, ph_moe(a, l, 1, lds));
        PHASE(base + 10, ph_moe(a, l, 2, lds));
    }
    PHASE(NPH - 1, ph_norm(a, 0, 2, true, 1, false, TL));
#undef PHASE
}

extern "C" void kernel_launch(void* const* d_in, const int* in_sizes, int n_in, void* d_out, int out_size, void* d_ws, size_t ws_size, hipStream_t stream) {
    static int grid = 0;
    if (grid == 0) {
        int dev = 0, cus = 0, per_cu = 0;
        hipGetDevice(&dev);
        hipDeviceGetAttribute(&cus, hipDeviceAttributeMultiprocessorCount, dev);
        hipOccupancyMaxActiveBlocksPerMultiprocessor(&per_cu, (const void*)mega, 256, 0);
        if (per_cu < 1) per_cu = 1;
        if (per_cu > 2) per_cu = 2;
        grid = cus * per_cu;
        if (n_in != 25 || ws_size < WS_END) { fprintf(stderr, "kernel_launch: unexpected n_in %d or ws_size %zu (need %zu)\n", n_in, ws_size, (size_t)WS_END); }
    }
    KArgs a{};
    for (int i = 0; i < 25; ++i) a.in[i] = (const float*)d_in[i];
    a.out = (float*)d_out; a.ws = (unsigned char*)d_ws;
#if ONE_LAUNCH
    a.ph_lo = 0; a.ph_hi = NPH;
    void* args[] = {&a};
    hipError_t e = hipLaunchCooperativeKernel((const void*)mega, dim3(grid), dim3(256), args, 0, stream);
    if (e != hipSuccess) fprintf(stderr, "cooperative launch failed: %s (grid %d)\n", hipGetErrorString(e), grid);
#else
    for (int ph = 0; ph < NPH; ++ph) {
        a.ph_lo = ph; a.ph_hi = ph + 1;
        hipLaunchKernelGGL(mega, dim3(grid), dim3(256), 0, stream, a);
    }
#endif
}
```

```cpp
#include <hip/hip_runtime.h>
#include <hip/hip_cooperative_groups.h>
#include <cstdio>
#include <cstdint>
namespace cg = cooperative_groups;

#ifndef ONE_LAUNCH
#define ONE_LAUNCH 1
#endif

#define DEV __device__ __forceinline__
typedef unsigned short bf16_t;
typedef float f32x4 __attribute__((ext_vector_type(4)));
typedef unsigned u32x2 __attribute__((ext_vector_type(2)));
typedef unsigned u32x4 __attribute__((ext_vector_type(4)));
typedef short bf16x8 __attribute__((ext_vector_type(8)));
typedef float f32x16 __attribute__((ext_vector_type(16)));

constexpr int D = 1024, NB = 16, SEQ = 2048, CTXL = 256;
constexpr int TL = NB * SEQ, TC = NB * CTXL, TA = TL + TC;
constexpr int DIN = 2592, OFF_AU = 0, OFF_AV = 512, OFF_BQ = 1024, OFF_BR = 1280, OFF_BK = 1792, OFF_BV = 2048, OFF_BG = 2560;
constexpr int NE = 64, DE = 512, LCAP = 2 * TA;
constexpr float EPS = 1e-6f;

constexpr size_t MiB = 1u << 20;
constexpr size_t WS_CTL = 0, WS_MOD = 1 * MiB, WS_WRT = 2 * MiB, WS_WSP = 2 * MiB + 512 * 1024, WS_WINT = 3 * MiB, WS_WOUTT = 14 * MiB,
                 WS_W1T = 18 * MiB, WS_W3T = 82 * MiB, WS_W2T = 146 * MiB, WS_H = 210 * MiB, WS_HN = 354 * MiB, WS_Z = 426 * MiB, WS_MIX = 609 * MiB,
                 WS_KV = 681 * MiB, WS_LIST = 825 * MiB, WS_GATE = 843 * MiB, WS_DECAY = 844 * MiB, WS_HN8 = 846 * MiB, WS_END = 884 * MiB;
static_assert(WS_WINT + (size_t)2 * DIN * D * 2 <= WS_WOUTT && WS_WOUTT + (size_t)2 * D * D * 2 <= WS_W1T && WS_W1T + (size_t)NE * DE * D * 2 <= WS_W3T && WS_W2T + (size_t)NE * DE * D * 2 <= WS_H, "ws map (weights)");
static_assert(WS_H + (size_t)TA * D * 4 <= WS_HN && WS_HN + (size_t)TA * D * 2 <= WS_Z && WS_Z + (size_t)TA * DIN * 2 <= WS_MIX &&
              WS_MIX + (size_t)TA * D * 2 <= WS_KV && WS_KV + (size_t)2 * TA * 512 * 4 <= WS_LIST && WS_LIST + (size_t)NE * LCAP * 4 <= WS_GATE, "ws map");

struct KArgs { const float* in[25]; float* out; unsigned char* ws; int ph_lo, ph_hi; };
enum { I_X = 0, I_C, I_CTX, I_CCTX, I_WMOD, I_BMOD, I_GN1, I_WIN, I_LNG, I_LNB, I_WSP, I_BSP, I_WGU, I_BG, I_GGLA, I_WOUT, I_GN2, I_WRG, I_BRG, I_WRE, I_BRE, I_W1, I_W3, I_W2, I_GF };

DEV float bf2f(bf16_t v) { return __uint_as_float((unsigned)v << 16); }
typedef __bf16 bf16x2_t __attribute__((ext_vector_type(2)));
DEV bf16_t f2bf(float f) { return __builtin_bit_cast(bf16_t, (__bf16)f); }
DEV unsigned pk2(float lo, float hi) { bf16x2_t v; v.x = (__bf16)lo; v.y = (__bf16)hi; return __builtin_bit_cast(unsigned, v); }
DEV u32x4 widen_pair(u32x2 a, u32x2 b) {
    auto r0 = __builtin_amdgcn_permlane32_swap(a.x, b.x, false, false); auto r1 = __builtin_amdgcn_permlane32_swap(a.y, b.y, false, false);
    u32x4 o; o.x = r0[0]; o.y = r1[0]; o.z = r0[1]; o.w = r1[1]; return o;
}
constexpr float W8_SCALE = 32.f, W8_INV = 1.f / 32.f, YS_SCALE = 16.f, YS_INV = 1.f / 16.f;
DEV unsigned pk4_fp8(float a, float b, float c, float d) { int w = 0; w = __builtin_amdgcn_cvt_pk_fp8_f32(a, b, w, false); w = __builtin_amdgcn_cvt_pk_fp8_f32(c, d, w, true); return (unsigned)w; }
DEV float silu_f(float x) { return x * __builtin_amdgcn_rcpf(1.f + __expf(-x)); }
DEV float gelu_f(float x) { const float x2 = x * x; const float u2 = x * (1.5957691216057308f + 0.07135481627f * x2); return x * __builtin_amdgcn_rcpf(1.f + __expf(-u2)); }
DEV float logsigmoid_f(float x) { return fminf(x, 0.f) - __logf(1.f + __expf(-fabsf(x))); }
DEV float wave_sum(float v) {
#pragma unroll
    for (int o = 1; o < 64; o <<= 1) v += __shfl_xor(v, o);
    return v;
}
DEV int get_tid() { int t = threadIdx.x; asm volatile("" : "+v"(t)); return t; }
DEV int mod_index(int row) { return row < TL ? (row >> 11) : 16; }

DEV void ph_prep(const KArgs& a, unsigned char* lds) {
    const int tid = get_tid(), lane = tid & 63, wid = tid >> 6;
    float* slab = (float*)lds + wid * 17 * 64;
    float* red = (float*)lds + 4 * 17 * 64;
    float* mod = (float*)(a.ws + WS_MOD);
    const float* c = a.in[I_C]; const float* cctx = a.in[I_CCTX];
    for (int item = blockIdx.x; item < 2 * 96 * 2; item += gridDim.x) {
        const int kh = item & 1, it2 = item >> 1, l = it2 / 96, j0 = (it2 % 96) * 64, j = j0 + lane;
        const float* W = a.in[I_WMOD] + (size_t)l * D * 6144;
        float acc[17];
#pragma unroll
        for (int i = 0; i < 17; ++i) acc[i] = 0.f;
#pragma unroll 1
        for (int ks = 0; ks < 2; ++ks) {
            const int kb = kh * 512 + wid * 128 + ks * 64;
#pragma unroll
            for (int bi = 0; bi < 17; ++bi) { const float x = (bi < 16) ? c[bi * D + kb + lane] : cctx[kb + lane]; slab[bi * 64 + lane] = silu_f(x); }
            __syncthreads();
#pragma unroll 1
            for (int k8 = 0; k8 < 64; k8 += 16) {
                float w[16];
#pragma unroll
                for (int u = 0; u < 16; ++u) w[u] = __builtin_nontemporal_load(W + (size_t)(kb + k8 + u) * 6144 + j);
#pragma unroll
                for (int u = 0; u < 16; ++u)
#pragma unroll
                    for (int bi = 0; bi < 17; ++bi) acc[bi] += slab[bi * 64 + k8 + u] * w[u];
            }
            __syncthreads();
        }
#pragma unroll
        for (int bi = 0; bi < 17; ++bi) red[(wid * 17 + bi) * 64 + lane] = acc[bi];
        __syncthreads();
        for (int idx = tid; idx < 17 * 64; idx += 256) {
            const int bi = idx >> 6, ln = idx & 63;
            const float sv = red[(0 * 17 + bi) * 64 + ln] + red[(1 * 17 + bi) * 64 + ln] + red[(2 * 17 + bi) * 64 + ln] + red[(3 * 17 + bi) * 64 + ln] + (kh == 0 ? a.in[I_BMOD][l * 6144 + j0 + ln] : 0.f);
            atomicAdd(mod + (size_t)(l * 17 + bi) * 6144 + j0 + ln, sv);
        }
        __syncthreads();
    }
}

DEV void ph_norm(const KArgs& a, int layer, int which  , bool combine, int comb_layer, bool from_input, int nrows) {
    const int tid = get_tid(), lane = tid & 63, wid = tid >> 6;
    float* hws = (float*)(a.ws + WS_H);
    bf16_t* hn = (bf16_t*)(a.ws + WS_HN);
    const bf16_t* ys = (const bf16_t*)(a.ws + WS_KV);
    const float* mod = (const float*)(a.ws + WS_MOD);
    const float* g = which == 0 ? a.in[I_GN1] + layer * D : (which == 1 ? a.in[I_GN2] + layer * D : a.in[I_GF]);
    const int nw = gridDim.x * 4;
    for (int r = blockIdx.x * 4 + wid; r < nrows; r += nw) {
        const int bi = mod_index(r);
        const float* src = from_input ? (r < TL ? a.in[I_X] + (size_t)r * D : a.in[I_CTX] + (size_t)(r - TL) * D) : hws + (size_t)r * D;
        f32x4 v[4];
#pragma unroll
        for (int j = 0; j < 4; ++j) v[j] = __builtin_nontemporal_load((const f32x4*)(src + (lane + 64 * j) * 4));
        if (combine) {
            const float* g2 = mod + (size_t)(comb_layer * 17 + bi) * 6144 + 5 * D;
            unsigned y0v[4], y1v[4]; f32x4 ggv[4];
#pragma unroll
            for (int j = 0; j < 4; ++j) { const int k = (lane + 64 * j) * 4; y0v[j] = __builtin_nontemporal_load((const unsigned*)((const unsigned char*)ys + (size_t)(2 * r) * D + k)); y1v[j] = __builtin_nontemporal_load((const unsigned*)((const unsigned char*)ys + (size_t)(2 * r + 1) * D + k)); ggv[j] = *(const f32x4*)(g2 + k); }
#pragma unroll
            for (int j = 0; j < 4; ++j) {
                const int k = (lane + 64 * j) * 4;
                const int y0 = (int)y0v[j], y1 = (int)y1v[j];
                const f32x4 gg = ggv[j] * YS_INV;
                v[j].x += gg.x * (__builtin_amdgcn_cvt_f32_fp8(y0, 0) + __builtin_amdgcn_cvt_f32_fp8(y1, 0));
                v[j].y += gg.y * (__builtin_amdgcn_cvt_f32_fp8(y0, 1) + __builtin_amdgcn_cvt_f32_fp8(y1, 1));
                v[j].z += gg.z * (__builtin_amdgcn_cvt_f32_fp8(y0, 2) + __builtin_amdgcn_cvt_f32_fp8(y1, 2));
                v[j].w += gg.w * (__builtin_amdgcn_cvt_f32_fp8(y0, 3) + __builtin_amdgcn_cvt_f32_fp8(y1, 3));
                if (which != 2) __builtin_nontemporal_store(v[j], (f32x4*)(hws + (size_t)r * D + k));
            }
        }
        float ss = 0.f;
#pragma unroll
        for (int j = 0; j < 4; ++j) ss += v[j].x * v[j].x + v[j].y * v[j].y + v[j].z * v[j].z + v[j].w * v[j].w;
        const float rstd = rsqrtf(wave_sum(ss) * (1.f / D) + EPS);
        if (which == 2) {
            f32x4 gv[4];
#pragma unroll
            for (int j = 0; j < 4; ++j) gv[j] = *(const f32x4*)(g + (lane + 64 * j) * 4);
#pragma unroll
            for (int j = 0; j < 4; ++j) { const int k = (lane + 64 * j) * 4; f32x4 o = v[j] * rstd * gv[j]; __builtin_nontemporal_store(o, (f32x4*)(a.out + (size_t)r * D + k)); }
        } else {
            const float* sh = mod + (size_t)(layer * 17 + bi) * 6144 + (which == 0 ? 0 : 3 * D);
            const float* sc = sh + D;
            f32x4 gv[4], s1v[4], s0v[4];
#pragma unroll
            for (int j = 0; j < 4; ++j) { const int k = (lane + 64 * j) * 4; gv[j] = *(const f32x4*)(g + k); s1v[j] = *(const f32x4*)(sc + k); s0v[j] = *(const f32x4*)(sh + k); }
#pragma unroll
            for (int j = 0; j < 4; ++j) {
                const int k = (lane + 64 * j) * 4;
                const f32x4 gg = gv[j], s1 = s1v[j], s0 = s0v[j];
                const f32x4 o = v[j] * rstd * gg * (1.f + s1) + s0;
                u32x2 w; w.x = pk2(o.x, o.y); w.y = pk2(o.z, o.w);
                *(u32x2*)(hn + (size_t)r * D + k) = w;
                if (which == 1) *(unsigned*)(a.ws + WS_HN8 + (size_t)r * D + k) = pk4_fp8(o.x, o.y, o.z, o.w);
            }
        }
    }
}


DEV void transpose_item(const float* W, int K, int N, bf16_t* WT, float* scr, int kb, int nb, int lane) {
    const int k0 = kb * 64, n0 = nb * 32;
    float wv[32];
#pragma unroll
    for (int i = 0; i < 32; ++i) wv[i] = __builtin_nontemporal_load(W + (size_t)(k0 + 2 * i + (lane >> 5)) * N + n0 + (lane & 31));
#pragma unroll
    for (int i = 0; i < 32; ++i) scr[(2 * i + (lane >> 5)) * 33 + (lane & 31)] = wv[i];
    asm volatile("s_waitcnt lgkmcnt(0)" ::: "memory");
    const int c = lane & 7;
#pragma unroll
    for (int j = 0; j < 4; ++j) {
        const int n = (lane >> 3) + 8 * j; const float* sp = scr + (8 * c) * 33 + n;
        u32x4 o; o.x = pk2(sp[0 * 33], sp[1 * 33]); o.y = pk2(sp[2 * 33], sp[3 * 33]); o.z = pk2(sp[4 * 33], sp[5 * 33]); o.w = pk2(sp[6 * 33], sp[7 * 33]);
        *(u32x4*)(WT + (size_t)(n0 + n) * K + k0 + 8 * c) = o;
    }
    asm volatile("s_waitcnt lgkmcnt(0)" ::: "memory");
}
DEV void transpose_item8(const float* W, int K, int N, unsigned char* WT, float* scr, int kb, int nb, int lane) {
    const int k0 = kb * 64, n0 = nb * 32;
    float wv[32];
#pragma unroll
    for (int i = 0; i < 32; ++i) wv[i] = __builtin_nontemporal_load(W + (size_t)(k0 + 2 * i + (lane >> 5)) * N + n0 + (lane & 31));
#pragma unroll
    for (int i = 0; i < 32; ++i) scr[(2 * i + (lane >> 5)) * 33 + (lane & 31)] = wv[i] * W8_SCALE;
    asm volatile("s_waitcnt lgkmcnt(0)" ::: "memory");
    const int n = lane >> 1, kh = (lane & 1) * 32;
    const float* sp = scr + kh * 33 + n;
    u32x4 o0, o1;
    o0.x = pk4_fp8(sp[0 * 33], sp[1 * 33], sp[2 * 33], sp[3 * 33]); o0.y = pk4_fp8(sp[4 * 33], sp[5 * 33], sp[6 * 33], sp[7 * 33]);
    o0.z = pk4_fp8(sp[8 * 33], sp[9 * 33], sp[10 * 33], sp[11 * 33]); o0.w = pk4_fp8(sp[12 * 33], sp[13 * 33], sp[14 * 33], sp[15 * 33]);
    o1.x = pk4_fp8(sp[16 * 33], sp[17 * 33], sp[18 * 33], sp[19 * 33]); o1.y = pk4_fp8(sp[20 * 33], sp[21 * 33], sp[22 * 33], sp[23 * 33]);
    o1.z = pk4_fp8(sp[24 * 33], sp[25 * 33], sp[26 * 33], sp[27 * 33]); o1.w = pk4_fp8(sp[28 * 33], sp[29 * 33], sp[30 * 33], sp[31 * 33]);
    unsigned char* dp = WT + (size_t)(n0 + n) * K + k0 + kh;
    __builtin_nontemporal_store(o0, (u32x4*)dp); __builtin_nontemporal_store(o1, (u32x4*)(dp + 16));
    asm volatile("s_waitcnt lgkmcnt(0)" ::: "memory");
}
DEV void convert_experts(const KArgs& a, int layer, unsigned char* lds) {
    const int tid = get_tid(), lane = tid & 63, wid = tid >> 6;
    float* scr = (float*)lds + wid * (64 * 33);
    const int gw = blockIdx.x * 4 + wid, ngw = gridDim.x * 4;
    for (int it = gw; it < NE * 3 * 256; it += ngw) {
        const int mat = it >> 8, sub = it & 255, e = mat / 3, which = mat % 3;
        if (which < 2) {
            const float* W = a.in[which == 0 ? I_W1 : I_W3] + ((size_t)layer * NE + e) * D * DE;
            unsigned char* WT = a.ws + (which == 0 ? WS_W1T : WS_W3T) + (size_t)e * DE * D;
            transpose_item8(W, D, DE, WT, scr, sub >> 4, sub & 15, lane);
        } else {
            const float* W = a.in[I_W2] + ((size_t)layer * NE + e) * DE * D;
            unsigned char* WT = a.ws + WS_W2T + (size_t)e * D * DE;
            transpose_item8(W, DE, D, WT, scr, sub >> 5, sub & 31, lane);
        }
    }
}
DEV void convert_shared(const KArgs& a, unsigned char* lds) {
    const int tid = get_tid(), lane = tid & 63, wid = tid >> 6;
    float* scr = (float*)lds + wid * (64 * 33);
    const int gw = blockIdx.x * 4 + wid, ngw = gridDim.x * 4;
    constexpr int I_IN = 16 * 81, I_OUT = 16 * 32;
    for (int it = gw; it < 2 * I_IN + 2 * I_OUT; it += ngw) {
        if (it < 2 * I_IN) { const int l = it / I_IN, sub = it % I_IN; transpose_item(a.in[I_WIN] + (size_t)l * D * DIN, D, DIN, (bf16_t*)(a.ws + WS_WINT) + (size_t)l * DIN * D, scr, sub / 81, sub % 81, lane); }
        else { const int r = it - 2 * I_IN, l = r / I_OUT, sub = r % I_OUT; transpose_item(a.in[I_WOUT] + (size_t)l * D * D, D, D, (bf16_t*)(a.ws + WS_WOUTT) + (size_t)l * D * D, scr, sub >> 5, sub & 31, lane); }
    }
    bf16_t* wrt = (bf16_t*)(a.ws + WS_WRT); bf16_t* wsp = (bf16_t*)(a.ws + WS_WSP);
    const int gt = blockIdx.x * 256 + tid, ngt = gridDim.x * 256;
    for (int i = gt; i < 2 * 128 * D; i += ngt) {
        const int l = i >> 17, n = (i >> 10) & 127, k = i & 1023;
        float v = 0.f;
        if (n < 8) v = a.in[I_WRG][((size_t)l * D + k) * 8 + n]; else if (n < 72) v = a.in[I_WRE][((size_t)l * D + k) * 64 + (n - 8)];
        wrt[i] = f2bf(v);
    }
    for (int i = gt; i < 2 * 4 * 128 * 128; i += ngt) wsp[i] = f2bf(a.in[I_WSP][i]);
}

DEV void glds16(const bf16_t* src, unsigned char* dst) { __builtin_amdgcn_global_load_lds((const unsigned*)src, (__attribute__((address_space(3))) unsigned*)dst, 16, 0, 0); }
template <class ARow, class BRow>
DEV void gemm_core(unsigned char* lds, int nk, ARow arow, BRow brow, f32x16 (&acc)[2][2]) {
    const int tid = get_tid(), lane = tid & 63, wid = tid >> 6, wr = wid >> 1, wc = wid & 1;
    const int srow = tid >> 3, sch = (tid & 7) ^ ((tid >> 4) & 7);
    const bf16_t* ap[4]; const bf16_t* bp[4];
#pragma unroll
    for (int i = 0; i < 4; ++i) { ap[i] = arow(i * 32 + srow) + sch * 8; bp[i] = brow(i * 32 + srow) + sch * 8; }
#pragma unroll
    for (int mi = 0; mi < 2; ++mi)
#pragma unroll
        for (int ni = 0; ni < 2; ++ni)
#pragma unroll
            for (int r = 0; r < 16; ++r) acc[mi][ni][r] = 0.f;
    unsigned char* dst = lds + tid * 16;
    const int fr = lane & 31, fh = lane >> 5, g = (fr >> 1) & 7;
    const unsigned char* ra = lds + (wr * 64 + fr) * 128;
    const unsigned char* rb = lds + 16384 + (wc * 64 + fr) * 128;
#pragma unroll
    for (int i = 0; i < 4; ++i) { glds16(ap[i], dst + i * 4096); glds16(bp[i], dst + 16384 + i * 4096); }
    if (nk > 1) {
#pragma unroll
        for (int i = 0; i < 4; ++i) { glds16(ap[i] + 64, dst + 32768 + i * 4096); glds16(bp[i] + 64, dst + 32768 + 16384 + i * 4096); }
    }
    for (int kt = 0; kt < nk; ++kt) {
        const int cur = (kt & 1) * 32768;
        if (kt + 1 < nk) asm volatile("s_waitcnt vmcnt(8)" ::: "memory"); else asm volatile("s_waitcnt vmcnt(0)" ::: "memory");
        __builtin_amdgcn_s_barrier();
        asm volatile("" ::: "memory");
        bf16x8 af[4][2], bfr[4][2];
#pragma unroll
        for (int ks = 0; ks < 4; ++ks) {
            const int co = ((ks * 2 + fh) ^ g) << 4;
#pragma unroll
            for (int mi = 0; mi < 2; ++mi) af[ks][mi] = *(const bf16x8*)(ra + cur + mi * 4096 + co);
#pragma unroll
            for (int ni = 0; ni < 2; ++ni) bfr[ks][ni] = *(const bf16x8*)(rb + cur + ni * 4096 + co);
        }
        asm volatile("s_waitcnt lgkmcnt(0)" ::: "memory");
        __builtin_amdgcn_s_barrier();
        asm volatile("" ::: "memory");
        if (kt + 2 < nk) {
            const int ko = (kt + 2) * 64;
#pragma unroll
            for (int i = 0; i < 4; ++i) { glds16(ap[i] + ko, dst + cur + i * 4096); glds16(bp[i] + ko, dst + cur + 16384 + i * 4096); }
        }
#pragma unroll
        for (int ks = 0; ks < 4; ++ks)
#pragma unroll
            for (int mi = 0; mi < 2; ++mi)
#pragma unroll
                for (int ni = 0; ni < 2; ++ni) acc[mi][ni] = __builtin_amdgcn_mfma_f32_32x32x16_bf16(af[ks][mi], bfr[ks][ni], acc[mi][ni], 0, 0, 0);
    }
    __builtin_amdgcn_s_barrier();
    asm volatile("" ::: "memory");
}
template <bool FP8 = false, class Prep, class ARow, class BRow, class Epi>
DEV void gemm_stream(unsigned char* lds, int nk, int t0, int tstep, int tend, Prep prep, ARow arow, BRow brow, Epi epi) {
    const int tid = get_tid(), lane = tid & 63, wid = tid >> 6, wr = wid >> 1, wc = wid & 1;
    const int srow = tid >> 3, sch = (tid & 7) ^ ((tid >> 4) & 7);
    if (t0 >= tend) return;
    auto cx = prep(t0);
    auto nx = cx;
    const bf16_t* ap[4]; const bf16_t* bp[4];
#pragma unroll
    for (int i = 0; i < 4; ++i) { ap[i] = arow(cx, i * 32 + srow) + sch * 8; bp[i] = brow(cx, i * 32 + srow) + sch * 8; }
    unsigned char* dst = lds + tid * 16;
    const int fr = lane & 31, fh = lane >> 5, g = (fr >> 1) & 7;
    const unsigned char* ra = lds + (wr * 64 + fr) * 128;
    const unsigned char* rb = lds + 16384 + (wc * 64 + fr) * 128;
#pragma unroll
    for (int i = 0; i < 4; ++i) { glds16(ap[i], dst + i * 4096); glds16(bp[i], dst + 16384 + i * 4096); }
#pragma unroll
    for (int i = 0; i < 4; ++i) { glds16(ap[i] + 64, dst + 32768 + i * 4096); glds16(bp[i] + 64, dst + 32768 + 16384 + i * 4096); }
    for (int t = t0; t < tend; t += tstep) {
        const bool has_next = t + tstep < tend;
        f32x16 acc[2][2];
#pragma unroll
        for (int mi = 0; mi < 2; ++mi)
#pragma unroll
            for (int ni = 0; ni < 2; ++ni)
#pragma unroll
                for (int r = 0; r < 16; ++r) acc[mi][ni][r] = 0.f;
        for (int kt = 0; kt < nk; ++kt) {
            const int cur = (kt & 1) * 32768;
            if (kt + 1 < nk || has_next) asm volatile("s_waitcnt vmcnt(8)" ::: "memory"); else asm volatile("s_waitcnt vmcnt(0)" ::: "memory");
            __builtin_amdgcn_s_barrier();
            asm volatile("" ::: "memory");
            bf16x8 af[4][2], bfr[4][2];
            long a8[8][2], b8[8][2];
            if (!FP8) {
#pragma unroll
            for (int ks = 0; ks < 4; ++ks) {
                const int co = ((ks * 2 + fh) ^ g) << 4;
#pragma unroll
                for (int mi = 0; mi < 2; ++mi) af[ks][mi] = *(const bf16x8*)(ra + cur + mi * 4096 + co);
#pragma unroll
                for (int ni = 0; ni < 2; ++ni) bfr[ks][ni] = *(const bf16x8*)(rb + cur + ni * 4096 + co);
            }
            } else {
#pragma unroll
            for (int ks = 0; ks < 8; ++ks) {
                const int co = ((ks ^ g) << 4) + fh * 8;
#pragma unroll
                for (int mi = 0; mi < 2; ++mi) a8[ks][mi] = *(const long*)(ra + cur + mi * 4096 + co);
#pragma unroll
                for (int ni = 0; ni < 2; ++ni) b8[ks][ni] = *(const long*)(rb + cur + ni * 4096 + co);
            }
            }
            asm volatile("s_waitcnt lgkmcnt(0)" ::: "memory");
            __builtin_amdgcn_sched_barrier(0);
            __builtin_amdgcn_s_barrier();
            asm volatile("" ::: "memory");
            __builtin_amdgcn_sched_barrier(0);
            int ko = -1;
            if (kt + 2 < nk) ko = (kt + 2) * 64;
            else if (has_next) {
                if (kt + 2 == nk) {
                    nx = prep(t + tstep);
#pragma unroll
                    for (int i = 0; i < 4; ++i) { ap[i] = arow(nx, i * 32 + srow) + sch * 8; bp[i] = brow(nx, i * 32 + srow) + sch * 8; }
                }
                ko = (kt + 2 - nk) * 64;
            }
            if (FP8) {
#pragma unroll
                for (int ks = 0; ks < 8; ++ks) {
                    if (ko >= 0) { if (ks & 1) glds16(bp[ks >> 1] + ko, dst + cur + 16384 + (ks >> 1) * 4096); else glds16(ap[ks >> 1] + ko, dst + cur + (ks >> 1) * 4096); }
                    acc[0][0] = __builtin_amdgcn_mfma_f32_32x32x16_fp8_fp8(a8[ks][0], b8[ks][0], acc[0][0], 0, 0, 0);
                    acc[0][1] = __builtin_amdgcn_mfma_f32_32x32x16_fp8_fp8(a8[ks][0], b8[ks][1], acc[0][1], 0, 0, 0);
                    acc[1][0] = __builtin_amdgcn_mfma_f32_32x32x16_fp8_fp8(a8[ks][1], b8[ks][0], acc[1][0], 0, 0, 0);
                    acc[1][1] = __builtin_amdgcn_mfma_f32_32x32x16_fp8_fp8(a8[ks][1], b8[ks][1], acc[1][1], 0, 0, 0);
                    __builtin_amdgcn_sched_barrier(0);
                }
            } else
#pragma unroll
            for (int ks = 0; ks < 4; ++ks) {
                if (ko >= 0) { glds16(ap[ks] + ko, dst + cur + ks * 4096); }
                acc[0][0] = __builtin_amdgcn_mfma_f32_32x32x16_bf16(af[ks][0], bfr[ks][0], acc[0][0], 0, 0, 0);
                acc[0][1] = __builtin_amdgcn_mfma_f32_32x32x16_bf16(af[ks][0], bfr[ks][1], acc[0][1], 0, 0, 0);
                __builtin_amdgcn_sched_barrier(0);
                if (ko >= 0) { glds16(bp[ks] + ko, dst + cur + 16384 + ks * 4096); }
                acc[1][0] = __builtin_amdgcn_mfma_f32_32x32x16_bf16(af[ks][1], bfr[ks][0], acc[1][0], 0, 0, 0);
                acc[1][1] = __builtin_amdgcn_mfma_f32_32x32x16_bf16(af[ks][1], bfr[ks][1], acc[1][1], 0, 0, 0);
                __builtin_amdgcn_sched_barrier(0);
            }
        }
        epi(cx, acc);
        cx = nx;
    }
    __builtin_amdgcn_s_barrier();
    asm volatile("" ::: "memory");
}
DEV int vblock() { const int G = gridDim.x, bx = blockIdx.x; return (G % 8 == 0) ? (bx % 8) * (G / 8) + bx / 8 : bx; }
#define ACC_FOREACH(mi, ni, r, row, col) \
    _Pragma("unroll") for (int mi = 0; mi < 2; ++mi) _Pragma("unroll") for (int ni = 0; ni < 2; ++ni) _Pragma("unroll") for (int r = 0; r < 16; ++r) \
        for (int row = (tid >> 7) * 64 + mi * 32 + (r & 3) + 8 * (r >> 2) + 4 * ((tid & 63) >> 5), col = ((tid >> 6) & 1) * 64 + ni * 32 + (tid & 31), once_ = 1; once_; once_ = 0)

template <class ARow, class Epi>
DEV void gemm_naive_tile(float* lds, int K, ARow arow, const float* W, int ldw, int col0, int ncols, Epi epi) {
    const int tid = get_tid(), ty = tid >> 4, tx = tid & 15;
    float* sA = lds;
    float* sB = lds + 16 * 68;
    const int ar = tid >> 2, kq = (tid & 3) * 4;
    const bf16_t* ap = arow(ar);
    const int kr = tid >> 4, c4 = (tid & 15) * 4;
    const bool cok = (col0 + c4) < ncols;
    float acc[4][4];
#pragma unroll
    for (int i = 0; i < 4; ++i)
#pragma unroll
        for (int j = 0; j < 4; ++j) acc[i][j] = 0.f;
    for (int k0 = 0; k0 < K; k0 += 16) {
        const u32x2 av = *(const u32x2*)(ap + k0 + kq);
        f32x4 wv = {0.f, 0.f, 0.f, 0.f};
        if (cok) wv = *(const f32x4*)(W + (size_t)(k0 + kr) * ldw + col0 + c4);
        sA[(kq + 0) * 68 + ar] = __uint_as_float(av.x << 16);
        sA[(kq + 1) * 68 + ar] = __uint_as_float(av.x & 0xffff0000u);
        sA[(kq + 2) * 68 + ar] = __uint_as_float(av.y << 16);
        sA[(kq + 3) * 68 + ar] = __uint_as_float(av.y & 0xffff0000u);
        *(f32x4*)(sB + kr * 64 + c4) = wv;
        __syncthreads();
#pragma unroll 4
        for (int k = 0; k < 16; ++k) {
            const f32x4 a4 = *(const f32x4*)(sA + k * 68 + ty * 4), b4 = *(const f32x4*)(sB + k * 64 + tx * 4);
            const float aa[4] = {a4.x, a4.y, a4.z, a4.w}, bb[4] = {b4.x, b4.y, b4.z, b4.w};
#pragma unroll
            for (int i = 0; i < 4; ++i)
#pragma unroll
                for (int j = 0; j < 4; ++j) acc[i][j] += aa[i] * bb[j];
        }
        __syncthreads();
    }
#pragma unroll
    for (int i = 0; i < 4; ++i)
#pragma unroll
        for (int j = 0; j < 4; ++j) { const int col = col0 + tx * 4 + j; if (col < ncols) epi(ty * 4 + i, col, acc[i][j]); }
}

DEV void ph_inproj(const KArgs& a, int layer, unsigned char* lds) {
    const int tid = get_tid();
    const bf16_t* hn = (const bf16_t*)(a.ws + WS_HN);
    bf16_t* z = (bf16_t*)(a.ws + WS_Z);
    const bf16_t* WT = (const bf16_t*)(a.ws + WS_WINT) + (size_t)layer * DIN * D;
    constexpr int ntn = (DIN + 127) / 128, nlat = (TL / 128) * ntn, ncn = ntn - OFF_BK / 128;
    const int ntiles = layer == 0 ? (TA / 128) * ntn : nlat + (TC / 128) * ncn;
    struct Cx { int row0, col0; };
    auto prep = [&](int t) { Cx c;
        if (layer == 0 || t < nlat) { c.row0 = (t / ntn) * 128; c.col0 = (t % ntn) * 128; }
        else { const int u = t - nlat; c.row0 = TL + (u / ncn) * 128; c.col0 = OFF_BK + (u % ncn) * 128; }
        return c; };
    gemm_stream(lds, D / 64, vblock(), gridDim.x, ntiles, prep,
        [&](const Cx& c, int r) { int n = c.col0 + r; n = n < DIN ? n : DIN - 1; return WT + (size_t)n * D; },
        [&](const Cx& c, int r) { return hn + (size_t)(c.row0 + r) * D; },
        [&](const Cx& c, const f32x16 (&acc)[2][2]) {
            const int row0 = c.row0, col0 = c.col0;
            const int wr = tid >> 7, wc = (tid >> 6) & 1, lane = tid & 63;
#pragma unroll
            for (int ni = 0; ni < 2; ++ni) {
                bf16_t* zr = z + (size_t)(row0 + wc * 64 + ni * 32 + (lane & 31)) * DIN + col0;
#pragma unroll
                for (int mi = 0; mi < 2; ++mi)
#pragma unroll
                    for (int kp = 0; kp < 2; ++kp) {
                        u32x2 wa, wb;
                        wa.x = pk2(acc[mi][ni][8 * kp], acc[mi][ni][8 * kp + 1]); wa.y = pk2(acc[mi][ni][8 * kp + 2], acc[mi][ni][8 * kp + 3]);
                        wb.x = pk2(acc[mi][ni][8 * kp + 4], acc[mi][ni][8 * kp + 5]); wb.y = pk2(acc[mi][ni][8 * kp + 6], acc[mi][ni][8 * kp + 7]);
                        const u32x4 w = widen_pair(wa, wb);
                        const int n = wr * 64 + mi * 32 + 16 * kp + 8 * (lane >> 5);
                        if (col0 + n < DIN) *(u32x4*)(zr + n) = w;
                    }
            }
        });
}

DEV void ph_outproj(const KArgs& a, int layer, int nrows, unsigned char* lds) {
    const int tid = get_tid();
    const bf16_t* mix = (const bf16_t*)(a.ws + WS_MIX);
    float* hws = (float*)(a.ws + WS_H);
    const float* mod = (const float*)(a.ws + WS_MOD);
    const bf16_t* WT = (const bf16_t*)(a.ws + WS_WOUTT) + (size_t)layer * D * D;
    constexpr int ntn = D / 128;
    gemm_stream(lds, D / 64, vblock(), gridDim.x, (nrows / 128) * ntn, [](int t) { return t; },
        [&](int t, int r) { return mix + (size_t)((t / ntn) * 128 + r) * D; },
        [&](int t, int r) { return WT + (size_t)((t % ntn) * 128 + r) * D; },
        [&](int t, const f32x16 (&acc)[2][2]) {
            const int row0 = (t / ntn) * 128, col0 = (t % ntn) * 128;
            const int bi = mod_index(row0);
            const float* g1 = mod + (size_t)(layer * 17 + bi) * 6144 + 2 * D + col0;
            const int wr = tid >> 7, wc = (tid >> 6) & 1, lane = tid & 63;
            const float g1a = g1[wc * 64 + (lane & 31)], g1b = g1[wc * 64 + 32 + (lane & 31)];
            const float* resb = (layer == 0 ? (row0 < TL ? a.in[I_X] + (size_t)row0 * D : a.in[I_CTX] + (size_t)(row0 - TL) * D) : hws + (size_t)row0 * D) + col0 + wc * 64 + (lane & 31);
            float* outb = hws + (size_t)row0 * D + col0 + wc * 64 + (lane & 31);
            float resc[8], resn[8];
#define OP_RO(b) ((size_t)(wr * 64 + ((b) >> 2) * 32 + 16 * ((b) & 1) + 4 * (lane >> 5)) * D + (((b) >> 1) & 1) * 32)
#pragma unroll
            for (int r = 0; r < 8; ++r) resc[r] = __builtin_nontemporal_load(resb + OP_RO(0) + (size_t)((r & 3) + 8 * (r >> 2)) * D);
#pragma unroll
            for (int b = 0; b < 8; ++b) {
                const int mi = b >> 2, ni = (b >> 1) & 1, hq = b & 1;
                if (b + 1 < 8) {
#pragma unroll
                    for (int r = 0; r < 8; ++r) resn[r] = __builtin_nontemporal_load(resb + OP_RO(b + 1) + (size_t)((r & 3) + 8 * (r >> 2)) * D);
                }
                asm volatile("" ::: "memory");
#pragma unroll
                for (int r = 0; r < 8; ++r) outb[OP_RO(b) + (size_t)((r & 3) + 8 * (r >> 2)) * D] = resc[r] + (ni ? g1b : g1a) * acc[mi][ni][8 * hq + r];
                asm volatile("" ::: "memory");
#pragma unroll
                for (int r = 0; r < 8; ++r) resc[r] = resn[r];
            }
#undef OP_RO
        });
}

DEV bf16x8 tr_frag_at(unsigned base, int RS, int c, int ks, int lane);
DEV void unpack8(const u32x4 v, float* f);
DEV void ph_spatial(const KArgs& a, int layer, int nrows, unsigned char* lds) {
    const int tid = get_tid(), lane = tid & 63, wid = tid >> 6, wr = wid >> 1, wc = wid & 1, fr = lane & 31, fh = lane >> 5;
    const bf16_t* z = (const bf16_t*)(a.ws + WS_Z);
    bf16_t* mix = (bf16_t*)(a.ws + WS_MIX);
    unsigned char* vs = lds;
    const unsigned vs_a = (unsigned)(size_t)vs;
    const int nitems = (nrows / 128) * 4;
    for (int item = vblock(); item < nitems; item += gridDim.x) {
        const int ci = item >> 2, g = item & 3, row0 = ci * 128;
        const int l8 = tid & 7, tk = tid >> 3;
        float lgv[16], lbv[16];
#pragma unroll
        for (int j = 0; j < 4; ++j) {
            const f32x4 g4 = *(const f32x4*)(a.in[I_LNG] + layer * 512 + g * 128 + l8 * 16 + 4 * j), b4 = *(const f32x4*)(a.in[I_LNB] + layer * 512 + g * 128 + l8 * 16 + 4 * j);
            lgv[4 * j] = g4.x; lgv[4 * j + 1] = g4.y; lgv[4 * j + 2] = g4.z; lgv[4 * j + 3] = g4.w; lbv[4 * j] = b4.x; lbv[4 * j + 1] = b4.y; lbv[4 * j + 2] = b4.z; lbv[4 * j + 3] = b4.w;
        }
#pragma unroll 2
        for (int pass = 0; pass < 4; ++pass) {
            const int tok = pass * 32 + tk;
            const bf16_t* zp = z + (size_t)(row0 + tok) * DIN + OFF_AV + g * 128 + l8 * 16;
            float x[16];
            unpack8(*(const u32x4*)zp, x); unpack8(*(const u32x4*)(zp + 8), x + 8);
            float sm = 0.f;
#pragma unroll
            for (int j = 0; j < 16; ++j) { x[j] = gelu_f(x[j]); sm += x[j]; }
            sm += __shfl_xor(sm, 1); sm += __shfl_xor(sm, 2); sm += __shfl_xor(sm, 4);
            const float mu = sm * (1.f / 128.f);
            float q = 0.f;
#pragma unroll
            for (int j = 0; j < 16; ++j) { x[j] -= mu; q += x[j] * x[j]; }
            q += __shfl_xor(q, 1); q += __shfl_xor(q, 2); q += __shfl_xor(q, 4);
            const float rs = rsqrtf(q * (1.f / 128.f) + EPS);
            u32x4 w0, w1;
            w0.x = pk2(x[0] * rs * lgv[0] + lbv[0], x[1] * rs * lgv[1] + lbv[1]); w0.y = pk2(x[2] * rs * lgv[2] + lbv[2], x[3] * rs * lgv[3] + lbv[3]);
            w0.z = pk2(x[4] * rs * lgv[4] + lbv[4], x[5] * rs * lgv[5] + lbv[5]); w0.w = pk2(x[6] * rs * lgv[6] + lbv[6], x[7] * rs * lgv[7] + lbv[7]);
            w1.x = pk2(x[8] * rs * lgv[8] + lbv[8], x[9] * rs * lgv[9] + lbv[9]); w1.y = pk2(x[10] * rs * lgv[10] + lbv[10], x[11] * rs * lgv[11] + lbv[11]);
            w1.z = pk2(x[12] * rs * lgv[12] + lbv[12], x[13] * rs * lgv[13] + lbv[13]); w1.w = pk2(x[14] * rs * lgv[14] + lbv[14], x[15] * rs * lgv[15] + lbv[15]);
            *(u32x4*)(vs + tok * 320 + l8 * 32) = w0; *(u32x4*)(vs + tok * 320 + l8 * 32 + 16) = w1;
        }
        __syncthreads();
        const bf16_t* wsp = (const bf16_t*)(a.ws + WS_WSP) + (size_t)(layer * 4 + g) * 128 * 128;
        f32x16 acc[2][2];
#pragma unroll
        for (int mi = 0; mi < 2; ++mi)
#pragma unroll
            for (int ni = 0; ni < 2; ++ni)
#pragma unroll
                for (int r = 0; r < 16; ++r) acc[mi][ni][r] = 0.f;
#pragma unroll 2
        for (int ks = 0; ks < 8; ++ks) {
            bf16x8 af[2], bfr[2];
#pragma unroll
            for (int mi = 0; mi < 2; ++mi) af[mi] = *(const bf16x8*)(wsp + (wr * 64 + mi * 32 + fr) * 128 + ks * 16 + fh * 8);
#pragma unroll
            for (int ni = 0; ni < 2; ++ni) bfr[ni] = tr_frag_at(vs_a, 320, wc * 2 + ni, ks, lane);
#pragma unroll
            for (int mi = 0; mi < 2; ++mi)
#pragma unroll
                for (int ni = 0; ni < 2; ++ni) acc[mi][ni] = __builtin_amdgcn_mfma_f32_32x32x16_bf16(af[mi], bfr[ni], acc[mi][ni], 0, 0, 0);
        }
        __syncthreads();
        ACC_FOREACH(mi, ni, r, row, col) { *(bf16_t*)(vs + row * 272 + col * 2) = f2bf(acc[mi][ni][r]); }
        __syncthreads();
        {
            const int p = tid >> 1, c0 = (tid & 1) * 64;
            const float bs = a.in[I_BSP][(layer * 4 + g) * 128 + p];
            const bf16_t* zu = z + (size_t)(row0 + p) * DIN + OFF_AU + g * 128 + c0;
            bf16_t* mo = mix + (size_t)(row0 + p) * D + g * 128 + c0;
            u32x4 zuv[8];
#pragma unroll
            for (int j = 0; j < 8; ++j) zuv[j] = *(const u32x4*)(zu + 8 * j);
#pragma unroll 2
            for (int j = 0; j < 8; ++j) {
                float uf[8], sf[8];
                unpack8(zuv[j], uf); unpack8(*(const u32x4*)(vs + p * 272 + (c0 + 8 * j) * 2), sf);
                u32x4 w;
                w.x = pk2(gelu_f(uf[0]) * (sf[0] + bs), gelu_f(uf[1]) * (sf[1] + bs)); w.y = pk2(gelu_f(uf[2]) * (sf[2] + bs), gelu_f(uf[3]) * (sf[3] + bs));
                w.z = pk2(gelu_f(uf[4]) * (sf[4] + bs), gelu_f(uf[5]) * (sf[5] + bs)); w.w = pk2(gelu_f(uf[6]) * (sf[6] + bs), gelu_f(uf[7]) * (sf[7] + bs));
                *(u32x4*)(mo + 8 * j) = w;
            }
        }
        __syncthreads();
    }
}

constexpr int GLA_LA_STRIDE = 65, GLA_VT_RS = 320, GLA_KD_RS = 192, GLA_QK_RS = 144;
constexpr int GLA_OFF_LA = 0, GLA_OFF_QE = 16896, GLA_OFF_KE = 16896 + 9216, GLA_OFF_VT = 16896 + 2 * 9216, GLA_OFF_WU = GLA_OFF_VT + 64 * GLA_VT_RS, GLA_OFF_TOT = GLA_OFF_WU + 2 * 4352, GLA_OFF_END = GLA_OFF_TOT + 1280;
static_assert(64 * GLA_LA_STRIDE * 4 <= GLA_OFF_QE && GLA_OFF_END <= 65536 + 768 && 64 * 132 * 4 <= GLA_OFF_VT && 64 * GLA_KD_RS <= 2 * 9216, "GLA LDS map");
DEV void gla_chunk_coords(int ci, int& row0, int& b, int& slot) {
    if (ci < 512) { row0 = ci * 64; b = ci >> 5; slot = 4 + (ci & 31); } else { const int c = ci - 512; row0 = TL + c * 64; b = c >> 2; slot = c & 3; }
}
DEV bf16x8 tr_frag(unsigned a0, unsigned a1) {
    u32x2 lo, hi;
    asm volatile("ds_read_b64_tr_b16 %0, %2\n\tds_read_b64_tr_b16 %1, %3\n\ts_waitcnt lgkmcnt(0)" : "=&v"(lo), "=&v"(hi) : "v"(a0), "v"(a1) : "memory");
    u32x4 w; w.x = lo.x; w.y = lo.y; w.z = hi.x; w.w = hi.y;
    return __builtin_bit_cast(bf16x8, w);
}
DEV bf16x8 tr_frag_at(unsigned base, int RS, int c, int ks, int lane) {
    const int h = lane >> 5, blk = (lane >> 4) & 1, q = (lane & 15) >> 2, p = lane & 3;
    const unsigned a0 = base + (unsigned)((16 * ks + 8 * h + q) * RS + (32 * c + 16 * blk + 4 * p) * 2);
    return tr_frag(a0, a0 + 4u * (unsigned)RS);
}
DEV void unpack8(const u32x4 v, float* f) {
    f[0] = __uint_as_float(v.x << 16); f[1] = __uint_as_float(v.x & 0xffff0000u); f[2] = __uint_as_float(v.y << 16); f[3] = __uint_as_float(v.y & 0xffff0000u);
    f[4] = __uint_as_float(v.z << 16); f[5] = __uint_as_float(v.z & 0xffff0000u); f[6] = __uint_as_float(v.w << 16); f[7] = __uint_as_float(v.w & 0xffff0000u);
}
DEV void gla_stage_gate(const KArgs& a, int layer, int dir, int h, float* swu, int tid) {
    bf16_t* hi = (bf16_t*)swu; bf16_t* lo = hi + 1024; float* bias = swu + 1024;
    for (int i = tid; i < 16 * 64; i += 256) {
        const int k = i >> 6, d = i & 63;
        const float w = a.in[I_WGU][((size_t)(layer * 2 + dir) * 16 + k) * 256 + h * 64 + d];
        const bf16_t wh = f2bf(w);
        hi[d * 16 + k] = wh; lo[d * 16 + k] = f2bf(w - bf2f(wh));
    }
    if (tid < 64) bias[tid] = a.in[I_BG][(layer * 2 + dir) * 256 + h * 64 + tid];
}
DEV void gla_logdecay(const bf16x8 zfrag, const float* swu, float* la, int tid) {
    const int lane = tid & 63, wid = tid >> 6, fr = lane & 31, fh = lane >> 5, dt = (wid & 1) * 32, tt = (wid >> 1) * 32;
    const bf16_t* hi = (const bf16_t*)swu; const bf16_t* lo = hi + 1024; const float* bias = swu + 1024;
    const bf16x8 bh = *(const bf16x8*)(hi + (dt + fr) * 16 + fh * 8), bl = *(const bf16x8*)(lo + (dt + fr) * 16 + fh * 8);
    f32x16 acc;
#pragma unroll
    for (int r = 0; r < 16; ++r) acc[r] = 0.f;
    acc = __builtin_amdgcn_mfma_f32_32x32x16_bf16(zfrag, bl, acc, 0, 0, 0);
    acc = __builtin_amdgcn_mfma_f32_32x32x16_bf16(zfrag, bh, acc, 0, 0, 0);
    const float bb = bias[dt + fr];
#pragma unroll
    for (int r = 0; r < 16; ++r) la[(tt + (r & 3) + 8 * (r >> 2) + 4 * fh) * GLA_LA_STRIDE + dt + fr] = logsigmoid_f(acc[r] + bb) * (1.f / 16.f);
}
DEV void gla_cumsum(float* la, float* tot, int dir, int tid) {
    const int d = tid & 63, sg = tid >> 6;
    float v[16];
#pragma unroll
    for (int t = 0; t < 16; ++t) v[t] = la[(sg * 16 + t) * GLA_LA_STRIDE + d];
    if (dir == 0) {
#pragma unroll
        for (int t = 1; t < 16; ++t) v[t] += v[t - 1];
        tot[sg * 64 + d] = v[15];
    } else {
#pragma unroll
        for (int t = 14; t >= 0; --t) v[t] += v[t + 1];
        tot[sg * 64 + d] = v[0];
    }
    __syncthreads();
    const float t0 = tot[d], t1 = tot[64 + d], t2 = tot[128 + d], t3 = tot[192 + d];
    float off;
    if (dir == 0) off = (sg > 0 ? t0 : 0.f) + (sg > 1 ? t1 : 0.f) + (sg > 2 ? t2 : 0.f);
    else off = (sg < 3 ? t3 : 0.f) + (sg < 2 ? t2 : 0.f) + (sg < 1 ? t1 : 0.f);
    if (sg == 0) tot[256 + d] = (t0 + t1) + (t2 + t3);
#pragma unroll
    for (int t = 0; t < 16; ++t) la[(sg * 16 + t) * GLA_LA_STRIDE + d] = v[t] + off;
    __syncthreads();
}
DEV void gla_store_v(const u32x4 (&vr)[4], unsigned char* vt, int tid) {
    const int i = tid >> 2, e0 = (tid & 3) * 32;
#pragma unroll
    for (int j = 0; j < 4; ++j) *(u32x4*)(vt + i * GLA_VT_RS + (e0 + 8 * j) * 2) = vr[j];
}

DEV void ph_gla_kv(const KArgs& a, int layer, unsigned char* lds) {
    const int tid = get_tid(), lane = tid & 63, wid = tid >> 6;
    const bf16_t* z = (const bf16_t*)(a.ws + WS_Z);
    bf16_t* kvo = (bf16_t*)(a.ws + WS_KV);
    float* dco = (float*)(a.ws + WS_DECAY);
    float* la = (float*)(lds + GLA_OFF_LA); unsigned char* kdt = lds + GLA_OFF_QE; unsigned char* vt = lds + GLA_OFF_VT;
    float* swu = (float*)(lds + GLA_OFF_WU); float* tot = (float*)(lds + GLA_OFF_TOT);
    const unsigned vt_a = (unsigned)(size_t)vt, kd_a = (unsigned)(size_t)kdt;
    const int vb = vblock(), h = vb & 3;
    gla_stage_gate(a, layer, 0, h, swu, tid); gla_stage_gate(a, layer, 1, h, swu + 1088, tid);
    __syncthreads();
    const int i = tid >> 2, d0 = (tid & 3) * 16, e0 = (tid & 3) * 32;
    for (int item = vb; item < 576 * 4; item += gridDim.x) {
        const int ci = item >> 2;
        int row0, b, slot; gla_chunk_coords(ci, row0, b, slot);
        const bf16_t* zr = z + (size_t)(row0 + i) * DIN;
        const bf16_t* zgp = z + (size_t)(row0 + (wid >> 1) * 32 + (lane & 31)) * DIN + OFF_BG + (lane >> 5) * 8;
        const bf16x8 zf0 = *(const bf16x8*)zgp, zf1 = *(const bf16x8*)(zgp + 16);
        const u32x4 kr0 = *(const u32x4*)(zr + OFF_BK + h * 64 + d0), kr1 = *(const u32x4*)(zr + OFF_BK + h * 64 + d0 + 8);
        u32x4 vr[4];
#pragma unroll
        for (int j = 0; j < 4; ++j) vr[j] = *(const u32x4*)(zr + OFF_BV + h * 128 + e0 + 8 * j);
        gla_store_v(vr, vt, tid);
#pragma unroll 1
        for (int dir = 0; dir < 2; ++dir) {
            gla_logdecay(dir ? zf1 : zf0, swu + dir * 1088, la, tid);
            __syncthreads();
            gla_cumsum(la, tot, dir, tid);
            const size_t tile = (size_t)(((dir * NB + b) * 4 + h) * 36 + slot);
            {
                float kf[16];
                unpack8(kr0, kf); unpack8(kr1, kf + 8);
#pragma unroll
                for (int dd = 0; dd < 16; ++dd) kf[dd] *= __expf(tot[256 + d0 + dd] - la[i * GLA_LA_STRIDE + d0 + dd]);
                u32x4 w0, w1;
                w0.x = pk2(kf[0], kf[1]); w0.y = pk2(kf[2], kf[3]); w0.z = pk2(kf[4], kf[5]); w0.w = pk2(kf[6], kf[7]);
                w1.x = pk2(kf[8], kf[9]); w1.y = pk2(kf[10], kf[11]); w1.z = pk2(kf[12], kf[13]); w1.w = pk2(kf[14], kf[15]);
                *(u32x4*)(kdt + i * GLA_KD_RS + d0 * 2) = w0; *(u32x4*)(kdt + i * GLA_KD_RS + d0 * 2 + 16) = w1;
                if (tid < 64) dco[tile * 64 + tid] = __expf(tot[256 + tid]);
            }
            __syncthreads();
            f32x16 acc[2];
#pragma unroll
            for (int nt = 0; nt < 2; ++nt)
#pragma unroll
                for (int r = 0; r < 16; ++r) acc[nt][r] = 0.f;
#pragma unroll
            for (int ks = 0; ks < 4; ++ks) {
                const bf16x8 af = tr_frag_at(vt_a, GLA_VT_RS, wid, ks, lane);
#pragma unroll
                for (int nt = 0; nt < 2; ++nt) { const bf16x8 bfr = tr_frag_at(kd_a, GLA_KD_RS, nt, ks, lane); acc[nt] = __builtin_amdgcn_mfma_f32_32x32x16_bf16(af, bfr, acc[nt], 0, 0, 0); }
            }
            bf16_t* out = kvo + tile * 8192;
#pragma unroll
            for (int nt = 0; nt < 2; ++nt)
#pragma unroll
                for (int r = 0; r < 16; ++r) { const int e = wid * 32 + (r & 3) + 8 * (r >> 2) + 4 * (lane >> 5); out[e * 64 + nt * 32 + (lane & 31)] = f2bf(acc[nt][r]); }
            __syncthreads();
        }
    }
}

DEV void ph_gla_scan(const KArgs& a) {
    const int tid = get_tid();
    const bf16_t* kv = (const bf16_t*)(a.ws + WS_KV);
    const float* dc = (const float*)(a.ws + WS_DECAY);
    bf16_t* sp = (bf16_t*)(a.ws + WS_HN);
    for (int item = blockIdx.x; item < 2 * NB * 4 * 8; item += gridDim.x) {
        const int dbh = item >> 3, sub = item & 7, dir = dbh >> 6;
        const int e = sub * 16 + (tid >> 4), dq = (tid & 15) * 4;
        f32x4 S = {0.f, 0.f, 0.f, 0.f};
#pragma unroll 4
        for (int step = 0; step < 36; ++step) {
            const int slot = dir == 0 ? step : (step < 4 ? 3 - step : 39 - step);
            const size_t tile = (size_t)dbh * 36 + slot;
            const u32x2 kvr = __builtin_nontemporal_load((const u32x2*)(kv + tile * 8192 + e * 64 + dq)); const f32x4 dcv = *(const f32x4*)(dc + tile * 64 + dq);
            const f32x4 kvv = {__uint_as_float(kvr.x << 16), __uint_as_float(kvr.x & 0xffff0000u), __uint_as_float(kvr.y << 16), __uint_as_float(kvr.y & 0xffff0000u)};
            u32x2 w; w.x = pk2(S.x, S.y); w.y = pk2(S.z, S.w);
            *(u32x2*)(sp + tile * 8192 + e * 64 + dq) = w;
            S = dcv * S + kvv;
        }
    }
}

DEV void ph_gla_out(const KArgs& a, int layer, unsigned char* lds) {
    const int tid = get_tid(), lane = tid & 63, wid = tid >> 6, ih = wid >> 1, eh = wid & 1, fr = lane & 31, fh = lane >> 5;
    const bf16_t* z = (const bf16_t*)(a.ws + WS_Z);
    const bf16_t* sp = (const bf16_t*)(a.ws + WS_HN);
    bf16_t* mix = (bf16_t*)(a.ws + WS_MIX);
    float* la = (float*)(lds + GLA_OFF_LA); unsigned char* att = lds + GLA_OFF_LA; unsigned char* qet = lds + GLA_OFF_QE; unsigned char* ket = lds + GLA_OFF_KE; unsigned char* vt = lds + GLA_OFF_VT;
    float* swu = (float*)(lds + GLA_OFF_WU); float* tot = (float*)(lds + GLA_OFF_TOT); float* ob = (float*)lds;
    const unsigned vt_a = (unsigned)(size_t)vt;
    const int nchunks = layer == 0 ? 576 : 512;
    const int vb = vblock(), h = vb & 3;
    gla_stage_gate(a, layer, 0, h, swu, tid); gla_stage_gate(a, layer, 1, h, swu + 1088, tid);
    __syncthreads();
    const int i = tid >> 2, d0 = (tid & 3) * 16, e0 = (tid & 3) * 32;
    for (int item = vb; item < nchunks * 4; item += gridDim.x) {
        const int ci = item >> 2;
        int row0, b, slot; gla_chunk_coords(ci, row0, b, slot);
        const bf16_t* zr = z + (size_t)(row0 + i) * DIN;
        const bf16_t* zgp = z + (size_t)(row0 + (wid >> 1) * 32 + (lane & 31)) * DIN + OFF_BG + (lane >> 5) * 8;
        const bf16x8 zf0 = *(const bf16x8*)zgp, zf1 = *(const bf16x8*)(zgp + 16);
        const u32x4 qr0 = *(const u32x4*)(zr + OFF_BQ + h * 64 + d0), qr1 = *(const u32x4*)(zr + OFF_BQ + h * 64 + d0 + 8);
        const u32x4 kr0 = *(const u32x4*)(zr + OFF_BK + h * 64 + d0), kr1 = *(const u32x4*)(zr + OFF_BK + h * 64 + d0 + 8);
        u32x4 vr[4], rr4[4];
#pragma unroll
        for (int j = 0; j < 4; ++j) vr[j] = *(const u32x4*)(zr + OFF_BV + h * 128 + e0 + 8 * j);
#pragma unroll
        for (int j = 0; j < 4; ++j) rr4[j] = *(const u32x4*)(zr + OFF_BR + h * 128 + e0 + 8 * j);
        gla_store_v(vr, vt, tid);
        f32x16 acc[2];
#pragma unroll
        for (int nt = 0; nt < 2; ++nt)
#pragma unroll
            for (int r = 0; r < 16; ++r) acc[nt][r] = 0.f;
#pragma unroll 1
        for (int dir = 0; dir < 2; ++dir) {
            gla_logdecay(dir ? zf1 : zf0, swu + dir * 1088, la, tid);
            __syncthreads();
            gla_cumsum(la, tot, dir, tid);
            {
                float qf[16], kf[16];
                unpack8(qr0, qf); unpack8(qr1, qf + 8); unpack8(kr0, kf); unpack8(kr1, kf + 8);
#pragma unroll
                for (int dd = 0; dd < 16; ++dd) { const float bb = la[i * GLA_LA_STRIDE + d0 + dd]; qf[dd] *= 0.125f * __expf(bb); kf[dd] *= __expf(-bb); }
                u32x4 w0, w1;
                w0.x = pk2(qf[0], qf[1]); w0.y = pk2(qf[2], qf[3]); w0.z = pk2(qf[4], qf[5]); w0.w = pk2(qf[6], qf[7]);
                w1.x = pk2(qf[8], qf[9]); w1.y = pk2(qf[10], qf[11]); w1.z = pk2(qf[12], qf[13]); w1.w = pk2(qf[14], qf[15]);
                *(u32x4*)(qet + i * GLA_QK_RS + d0 * 2) = w0; *(u32x4*)(qet + i * GLA_QK_RS + d0 * 2 + 16) = w1;
                w0.x = pk2(kf[0], kf[1]); w0.y = pk2(kf[2], kf[3]); w0.z = pk2(kf[4], kf[5]); w0.w = pk2(kf[6], kf[7]);
                w1.x = pk2(kf[8], kf[9]); w1.y = pk2(kf[10], kf[11]); w1.z = pk2(kf[12], kf[13]); w1.w = pk2(kf[14], kf[15]);
                *(u32x4*)(ket + i * GLA_QK_RS + d0 * 2) = w0; *(u32x4*)(ket + i * GLA_QK_RS + d0 * 2 + 16) = w1;
            }
            const bf16_t* st = sp + (size_t)(((dir * NB + b) * 4 + h) * 36 + slot) * 8192;
            bf16x8 bs[4][2];
#pragma unroll
            for (int ks = 0; ks < 4; ++ks)
#pragma unroll
                for (int nt = 0; nt < 2; ++nt) bs[ks][nt] = *(const bf16x8*)(st + (eh * 64 + nt * 32 + fr) * 64 + ks * 16 + fh * 8);
            __syncthreads();
            bf16x8 aq[4];
#pragma unroll
            for (int ks = 0; ks < 4; ++ks) aq[ks] = *(const bf16x8*)(qet + (ih * 32 + fr) * GLA_QK_RS + (ks * 16 + fh * 8) * 2);
            {
                f32x16 sa;
#pragma unroll
                for (int r = 0; r < 16; ++r) sa[r] = 0.f;
#pragma unroll
                for (int ks = 0; ks < 4; ++ks) { const bf16x8 bk = *(const bf16x8*)(ket + (eh * 32 + fr) * GLA_QK_RS + (ks * 16 + fh * 8) * 2); sa = __builtin_amdgcn_mfma_f32_32x32x16_bf16(aq[ks], bk, sa, 0, 0, 0); }
                const int j = eh * 32 + fr;
#pragma unroll
                for (int r = 0; r < 16; ++r) {
                    const int ii = ih * 32 + (r & 3) + 8 * (r >> 2) + 4 * fh;
                    const bool keep = dir == 0 ? (j <= ii) : (j >= ii);
                    *(bf16_t*)(att + ii * GLA_QK_RS + j * 2) = f2bf(keep ? sa[r] : 0.f);
                }
            }
            __syncthreads();
#pragma unroll
            for (int ks = 0; ks < 4; ++ks) {
                const bf16x8 aa = *(const bf16x8*)(att + (ih * 32 + fr) * GLA_QK_RS + (ks * 16 + fh * 8) * 2);
#pragma unroll
                for (int nt = 0; nt < 2; ++nt) {
                    const bf16x8 bv = tr_frag_at(vt_a, GLA_VT_RS, eh * 2 + nt, ks, lane);
                    acc[nt] = __builtin_amdgcn_mfma_f32_32x32x16_bf16(aa, bv, acc[nt], 0, 0, 0);
                    acc[nt] = __builtin_amdgcn_mfma_f32_32x32x16_bf16(aq[ks], bs[ks][nt], acc[nt], 0, 0, 0);
                }
            }
            __syncthreads();
        }
#pragma unroll
        for (int nt = 0; nt < 2; ++nt)
#pragma unroll
            for (int r = 0; r < 16; ++r) ob[(ih * 32 + (r & 3) + 8 * (r >> 2) + 4 * fh) * 132 + eh * 64 + nt * 32 + fr] = acc[nt][r];
        __syncthreads();
        {
            float o[32]; float ss = 0.f;
#pragma unroll
            for (int j = 0; j < 8; ++j) { const f32x4 v = *(const f32x4*)(ob + i * 132 + e0 + 4 * j); o[4 * j] = v.x; o[4 * j + 1] = v.y; o[4 * j + 2] = v.z; o[4 * j + 3] = v.w; ss += v.x * v.x + v.y * v.y + v.z * v.z + v.w * v.w; }
            ss += __shfl_xor(ss, 1); ss += __shfl_xor(ss, 2);
            const float rstd = rsqrtf(ss * (1.f / 128.f) + EPS);
            const float* gg = a.in[I_GGLA] + layer * 512 + h * 128 + e0;
            bf16_t* mo = mix + (size_t)(row0 + i) * D + 512 + h * 128 + e0;
#pragma unroll
            for (int j = 0; j < 4; ++j) {
                float rf[8]; unpack8(rr4[j], rf);
                const f32x4 g0 = *(const f32x4*)(gg + 8 * j), g1 = *(const f32x4*)(gg + 8 * j + 4);
                u32x4 w;
                w.x = pk2(o[8 * j + 0] * rstd * g0.x * silu_f(rf[0]), o[8 * j + 1] * rstd * g0.y * silu_f(rf[1]));
                w.y = pk2(o[8 * j + 2] * rstd * g0.z * silu_f(rf[2]), o[8 * j + 3] * rstd * g0.w * silu_f(rf[3]));
                w.z = pk2(o[8 * j + 4] * rstd * g1.x * silu_f(rf[4]), o[8 * j + 5] * rstd * g1.y * silu_f(rf[5]));
                w.w = pk2(o[8 * j + 6] * rstd * g1.z * silu_f(rf[6]), o[8 * j + 7] * rstd * g1.w * silu_f(rf[7]));
                *(u32x4*)(mo + 8 * j) = w;
            }
        }
        __syncthreads();
    }
}

DEV void ph_router(const KArgs& a, int layer, int nrows, unsigned char* lds) {
    const int tid = get_tid();
    const bf16_t* hn = (const bf16_t*)(a.ws + WS_HN);
    const bf16_t* WT = (const bf16_t*)(a.ws + WS_WRT) + (size_t)layer * 128 * D;
    unsigned* cnt = (unsigned*)(a.ws + WS_CTL) + layer * NE;
    unsigned* list = (unsigned*)(a.ws + WS_LIST);
    float* gate = (float*)(a.ws + WS_GATE);
    float* lgs = (float*)lds;
    for (int t = vblock(); t < nrows / 128; t += gridDim.x) {
        const int row0 = t * 128;
        f32x16 acc[2][2];
        gemm_core(lds, D / 64, [&](int r) { return hn + (size_t)(row0 + r) * D; }, [&](int r) { return WT + (size_t)r * D; }, acc);
        ACC_FOREACH(mi, ni, r, row, col) { if (col < 72) lgs[row * 73 + col] = acc[mi][ni][r]; }
        __syncthreads();
        if (tid < 128) {
            const float* lr = lgs + tid * 73; const int r = row0 + tid;
            float lg[8];
#pragma unroll
            for (int j = 0; j < 8; ++j) lg[j] = lr[j] + a.in[I_BRG][layer * 8 + j];
            float m = lg[0]; int gi = 0;
#pragma unroll
            for (int j = 1; j < 8; ++j) if (lg[j] > m) { m = lg[j]; gi = j; }
            float sum = 0.f;
#pragma unroll
            for (int j = 0; j < 8; ++j) sum += __expf(lg[j] - m);
            const float ptop = 1.f / sum;
            float le[8];
#pragma unroll
            for (int j = 0; j < 8; ++j) le[j] = lr[8 + gi * 8 + j] + a.in[I_BRE][layer * 64 + gi * 8 + j];
            float l1 = le[0]; int i1 = 0;
#pragma unroll
            for (int j = 1; j < 8; ++j) if (le[j] > l1) { l1 = le[j]; i1 = j; }
            float l2 = -3.0e38f; int i2 = 0;
#pragma unroll
            for (int j = 0; j < 8; ++j) if (j != i1 && le[j] > l2) { l2 = le[j]; i2 = j; }
            const float e2 = __expf(l2 - l1), w1 = 1.f / (1.f + e2), w2 = e2 / (1.f + e2);
            const int ex1 = gi * 8 + i1, ex2 = gi * 8 + i2;
            const unsigned p1 = atomicAdd(cnt + ex1, 1u), p2 = atomicAdd(cnt + ex2, 1u);
            list[(size_t)ex1 * LCAP + p1] = (unsigned)(2 * r); list[(size_t)ex2 * LCAP + p2] = (unsigned)(2 * r + 1);
            gate[2 * r] = ptop * w1; gate[2 * r + 1] = ptop * w2;
        }
        __syncthreads();
    }
}

DEV void ph_moe(const KArgs& a, int layer, int sub, unsigned char* lds) {
    const int tid = get_tid();
    const unsigned* cnt = (const unsigned*)(a.ws + WS_CTL) + layer * NE;
    const unsigned* list = (const unsigned*)(a.ws + WS_LIST);
    const float* gate = (const float*)(a.ws + WS_GATE);
    bf16_t* ys = (bf16_t*)(a.ws + WS_KV);
    int (*s_off)[80] = (int (*)[80])(lds + 65536);
    constexpr int ntn = 8;
    if (tid == 0) { int o = 0, t = 0; for (int e = 0; e < NE; ++e) { const int c = (int)cnt[e]; s_off[0][e] = o; s_off[1][e] = t; o += c; t += ((c + 127) / 128) * ntn; } s_off[0][NE] = o; s_off[1][NE] = t; }
    __syncthreads();
    const int ntiles = s_off[1][NE];
    struct Cx { int e, p0, nt, c, ro; };
    auto prep = [&](int t) { Cx x; int e = 0;
#pragma unroll
        for (int st = 32; st >= 1; st >>= 1) if (s_off[1][e + st] <= t) e += st;
        const int local = t - s_off[1][e]; x.e = e; x.p0 = (local / ntn) * 128; x.nt = local % ntn; x.c = (int)cnt[e]; x.ro = s_off[0][e];
        return x; };
    const int wr = tid >> 7, wc = (tid >> 6) & 1, lane = tid & 63;
    const unsigned char* hn8 = a.ws + WS_HN8;
    unsigned char* H8 = a.ws + WS_Z;
    if (sub == 0) {
        gemm_stream<true>(lds, D / 128, vblock(), gridDim.x, ntiles, prep,
            [&](const Cx& x, int r) { const int n = x.nt * 64 + (r >> 6) * 32 + (r & 31);
                                return (const bf16_t*)(a.ws + ((r >> 5) & 1 ? WS_W3T : WS_W1T) + ((size_t)x.e * DE + n) * D); },
            [&](const Cx& x, int r) { const int p = x.p0 + r; const unsigned slot = list[(size_t)x.e * LCAP + (p < x.c ? p : 0)]; return (const bf16_t*)(hn8 + (size_t)(slot >> 1) * D); },
            [&](const Cx& x, const f32x16 (&acc)[2][2]) {
                const int p0 = x.p0, nt = x.nt, c = x.c, ro = x.ro;
#pragma unroll
                for (int ni = 0; ni < 2; ++ni) {
                    const int p = p0 + wc * 64 + ni * 32 + (lane & 31);
                    unsigned char* hr = H8 + (size_t)(ro + (p < c ? p : 0)) * DE + nt * 64 + wr * 32 + 8 * (lane >> 5);
#pragma unroll
                    for (int kp = 0; kp < 2; ++kp) {
                        float hv[8];
#pragma unroll
                        for (int q = 0; q < 8; ++q) hv[q] = silu_f(acc[0][ni][8 * kp + q] * W8_INV) * (acc[1][ni][8 * kp + q] * W8_INV);
                        const unsigned wa = pk4_fp8(hv[0], hv[1], hv[2], hv[3]), wb = pk4_fp8(hv[4], hv[5], hv[6], hv[7]);
                        auto rsw = __builtin_amdgcn_permlane32_swap(wa, wb, false, false);
                        u32x2 w; w.x = rsw[0]; w.y = rsw[1];
                        if (p < c) *(u32x2*)(hr + 16 * kp) = w;
                    }
                }
            });
    } else {
        gemm_stream<true>(lds, DE / 128, vblock(), gridDim.x, ntiles, prep,
            [&](const Cx& x, int r) { return (const bf16_t*)(a.ws + WS_W2T + ((size_t)x.e * D + x.nt * 128 + r) * DE); },
            [&](const Cx& x, int r) { const int p = x.p0 + r; return (const bf16_t*)(H8 + (size_t)(x.ro + (p < x.c ? p : 0)) * DE); },
            [&](const Cx& x, const f32x16 (&acc)[2][2]) {
                const int e = x.e, p0 = x.p0, nt = x.nt, c = x.c;
                unsigned slotv[2]; float gtv[2];
#pragma unroll
                for (int ni = 0; ni < 2; ++ni) { const int p = p0 + wc * 64 + ni * 32 + (lane & 31); slotv[ni] = list[(size_t)e * LCAP + (p < c ? p : 0)]; }
#pragma unroll
                for (int ni = 0; ni < 2; ++ni) gtv[ni] = gate[slotv[ni]] * W8_INV;
#pragma unroll
                for (int ni = 0; ni < 2; ++ni) {
                    const int p = p0 + wc * 64 + ni * 32 + (lane & 31);
                    const unsigned slot = slotv[ni]; const float gt = gtv[ni] * YS_SCALE;
                    unsigned char* yo = (unsigned char*)ys + (size_t)slot * D + nt * 128 + wr * 64 + 8 * (lane >> 5);
#pragma unroll
                    for (int mi = 0; mi < 2; ++mi)
#pragma unroll
                        for (int kp = 0; kp < 2; ++kp) {
                            const unsigned wa = pk4_fp8(gt * acc[mi][ni][8 * kp], gt * acc[mi][ni][8 * kp + 1], gt * acc[mi][ni][8 * kp + 2], gt * acc[mi][ni][8 * kp + 3]);
                            const unsigned wb = pk4_fp8(gt * acc[mi][ni][8 * kp + 4], gt * acc[mi][ni][8 * kp + 5], gt * acc[mi][ni][8 * kp + 6], gt * acc[mi][ni][8 * kp + 7]);
                            auto rsw = __builtin_amdgcn_permlane32_swap(wa, wb, false, false);
                            u32x2 w; w.x = rsw[0]; w.y = rsw[1];
                            if (p < c) *(u32x2*)(yo + mi * 32 + 16 * kp) = w;
                        }
                }
            });
    }
}

#define XB_TMO      128
#define XB_XCNT(j)  (256  + 64 * (j))
#define XB_XSUB(j)  (1280 + 64 * (j))
#define XB_XGEN(j)  (2304 + 64 * (j))
#define XB_TOP      3328
#define XB_TOPGEN   3392
#define XCD_BAR_WORDS 3456
#define XB_SPIN_CAP (1u << 18)
#define LAS __attribute__((address_space(3)))
DEV unsigned xb_ld(unsigned* p)              { return __hip_atomic_load(p, __ATOMIC_RELAXED, __HIP_MEMORY_SCOPE_AGENT); }
DEV unsigned xb_add(unsigned* p, unsigned v) { return __hip_atomic_fetch_add(p, v, __ATOMIC_RELAXED, __HIP_MEMORY_SCOPE_AGENT); }
DEV unsigned xb_xcc_id() { return (unsigned)__builtin_amdgcn_s_getreg((3 << 11) | 20) & 0xFu; }
#define XB_SPIN(cond, bar) do { unsigned _sp = 0; while (cond) { __builtin_amdgcn_s_sleep(1); \
    if ((++_sp & 255u) == 0u) { if (xb_ld(&(bar)[XB_TMO])) break; if (_sp > XB_SPIN_CAP) { atomicAdd(&(bar)[XB_TMO], 1u); break; } } } } while (0)
struct XcdBarrier { unsigned* bar; unsigned x; volatile LAS unsigned* st; };
DEV XcdBarrier xcd_barrier_post(unsigned* bar, volatile LAS unsigned* st) {
    XcdBarrier b; b.bar = bar; b.x = xb_xcc_id(); b.st = st;
    if (threadIdx.x == 0) (void)xb_add(&bar[XB_XCNT(b.x)], 1u);
    return b;
}
DEV void xcd_barrier_complete(unsigned* bar, unsigned x, unsigned& nloc, unsigned& nx) {
    const unsigned G = gridDim.x * gridDim.y * gridDim.z;
    unsigned sum, cnt, mine, sp = 0u;
    for (;;) {
        sum = 0u; cnt = 0u; mine = 0u;
#pragma unroll
        for (unsigned j = 0; j < 16; ++j) { const unsigned c = xb_ld(&bar[XB_XCNT(j)]); sum += c; cnt += (c > 0u) ? 1u : 0u; mine = (j == x) ? c : mine; }
        if (sum == G) break;
        __builtin_amdgcn_s_sleep(1);
        if ((++sp & 255u) == 0u) { if (xb_ld(&bar[XB_TMO])) break; if (sp > XB_SPIN_CAP) { atomicAdd(&bar[XB_TMO], 1u); break; } }
    }
    nloc = mine > 0u ? mine : 1u; nx = cnt > 0u ? cnt : 1u;
}
DEV void xcd_barrier(const XcdBarrier& b) {
    asm volatile("s_waitcnt vmcnt(0)" ::: "memory");
    __syncthreads();
    if (threadIdx.x == 0) {
        unsigned* bar = b.bar;
        __builtin_amdgcn_s_waitcnt(0);
        unsigned nloc = b.st[0], nx = b.st[1];
        if (nloc == 0u) { xcd_barrier_complete(bar, b.x, nloc, nx); b.st[0] = nloc; b.st[1] = nx; }
        const unsigned old = xb_add(&bar[XB_XSUB(b.x)], 1u);
        const unsigned gen = old / nloc;
        if (old + 1u == (gen + 1u) * nloc) {
            __builtin_amdgcn_fence(__ATOMIC_RELEASE, "agent");
            asm volatile("s_waitcnt vmcnt(0)" ::: "memory");
            const unsigned og = xb_add(&bar[XB_TOP], 1u);
            const unsigned tg = og / nx;
            if (og + 1u == (tg + 1u) * nx) xb_add(&bar[XB_TOPGEN], 1u);
            else XB_SPIN(xb_ld(&bar[XB_TOPGEN]) == tg, bar);
            __builtin_amdgcn_fence(__ATOMIC_ACQUIRE, "agent");
            xb_add(&bar[XB_XGEN(b.x)], 1u);
            asm volatile("s_waitcnt vmcnt(0)" ::: "memory");
        } else {
            XB_SPIN(xb_ld(&bar[XB_XGEN(b.x)]) == gen, bar);
            __builtin_amdgcn_fence(__ATOMIC_ACQUIRE, "agent");
            asm volatile("s_waitcnt vmcnt(0)" ::: "memory");
        }
    }
    __syncthreads();
}

constexpr int NPH_LAYER = 10, NPH = 1 + 2 * NPH_LAYER + 1;
__global__ void __launch_bounds__(256, 2) mega(KArgs a) {
    __shared__ __attribute__((aligned(16))) unsigned char lds[65536 + 1024];
    uint4& xb_words = *(uint4*)(lds + 65536 + 768);
    cg::grid_group grid = cg::this_grid();
    const int lo = a.ph_lo, hi = a.ph_hi;
    if (threadIdx.x == 0) xb_words = make_uint4(0u, 0u, 0u, 0u);
    __syncthreads();
    const XcdBarrier xb = xcd_barrier_post((unsigned*)(a.ws + WS_CTL + 65536), (volatile LAS unsigned*)&xb_words);
    if (threadIdx.x == 0) {
        const unsigned hwid = (unsigned)__builtin_amdgcn_s_getreg((31 << 11) | 4), key = xb.x * 256u + ((hwid >> 8) & 0xffu);
        ((volatile unsigned*)&xb_words)[2] = atomicAdd((unsigned*)(a.ws + WS_CTL + 16384) + key, 1u);
    }
    __syncthreads();
    const int cu_role = __builtin_amdgcn_readfirstlane((int)(((volatile unsigned*)&xb_words)[2] & 1u));
#define GEMM_PRIO_ON()  (cu_role ? __builtin_amdgcn_s_setprio(2) : (void)0)
#define GEMM_PRIO_OFF() __builtin_amdgcn_s_setprio(0)
    if (hi < 0) grid.sync();
#define PHASE(k, call) do { const int k_ = (k); if (lo <= k_ && k_ < hi) { call; if (k_ + 1 < hi) xcd_barrier(xb); } } while (0)
    PHASE(0, (ph_prep(a, lds), convert_shared(a, lds)));
#pragma unroll 1
    for (int l = 0; l < 2; ++l) {
        const int base = 1 + l * NPH_LAYER;
        const int nrows = l == 0 ? TA : TL;
        PHASE(base + 0, ph_norm(a, l, 0, l > 0, l - 1, l == 0, TA));
        PHASE(base + 1, (GEMM_PRIO_ON(), ph_inproj(a, l, lds), GEMM_PRIO_OFF()));
        PHASE(base + 2, (blockIdx.x < (gridDim.x >> 1) ? (convert_experts(a, l, lds), __syncthreads(), ph_spatial(a, l, nrows, lds), ph_gla_kv(a, l, lds))
                                                        : (ph_spatial(a, l, nrows, lds), ph_gla_kv(a, l, lds), __syncthreads(), convert_experts(a, l, lds))));
        PHASE(base + 3, ph_gla_scan(a));
        PHASE(base + 4, ph_gla_out(a, l, lds));
        PHASE(base + 5, (GEMM_PRIO_ON(), ph_outproj(a, l, nrows, lds), GEMM_PRIO_OFF()));
        PHASE(base + 6, ph_norm(a, l, 1, false, 0, false, nrows));
        PHASE(base + 7, ph_router(a, l, nrows, lds));
        PHASE(base + 8, (GEMM_PRIO_ON(), ph_moe(a, l, 0, lds), GEMM_PRIO_OFF()));
        PHASE(base + 9, (GEMM_PRIO_ON(), ph_moe(a, l, 1, lds), GEMM_PRIO_OFF()));
    }
    PHASE(NPH - 1, ph_norm(a, 0, 2, true, 1, false, TL));
#undef PHASE
}

extern "C" void kernel_launch(void* const* d_in, const int* in_sizes, int n_in, void* d_out, int out_size, void* d_ws, size_t ws_size, hipStream_t stream) {
    static int grid = 0;
    if (grid == 0) {
        int dev = 0, cus = 0, per_cu = 0;
        hipGetDevice(&dev);
        hipDeviceGetAttribute(&cus, hipDeviceAttributeMultiprocessorCount, dev);
        hipOccupancyMaxActiveBlocksPerMultiprocessor(&per_cu, (const void*)mega, 256, 0);
        if (per_cu < 1) per_cu = 1;
        if (per_cu > 2) per_cu = 2;
        grid = cus * per_cu;
        if (n_in != 25 || ws_size < WS_END) { fprintf(stderr, "kernel_launch: unexpected n_in %d or ws_size %zu (need %zu)\n", n_in, ws_size, (size_t)WS_END); }
    }
    KArgs a{};
    for (int i = 0; i < 25; ++i) a.in[i] = (const float*)d_in[i];
    a.out = (float*)d_out; a.ws = (unsigned char*)d_ws;
    hipMemsetAsync(d_ws, 0, WS_MOD + 2 * 17 * 6144 * 4, stream);
#if ONE_LAUNCH
    a.ph_lo = 0; a.ph_hi = NPH;
    void* args[] = {&a};
    hipError_t e = hipLaunchCooperativeKernel((const void*)mega, dim3(grid), dim3(256), args, 0, stream);
    if (e != hipSuccess) fprintf(stderr, "cooperative launch failed: %s (grid %d)\n", hipGetErrorString(e), grid);
#else
    for (int ph = 0; ph < NPH; ++ph) {
        a.ph_lo = ph; a.ph_hi = ph + 1;
        hipLaunchKernelGGL(mega, dim3(grid), dim3(256), 0, stream, a);
    }
#endif
}
```

```cpp
#include <hip/hip_runtime.h>
#include <hip/hip_cooperative_groups.h>
#include <cstdio>
#include <cstdint>
namespace cg = cooperative_groups;

#ifndef ONE_LAUNCH
#define ONE_LAUNCH 1
#endif

#define DEV __device__ __forceinline__
typedef unsigned short bf16_t;
typedef float f32x4 __attribute__((ext_vector_type(4)));
typedef unsigned u32x2 __attribute__((ext_vector_type(2)));
typedef unsigned u32x4 __attribute__((ext_vector_type(4)));
typedef short bf16x8 __attribute__((ext_vector_type(8)));
typedef float f32x16 __attribute__((ext_vector_type(16)));

constexpr int D = 1024, NB = 16, SEQ = 2048, CTXL = 256;
constexpr int TL = NB * SEQ, TC = NB * CTXL, TA = TL + TC;
constexpr int DIN = 2592, OFF_AU = 0, OFF_AV = 512, OFF_BQ = 1024, OFF_BR = 1280, OFF_BK = 1792, OFF_BV = 2048, OFF_BG = 2560;
constexpr int NE = 64, DE = 512, LCAP = 2 * TA;
constexpr float EPS = 1e-6f;

constexpr size_t MiB = 1u << 20;
constexpr size_t WS_CTL = 0, WS_MOD = 1 * MiB, WS_WRT = 2 * MiB, WS_WSP = 2 * MiB + 512 * 1024, WS_WINT = 3 * MiB, WS_WOUTT = 14 * MiB,
                 WS_W1T = 18 * MiB, WS_W3T = 82 * MiB, WS_W2T = 146 * MiB, WS_H = 210 * MiB, WS_HN = 354 * MiB, WS_Z = 426 * MiB, WS_MIX = 609 * MiB,
                 WS_KV = 681 * MiB, WS_LIST = 825 * MiB, WS_GATE = 843 * MiB, WS_DECAY = 844 * MiB, WS_HN8 = 846 * MiB, WS_END = 884 * MiB;
static_assert(WS_WINT + (size_t)2 * DIN * D * 2 <= WS_WOUTT && WS_WOUTT + (size_t)2 * D * D * 2 <= WS_W1T && WS_W1T + (size_t)NE * DE * D * 2 <= WS_W3T && WS_W2T + (size_t)NE * DE * D * 2 <= WS_H, "ws map (weights)");
static_assert(WS_H + (size_t)TA * D * 4 <= WS_HN && WS_HN + (size_t)TA * D * 2 <= WS_Z && WS_Z + (size_t)TA * DIN * 2 <= WS_MIX &&
              WS_MIX + (size_t)TA * D * 2 <= WS_KV && WS_KV + (size_t)2 * TA * 512 * 4 <= WS_LIST && WS_LIST + (size_t)NE * LCAP * 4 <= WS_GATE, "ws map");

struct KArgs { const float* in[25]; float* out; unsigned char* ws; int ph_lo, ph_hi; };
enum { I_X = 0, I_C, I_CTX, I_CCTX, I_WMOD, I_BMOD, I_GN1, I_WIN, I_LNG, I_LNB, I_WSP, I_BSP, I_WGU, I_BG, I_GGLA, I_WOUT, I_GN2, I_WRG, I_BRG, I_WRE, I_BRE, I_W1, I_W3, I_W2, I_GF };

DEV float bf2f(bf16_t v) { return __uint_as_float((unsigned)v << 16); }
typedef __bf16 bf16x2_t __attribute__((ext_vector_type(2)));
DEV bf16_t f2bf(float f) { return __builtin_bit_cast(bf16_t, (__bf16)f); }
DEV unsigned pk2(float lo, float hi) { bf16x2_t v; v.x = (__bf16)lo; v.y = (__bf16)hi; return __builtin_bit_cast(unsigned, v); }
DEV u32x4 widen_pair(u32x2 a, u32x2 b) {
    auto r0 = __builtin_amdgcn_permlane32_swap(a.x, b.x, false, false); auto r1 = __builtin_amdgcn_permlane32_swap(a.y, b.y, false, false);
    u32x4 o; o.x = r0[0]; o.y = r1[0]; o.z = r0[1]; o.w = r1[1]; return o;
}
constexpr float W8_SCALE = 32.f, W8_INV = 1.f / 32.f, YS_SCALE = 16.f, YS_INV = 1.f / 16.f;
DEV unsigned pk4_fp8(float a, float b, float c, float d) { int w = 0; w = __builtin_amdgcn_cvt_pk_fp8_f32(a, b, w, false); w = __builtin_amdgcn_cvt_pk_fp8_f32(c, d, w, true); return (unsigned)w; }
DEV float silu_f(float x) { return x * __builtin_amdgcn_rcpf(1.f + __expf(-x)); }
DEV float gelu_f(float x) { const float x2 = x * x; const float u2 = x * (1.5957691216057308f + 0.07135481627f * x2); return x * __builtin_amdgcn_rcpf(1.f + __expf(-u2)); }
DEV float logsigmoid_f(float x) { return fminf(x, 0.f) - __logf(1.f + __expf(-fabsf(x))); }
DEV float wave_sum(float v) {
#pragma unroll
    for (int o = 1; o < 64; o <<= 1) v += __shfl_xor(v, o);
    return v;
}
DEV int get_tid() { int t = threadIdx.x; asm volatile("" : "+v"(t)); return t; }
DEV int mod_index(int row) { return row < TL ? (row >> 11) : 16; }

DEV void ph_prep(const KArgs& a, unsigned char* lds) {
    const int tid = get_tid(), lane = tid & 63, wid = tid >> 6;
    float* slab = (float*)lds + wid * 17 * 64;
    float* red = (float*)lds + 4 * 17 * 64;
    float* mod = (float*)(a.ws + WS_MOD);
    const float* c = a.in[I_C]; const float* cctx = a.in[I_CCTX];
    for (int item = blockIdx.x; item < 2 * 96 * 2; item += gridDim.x) {
        const int kh = item & 1, it2 = item >> 1, l = it2 / 96, j0 = (it2 % 96) * 64, j = j0 + lane;
        const float* W = a.in[I_WMOD] + (size_t)l * D * 6144;
        float acc[17];
#pragma unroll
        for (int i = 0; i < 17; ++i) acc[i] = 0.f;
#pragma unroll 1
        for (int ks = 0; ks < 2; ++ks) {
            const int kb = kh * 512 + wid * 128 + ks * 64;
#pragma unroll
            for (int bi = 0; bi < 17; ++bi) { const float x = (bi < 16) ? c[bi * D + kb + lane] : cctx[kb + lane]; slab[bi * 64 + lane] = silu_f(x); }
            __syncthreads();
#pragma unroll 1
            for (int k8 = 0; k8 < 64; k8 += 16) {
                float w[16];
#pragma unroll
                for (int u = 0; u < 16; ++u) w[u] = __builtin_nontemporal_load(W + (size_t)(kb + k8 + u) * 6144 + j);
#pragma unroll
                for (int u = 0; u < 16; ++u)
#pragma unroll
                    for (int bi = 0; bi < 17; ++bi) acc[bi] += slab[bi * 64 + k8 + u] * w[u];
            }
            __syncthreads();
        }
#pragma unroll
        for (int bi = 0; bi < 17; ++bi) red[(wid * 17 + bi) * 64 + lane] = acc[bi];
        __syncthreads();
        for (int idx = tid; idx < 17 * 64; idx += 256) {
            const int bi = idx >> 6, ln = idx & 63;
            const float sv = red[(0 * 17 + bi) * 64 + ln] + red[(1 * 17 + bi) * 64 + ln] + red[(2 * 17 + bi) * 64 + ln] + red[(3 * 17 + bi) * 64 + ln] + (kh == 0 ? a.in[I_BMOD][l * 6144 + j0 + ln] : 0.f);
            atomicAdd(mod + (size_t)(l * 17 + bi) * 6144 + j0 + ln, sv);
        }
        __syncthreads();
    }
}

DEV void ph_norm(const KArgs& a, int layer, int which  , bool combine, int comb_layer, bool from_input, int nrows) {
    const int tid = get_tid(), lane = tid & 63, wid = tid >> 6;
    float* hws = (float*)(a.ws + WS_H);
    bf16_t* hn = (bf16_t*)(a.ws + WS_HN);
    const bf16_t* ys = (const bf16_t*)(a.ws + WS_KV);
    const float* mod = (const float*)(a.ws + WS_MOD);
    const float* g = which == 0 ? a.in[I_GN1] + layer * D : (which == 1 ? a.in[I_GN2] + layer * D : a.in[I_GF]);
    const int nw = gridDim.x * 4;
    for (int r = blockIdx.x * 4 + wid; r < nrows; r += nw) {
        const int bi = mod_index(r);
        const float* src = from_input ? (r < TL ? a.in[I_X] + (size_t)r * D : a.in[I_CTX] + (size_t)(r - TL) * D) : hws + (size_t)r * D;
        f32x4 v[4];
#pragma unroll
        for (int j = 0; j < 4; ++j) v[j] = __builtin_nontemporal_load((const f32x4*)(src + (lane + 64 * j) * 4));
        if (combine) {
            const float* g2 = mod + (size_t)(comb_layer * 17 + bi) * 6144 + 5 * D;
            unsigned y0v[4], y1v[4]; f32x4 ggv[4];
#pragma unroll
            for (int j = 0; j < 4; ++j) { const int k = (lane + 64 * j) * 4; y0v[j] = __builtin_nontemporal_load((const unsigned*)((const unsigned char*)ys + (size_t)(2 * r) * D + k)); y1v[j] = __builtin_nontemporal_load((const unsigned*)((const unsigned char*)ys + (size_t)(2 * r + 1) * D + k)); ggv[j] = *(const f32x4*)(g2 + k); }
#pragma unroll
            for (int j = 0; j < 4; ++j) {
                const int k = (lane + 64 * j) * 4;
                const int y0 = (int)y0v[j], y1 = (int)y1v[j];
                const f32x4 gg = ggv[j] * YS_INV;
                v[j].x += gg.x * (__builtin_amdgcn_cvt_f32_fp8(y0, 0) + __builtin_amdgcn_cvt_f32_fp8(y1, 0));
                v[j].y += gg.y * (__builtin_amdgcn_cvt_f32_fp8(y0, 1) + __builtin_amdgcn_cvt_f32_fp8(y1, 1));
                v[j].z += gg.z * (__builtin_amdgcn_cvt_f32_fp8(y0, 2) + __builtin_amdgcn_cvt_f32_fp8(y1, 2));
                v[j].w += gg.w * (__builtin_amdgcn_cvt_f32_fp8(y0, 3) + __builtin_amdgcn_cvt_f32_fp8(y1, 3));
                if (which != 2) __builtin_nontemporal_store(v[j], (f32x4*)(hws + (size_t)r * D + k));
            }
        }
        float ss = 0.f;
#pragma unroll
        for (int j = 0; j < 4; ++j) ss += v[j].x * v[j].x + v[j].y * v[j].y + v[j].z * v[j].z + v[j].w * v[j].w;
        const float rstd = rsqrtf(wave_sum(ss) * (1.f / D) + EPS);
        if (which == 2) {
            f32x4 gv[4];
#pragma unroll
            for (int j = 0; j < 4; ++j) gv[j] = *(const f32x4*)(g + (lane + 64 * j) * 4);
#pragma unroll
            for (int j = 0; j < 4; ++j) { const int k = (lane + 64 * j) * 4; f32x4 o = v[j] * rstd * gv[j]; __builtin_nontemporal_store(o, (f32x4*)(a.out + (size_t)r * D + k)); }
        } else {
            const float* sh = mod + (size_t)(layer * 17 + bi) * 6144 + (which == 0 ? 0 : 3 * D);
            const float* sc = sh + D;
            f32x4 gv[4], s1v[4], s0v[4];
#pragma unroll
            for (int j = 0; j < 4; ++j) { const int k = (lane + 64 * j) * 4; gv[j] = *(const f32x4*)(g + k); s1v[j] = *(const f32x4*)(sc + k); s0v[j] = *(const f32x4*)(sh + k); }
#pragma unroll
            for (int j = 0; j < 4; ++j) {
                const int k = (lane + 64 * j) * 4;
                const f32x4 gg = gv[j], s1 = s1v[j], s0 = s0v[j];
                const f32x4 o = v[j] * rstd * gg * (1.f + s1) + s0;
                u32x2 w; w.x = pk2(o.x, o.y); w.y = pk2(o.z, o.w);
                *(u32x2*)(hn + (size_t)r * D + k) = w;
                if (which == 1) *(unsigned*)(a.ws + WS_HN8 + (size_t)r * D + k) = pk4_fp8(o.x, o.y, o.z, o.w);
            }
        }
    }
}


DEV void transpose_item(const float* W, int K, int N, bf16_t* WT, float* scr, int kb, int nb, int lane) {
    const int k0 = kb * 64, n0 = nb * 32;
    float wv[32];
#pragma unroll
    for (int i = 0; i < 32; ++i) wv[i] = __builtin_nontemporal_load(W + (size_t)(k0 + 2 * i + (lane >> 5)) * N + n0 + (lane & 31));
#pragma unroll
    for (int i = 0; i < 32; ++i) scr[(2 * i + (lane >> 5)) * 33 + (lane & 31)] = wv[i];
    asm volatile("s_waitcnt lgkmcnt(0)" ::: "memory");
    const int c = lane & 7;
#pragma unroll
    for (int j = 0; j < 4; ++j) {
        const int n = (lane >> 3) + 8 * j; const float* sp = scr + (8 * c) * 33 + n;
        u32x4 o; o.x = pk2(sp[0 * 33], sp[1 * 33]); o.y = pk2(sp[2 * 33], sp[3 * 33]); o.z = pk2(sp[4 * 33], sp[5 * 33]); o.w = pk2(sp[6 * 33], sp[7 * 33]);
        *(u32x4*)(WT + (size_t)(n0 + n) * K + k0 + 8 * c) = o;
    }
    asm volatile("s_waitcnt lgkmcnt(0)" ::: "memory");
}
DEV void transpose_item8(const float* W, int K, int N, unsigned char* WT, float* scr, int kb, int nb, int lane) {
    const int k0 = kb * 64, n0 = nb * 32;
    float wv[32];
#pragma unroll
    for (int i = 0; i < 32; ++i) wv[i] = __builtin_nontemporal_load(W + (size_t)(k0 + 2 * i + (lane >> 5)) * N + n0 + (lane & 31));
#pragma unroll
    for (int i = 0; i < 32; ++i) scr[(2 * i + (lane >> 5)) * 33 + (lane & 31)] = wv[i] * W8_SCALE;
    asm volatile("s_waitcnt lgkmcnt(0)" ::: "memory");
    const int n = lane >> 1, kh = (lane & 1) * 32;
    const float* sp = scr + kh * 33 + n;
    u32x4 o0, o1;
    o0.x = pk4_fp8(sp[0 * 33], sp[1 * 33], sp[2 * 33], sp[3 * 33]); o0.y = pk4_fp8(sp[4 * 33], sp[5 * 33], sp[6 * 33], sp[7 * 33]);
    o0.z = pk4_fp8(sp[8 * 33], sp[9 * 33], sp[10 * 33], sp[11 * 33]); o0.w = pk4_fp8(sp[12 * 33], sp[13 * 33], sp[14 * 33], sp[15 * 33]);
    o1.x = pk4_fp8(sp[16 * 33], sp[17 * 33], sp[18 * 33], sp[19 * 33]); o1.y = pk4_fp8(sp[20 * 33], sp[21 * 33], sp[22 * 33], sp[23 * 33]);
    o1.z = pk4_fp8(sp[24 * 33], sp[25 * 33], sp[26 * 33], sp[27 * 33]); o1.w = pk4_fp8(sp[28 * 33], sp[29 * 33], sp[30 * 33], sp[31 * 33]);
    unsigned char* dp = WT + (size_t)(n0 + n) * K + k0 + kh;
    __builtin_nontemporal_store(o0, (u32x4*)dp); __builtin_nontemporal_store(o1, (u32x4*)(dp + 16));
    asm volatile("s_waitcnt lgkmcnt(0)" ::: "memory");
}
DEV void convert_experts(const KArgs& a, int layer, unsigned char* lds) {
    const int tid = get_tid(), lane = tid & 63, wid = tid >> 6;
    float* scr = (float*)lds + wid * (64 * 33);
    const int gw = blockIdx.x * 4 + wid, ngw = gridDim.x * 4;
    for (int it = gw; it < NE * 3 * 256; it += ngw) {
        const int mat = it >> 8, sub = it & 255, e = mat / 3, which = mat % 3;
        if (which < 2) {
            const float* W = a.in[which == 0 ? I_W1 : I_W3] + ((size_t)layer * NE + e) * D * DE;
            unsigned char* WT = a.ws + (which == 0 ? WS_W1T : WS_W3T) + (size_t)e * DE * D;
            transpose_item8(W, D, DE, WT, scr, sub >> 4, sub & 15, lane);
        } else {
            const float* W = a.in[I_W2] + ((size_t)layer * NE + e) * DE * D;
            unsigned char* WT = a.ws + WS_W2T + (size_t)e * D * DE;
            transpose_item8(W, DE, D, WT, scr, sub >> 5, sub & 31, lane);
        }
    }
}
DEV void convert_shared(const KArgs& a, unsigned char* lds) {
    const int tid = get_tid(), lane = tid & 63, wid = tid >> 6;
    float* scr = (float*)lds + wid * (64 * 33);
    const int gw = blockIdx.x * 4 + wid, ngw = gridDim.x * 4;
    constexpr int I_IN = 16 * 81, I_OUT = 16 * 32;
    for (int it = gw; it < 2 * I_IN + 2 * I_OUT; it += ngw) {
        if (it < 2 * I_IN) { const int l = it / I_IN, sub = it % I_IN; transpose_item(a.in[I_WIN] + (size_t)l * D * DIN, D, DIN, (bf16_t*)(a.ws + WS_WINT) + (size_t)l * DIN * D, scr, sub / 81, sub % 81, lane); }
        else { const int r = it - 2 * I_IN, l = r / I_OUT, sub = r % I_OUT; transpose_item(a.in[I_WOUT] + (size_t)l * D * D, D, D, (bf16_t*)(a.ws + WS_WOUTT) + (size_t)l * D * D, scr, sub >> 5, sub & 31, lane); }
    }
    bf16_t* wrt = (bf16_t*)(a.ws + WS_WRT); bf16_t* wsp = (bf16_t*)(a.ws + WS_WSP);
    const int gt = blockIdx.x * 256 + tid, ngt = gridDim.x * 256;
    for (int i = gt; i < 2 * 128 * D; i += ngt) {
        const int l = i >> 17, n = (i >> 10) & 127, k = i & 1023;
        float v = 0.f;
        if (n < 8) v = a.in[I_WRG][((size_t)l * D + k) * 8 + n]; else if (n < 72) v = a.in[I_WRE][((size_t)l * D + k) * 64 + (n - 8)];
        wrt[i] = f2bf(v);
    }
    for (int i = gt; i < 2 * 4 * 128 * 128; i += ngt) wsp[i] = f2bf(a.in[I_WSP][i]);
}

DEV void glds16(const bf16_t* src, unsigned char* dst) { __builtin_amdgcn_global_load_lds((const unsigned*)src, (__attribute__((address_space(3))) unsigned*)dst, 16, 0, 0); }
template <class ARow, class BRow>
DEV void gemm_core(unsigned char* lds, int nk, ARow arow, BRow brow, f32x16 (&acc)[2][2]) {
    const int tid = get_tid(), lane = tid & 63, wid = tid >> 6, wr = wid >> 1, wc = wid & 1;
    const int srow = tid >> 3, sch = (tid & 7) ^ ((tid >> 4) & 7);
    const bf16_t* ap[4]; const bf16_t* bp[4];
#pragma unroll
    for (int i = 0; i < 4; ++i) { ap[i] = arow(i * 32 + srow) + sch * 8; bp[i] = brow(i * 32 + srow) + sch * 8; }
#pragma unroll
    for (int mi = 0; mi < 2; ++mi)
#pragma unroll
        for (int ni = 0; ni < 2; ++ni)
#pragma unroll
            for (int r = 0; r < 16; ++r) acc[mi][ni][r] = 0.f;
    unsigned char* dst = lds + tid * 16;
    const int fr = lane & 31, fh = lane >> 5, g = (fr >> 1) & 7;
    const unsigned char* ra = lds + (wr * 64 + fr) * 128;
    const unsigned char* rb = lds + 16384 + (wc * 64 + fr) * 128;
#pragma unroll
    for (int i = 0; i < 4; ++i) { glds16(ap[i], dst + i * 4096); glds16(bp[i], dst + 16384 + i * 4096); }
    if (nk > 1) {
#pragma unroll
        for (int i = 0; i < 4; ++i) { glds16(ap[i] + 64, dst + 32768 + i * 4096); glds16(bp[i] + 64, dst + 32768 + 16384 + i * 4096); }
    }
    for (int kt = 0; kt < nk; ++kt) {
        const int cur = (kt & 1) * 32768;
        if (kt + 1 < nk) asm volatile("s_waitcnt vmcnt(8)" ::: "memory"); else asm volatile("s_waitcnt vmcnt(0)" ::: "memory");
        __builtin_amdgcn_s_barrier();
        asm volatile("" ::: "memory");
        bf16x8 af[4][2], bfr[4][2];
#pragma unroll
        for (int ks = 0; ks < 4; ++ks) {
            const int co = ((ks * 2 + fh) ^ g) << 4;
#pragma unroll
            for (int mi = 0; mi < 2; ++mi) af[ks][mi] = *(const bf16x8*)(ra + cur + mi * 4096 + co);
#pragma unroll
            for (int ni = 0; ni < 2; ++ni) bfr[ks][ni] = *(const bf16x8*)(rb + cur + ni * 4096 + co);
        }
        asm volatile("s_waitcnt lgkmcnt(0)" ::: "memory");
        __builtin_amdgcn_s_barrier();
        asm volatile("" ::: "memory");
        if (kt + 2 < nk) {
            const int ko = (kt + 2) * 64;
#pragma unroll
            for (int i = 0; i < 4; ++i) { glds16(ap[i] + ko, dst + cur + i * 4096); glds16(bp[i] + ko, dst + cur + 16384 + i * 4096); }
        }
#pragma unroll
        for (int ks = 0; ks < 4; ++ks)
#pragma unroll
            for (int mi = 0; mi < 2; ++mi)
#pragma unroll
                for (int ni = 0; ni < 2; ++ni) acc[mi][ni] = __builtin_amdgcn_mfma_f32_32x32x16_bf16(af[ks][mi], bfr[ks][ni], acc[mi][ni], 0, 0, 0);
    }
    __builtin_amdgcn_s_barrier();
    asm volatile("" ::: "memory");
}
template <bool FP8 = false, class Prep, class ARow, class BRow, class Epi>
DEV void gemm_stream(unsigned char* lds, int nk, int t0, int tstep, int tend, Prep prep, ARow arow, BRow brow, Epi epi) {
    const int tid = get_tid(), lane = tid & 63, wid = tid >> 6, wr = wid >> 1, wc = wid & 1;
    const int srow = tid >> 3, sch = (tid & 7) ^ ((tid >> 4) & 7);
    if (t0 >= tend) return;
    auto cx = prep(t0);
    auto nx = cx;
    const bf16_t* ap[4]; const bf16_t* bp[4];
#pragma unroll
    for (int i = 0; i < 4; ++i) { ap[i] = arow(cx, i * 32 + srow) + sch * 8; bp[i] = brow(cx, i * 32 + srow) + sch * 8; }
    unsigned char* dst = lds + tid * 16;
    const int fr = lane & 31, fh = lane >> 5, g = (fr >> 1) & 7;
    const unsigned char* ra = lds + (wr * 64 + fr) * 128;
    const unsigned char* rb = lds + 16384 + (wc * 64 + fr) * 128;
#pragma unroll
    for (int i = 0; i < 4; ++i) { glds16(ap[i], dst + i * 4096); glds16(bp[i], dst + 16384 + i * 4096); }
#pragma unroll
    for (int i = 0; i < 4; ++i) { glds16(ap[i] + 64, dst + 32768 + i * 4096); glds16(bp[i] + 64, dst + 32768 + 16384 + i * 4096); }
    for (int t = t0; t < tend; t += tstep) {
        const bool has_next = t + tstep < tend;
        f32x16 acc[2][2];
#pragma unroll
        for (int mi = 0; mi < 2; ++mi)
#pragma unroll
            for (int ni = 0; ni < 2; ++ni)
#pragma unroll
                for (int r = 0; r < 16; ++r) acc[mi][ni][r] = 0.f;
        for (int kt = 0; kt < nk; ++kt) {
            const int cur = (kt & 1) * 32768;
            if (kt + 1 < nk || has_next) asm volatile("s_waitcnt vmcnt(8)" ::: "memory"); else asm volatile("s_waitcnt vmcnt(0)" ::: "memory");
            __builtin_amdgcn_s_barrier();
            asm volatile("" ::: "memory");
            bf16x8 af[4][2], bfr[4][2];
            long a8[8][2], b8[8][2];
            if (!FP8) {
#pragma unroll
            for (int ks = 0; ks < 4; ++ks) {
                const int co = ((ks * 2 + fh) ^ g) << 4;
#pragma unroll
                for (int mi = 0; mi < 2; ++mi) af[ks][mi] = *(const bf16x8*)(ra + cur + mi * 4096 + co);
#pragma unroll
                for (int ni = 0; ni < 2; ++ni) bfr[ks][ni] = *(const bf16x8*)(rb + cur + ni * 4096 + co);
            }
            } else {
#pragma unroll
            for (int ks = 0; ks < 8; ++ks) {
                const int co = ((ks ^ g) << 4) + fh * 8;
#pragma unroll
                for (int mi = 0; mi < 2; ++mi) a8[ks][mi] = *(const long*)(ra + cur + mi * 4096 + co);
#pragma unroll
                for (int ni = 0; ni < 2; ++ni) b8[ks][ni] = *(const long*)(rb + cur + ni * 4096 + co);
            }
            }
            asm volatile("s_waitcnt lgkmcnt(0)" ::: "memory");
            __builtin_amdgcn_sched_barrier(0);
            __builtin_amdgcn_s_barrier();
            asm volatile("" ::: "memory");
            __builtin_amdgcn_sched_barrier(0);
            int ko = -1;
            if (kt + 2 < nk) ko = (kt + 2) * 64;
            else if (has_next) {
                if (kt + 2 == nk) {
                    nx = prep(t + tstep);
#pragma unroll
                    for (int i = 0; i < 4; ++i) { ap[i] = arow(nx, i * 32 + srow) + sch * 8; bp[i] = brow(nx, i * 32 + srow) + sch * 8; }
                }
                ko = (kt + 2 - nk) * 64;
            }
            if (FP8) {
#pragma unroll
                for (int ks = 0; ks < 8; ++ks) {
                    if (ko >= 0) { if (ks & 1) glds16(bp[ks >> 1] + ko, dst + cur + 16384 + (ks >> 1) * 4096); else glds16(ap[ks >> 1] + ko, dst + cur + (ks >> 1) * 4096); }
                    acc[0][0] = __builtin_amdgcn_mfma_f32_32x32x16_fp8_fp8(a8[ks][0], b8[ks][0], acc[0][0], 0, 0, 0);
                    acc[0][1] = __builtin_amdgcn_mfma_f32_32x32x16_fp8_fp8(a8[ks][0], b8[ks][1], acc[0][1], 0, 0, 0);
                    acc[1][0] = __builtin_amdgcn_mfma_f32_32x32x16_fp8_fp8(a8[ks][1], b8[ks][0], acc[1][0], 0, 0, 0);
                    acc[1][1] = __builtin_amdgcn_mfma_f32_32x32x16_fp8_fp8(a8[ks][1], b8[ks][1], acc[1][1], 0, 0, 0);
                    __builtin_amdgcn_sched_barrier(0);
                }
            } else
#pragma unroll
            for (int ks = 0; ks < 4; ++ks) {
                if (ko >= 0) { glds16(ap[ks] + ko, dst + cur + ks * 4096); }
                acc[0][0] = __builtin_amdgcn_mfma_f32_32x32x16_bf16(af[ks][0], bfr[ks][0], acc[0][0], 0, 0, 0);
                acc[0][1] = __builtin_amdgcn_mfma_f32_32x32x16_bf16(af[ks][0], bfr[ks][1], acc[0][1], 0, 0, 0);
                __builtin_amdgcn_sched_barrier(0);
                if (ko >= 0) { glds16(bp[ks] + ko, dst + cur + 16384 + ks * 4096); }
                acc[1][0] = __builtin_amdgcn_mfma_f32_32x32x16_bf16(af[ks][1], bfr[ks][0], acc[1][0], 0, 0, 0);
                acc[1][1] = __builtin_amdgcn_mfma_f32_32x32x16_bf16(af[ks][1], bfr[ks][1], acc[1][1], 0, 0, 0);
                __builtin_amdgcn_sched_barrier(0);
            }
        }
        epi(cx, acc);
        cx = nx;
    }
    __builtin_amdgcn_s_barrier();
    asm volatile("" ::: "memory");
}
DEV int vblock() { const int G = gridDim.x, bx = blockIdx.x; return (G % 8 == 0) ? (bx % 8) * (G / 8) + bx / 8 : bx; }
#define ACC_FOREACH(mi, ni, r, row, col) \
    _Pragma("unroll") for (int mi = 0; mi < 2; ++mi) _Pragma("unroll") for (int ni = 0; ni < 2; ++ni) _Pragma("unroll") for (int r = 0; r < 16; ++r) \
        for (int row = (tid >> 7) * 64 + mi * 32 + (r & 3) + 8 * (r >> 2) + 4 * ((tid & 63) >> 5), col = ((tid >> 6) & 1) * 64 + ni * 32 + (tid & 31), once_ = 1; once_; once_ = 0)

template <class ARow, class Epi>
DEV void gemm_naive_tile(float* lds, int K, ARow arow, const float* W, int ldw, int col0, int ncols, Epi epi) {
    const int tid = get_tid(), ty = tid >> 4, tx = tid & 15;
    float* sA = lds;
    float* sB = lds + 16 * 68;
    const int ar = tid >> 2, kq = (tid & 3) * 4;
    const bf16_t* ap = arow(ar);
    const int kr = tid >> 4, c4 = (tid & 15) * 4;
    const bool cok = (col0 + c4) < ncols;
    float acc[4][4];
#pragma unroll
    for (int i = 0; i < 4; ++i)
#pragma unroll
        for (int j = 0; j < 4; ++j) acc[i][j] = 0.f;
    for (int k0 = 0; k0 < K; k0 += 16) {
        const u32x2 av = *(const u32x2*)(ap + k0 + kq);
        f32x4 wv = {0.f, 0.f, 0.f, 0.f};
        if (cok) wv = *(const f32x4*)(W + (size_t)(k0 + kr) * ldw + col0 + c4);
        sA[(kq + 0) * 68 + ar] = __uint_as_float(av.x << 16);
        sA[(kq + 1) * 68 + ar] = __uint_as_float(av.x & 0xffff0000u);
        sA[(kq + 2) * 68 + ar] = __uint_as_float(av.y << 16);
        sA[(kq + 3) * 68 + ar] = __uint_as_float(av.y & 0xffff0000u);
        *(f32x4*)(sB + kr * 64 + c4) = wv;
        __syncthreads();
#pragma unroll 4
        for (int k = 0; k < 16; ++k) {
            const f32x4 a4 = *(const f32x4*)(sA + k * 68 + ty * 4), b4 = *(const f32x4*)(sB + k * 64 + tx * 4);
            const float aa[4] = {a4.x, a4.y, a4.z, a4.w}, bb[4] = {b4.x, b4.y, b4.z, b4.w};
#pragma unroll
            for (int i = 0; i < 4; ++i)
#pragma unroll
                for (int j = 0; j < 4; ++j) acc[i][j] += aa[i] * bb[j];
        }
        __syncthreads();
    }
#pragma unroll
    for (int i = 0; i < 4; ++i)
#pragma unroll
        for (int j = 0; j < 4; ++j) { const int col = col0 + tx * 4 + j; if (col < ncols) epi(ty * 4 + i, col, acc[i][j]); }
}

DEV void ph_inproj(const KArgs& a, int layer, unsigned char* lds) {
    const int tid = get_tid();
    const bf16_t* hn = (const bf16_t*)(a.ws + WS_HN);
    bf16_t* z = (bf16_t*)(a.ws + WS_Z);
    const bf16_t* WT = (const bf16_t*)(a.ws + WS_WINT) + (size_t)layer * DIN * D;
    constexpr int ntn = (DIN + 127) / 128, nlat = (TL / 128) * ntn, ncn = ntn - OFF_BK / 128;
    const int ntiles = layer == 0 ? (TA / 128) * ntn : nlat + (TC / 128) * ncn;
    struct Cx { int row0, col0; };
    auto prep = [&](int t) { Cx c;
        if (layer == 0 || t < nlat) { c.row0 = (t / ntn) * 128; c.col0 = (t % ntn) * 128; }
        else { const int u = t - nlat; c.row0 = TL + (u / ncn) * 128; c.col0 = OFF_BK + (u % ncn) * 128; }
        return c; };
    gemm_stream(lds, D / 64, vblock(), gridDim.x, ntiles, prep,
        [&](const Cx& c, int r) { int n = c.col0 + r; n = n < DIN ? n : DIN - 1; return WT + (size_t)n * D; },
        [&](const Cx& c, int r) { return hn + (size_t)(c.row0 + r) * D; },
        [&](const Cx& c, const f32x16 (&acc)[2][2]) {
            const int row0 = c.row0, col0 = c.col0;
            const int wr = tid >> 7, wc = (tid >> 6) & 1, lane = tid & 63;
#pragma unroll
            for (int ni = 0; ni < 2; ++ni) {
                bf16_t* zr = z + (size_t)(row0 + wc * 64 + ni * 32 + (lane & 31)) * DIN + col0;
#pragma unroll
                for (int mi = 0; mi < 2; ++mi)
#pragma unroll
                    for (int kp = 0; kp < 2; ++kp) {
                        u32x2 wa, wb;
                        wa.x = pk2(acc[mi][ni][8 * kp], acc[mi][ni][8 * kp + 1]); wa.y = pk2(acc[mi][ni][8 * kp + 2], acc[mi][ni][8 * kp + 3]);
                        wb.x = pk2(acc[mi][ni][8 * kp + 4], acc[mi][ni][8 * kp + 5]); wb.y = pk2(acc[mi][ni][8 * kp + 6], acc[mi][ni][8 * kp + 7]);
                        const u32x4 w = widen_pair(wa, wb);
                        const int n = wr * 64 + mi * 32 + 16 * kp + 8 * (lane >> 5);
                        if (col0 + n < DIN) *(u32x4*)(zr + n) = w;
                    }
            }
        });
}

DEV void ph_outproj(const KArgs& a, int layer, int nrows, unsigned char* lds) {
    const int tid = get_tid();
    const bf16_t* mix = (const bf16_t*)(a.ws + WS_MIX);
    float* hws = (float*)(a.ws + WS_H);
    const float* mod = (const float*)(a.ws + WS_MOD);
    const bf16_t* WT = (const bf16_t*)(a.ws + WS_WOUTT) + (size_t)layer * D * D;
    constexpr int ntn = D / 128;
    gemm_stream(lds, D / 64, vblock(), gridDim.x, (nrows / 128) * ntn, [](int t) { return t; },
        [&](int t, int r) { return mix + (size_t)((t / ntn) * 128 + r) * D; },
        [&](int t, int r) { return WT + (size_t)((t % ntn) * 128 + r) * D; },
        [&](int t, const f32x16 (&acc)[2][2]) {
            const int row0 = (t / ntn) * 128, col0 = (t % ntn) * 128;
            const int bi = mod_index(row0);
            const float* g1 = mod + (size_t)(layer * 17 + bi) * 6144 + 2 * D + col0;
            const int wr = tid >> 7, wc = (tid >> 6) & 1, lane = tid & 63;
            const float g1a = g1[wc * 64 + (lane & 31)], g1b = g1[wc * 64 + 32 + (lane & 31)];
            const float* resb = (layer == 0 ? (row0 < TL ? a.in[I_X] + (size_t)row0 * D : a.in[I_CTX] + (size_t)(row0 - TL) * D) : hws + (size_t)row0 * D) + col0 + wc * 64 + (lane & 31);
            float* outb = hws + (size_t)row0 * D + col0 + wc * 64 + (lane & 31);
            float resc[8], resn[8];
#define OP_RO(b) ((size_t)(wr * 64 + ((b) >> 2) * 32 + 16 * ((b) & 1) + 4 * (lane >> 5)) * D + (((b) >> 1) & 1) * 32)
#pragma unroll
            for (int r = 0; r < 8; ++r) resc[r] = __builtin_nontemporal_load(resb + OP_RO(0) + (size_t)((r & 3) + 8 * (r >> 2)) * D);
#pragma unroll
            for (int b = 0; b < 8; ++b) {
                const int mi = b >> 2, ni = (b >> 1) & 1, hq = b & 1;
                if (b + 1 < 8) {
#pragma unroll
                    for (int r = 0; r < 8; ++r) resn[r] = __builtin_nontemporal_load(resb + OP_RO(b + 1) + (size_t)((r & 3) + 8 * (r >> 2)) * D);
                }
                asm volatile("" ::: "memory");
#pragma unroll
                for (int r = 0; r < 8; ++r) outb[OP_RO(b) + (size_t)((r & 3) + 8 * (r >> 2)) * D] = resc[r] + (ni ? g1b : g1a) * acc[mi][ni][8 * hq + r];
                asm volatile("" ::: "memory");
#pragma unroll
                for (int r = 0; r < 8; ++r) resc[r] = resn[r];
            }
#undef OP_RO
        });
}

DEV bf16x8 tr_frag_at(unsigned base, int RS, int c, int ks, int lane);
DEV void unpack8(const u32x4 v, float* f);
DEV void ph_spatial(const KArgs& a, int layer, int nrows, unsigned char* lds) {
    const int tid = get_tid(), lane = tid & 63, wid = tid >> 6, wr = wid >> 1, wc = wid & 1, fr = lane & 31, fh = lane >> 5;
    const bf16_t* z = (const bf16_t*)(a.ws + WS_Z);
    bf16_t* mix = (bf16_t*)(a.ws + WS_MIX);
    unsigned char* vs = lds;
    const unsigned vs_a = (unsigned)(size_t)vs;
    const int nitems = (nrows / 128) * 4;
    for (int item = vblock(); item < nitems; item += gridDim.x) {
        const int ci = item >> 2, g = item & 3, row0 = ci * 128;
        const int l8 = tid & 7, tk = tid >> 3;
        float lgv[16], lbv[16];
#pragma unroll
        for (int j = 0; j < 4; ++j) {
            const f32x4 g4 = *(const f32x4*)(a.in[I_LNG] + layer * 512 + g * 128 + l8 * 16 + 4 * j), b4 = *(const f32x4*)(a.in[I_LNB] + layer * 512 + g * 128 + l8 * 16 + 4 * j);
            lgv[4 * j] = g4.x; lgv[4 * j + 1] = g4.y; lgv[4 * j + 2] = g4.z; lgv[4 * j + 3] = g4.w; lbv[4 * j] = b4.x; lbv[4 * j + 1] = b4.y; lbv[4 * j + 2] = b4.z; lbv[4 * j + 3] = b4.w;
        }
#pragma unroll 2
        for (int pass = 0; pass < 4; ++pass) {
            const int tok = pass * 32 + tk;
            const bf16_t* zp = z + (size_t)(row0 + tok) * DIN + OFF_AV + g * 128 + l8 * 16;
            float x[16];
            unpack8(*(const u32x4*)zp, x); unpack8(*(const u32x4*)(zp + 8), x + 8);
            float sm = 0.f;
#pragma unroll
            for (int j = 0; j < 16; ++j) { x[j] = gelu_f(x[j]); sm += x[j]; }
            sm += __shfl_xor(sm, 1); sm += __shfl_xor(sm, 2); sm += __shfl_xor(sm, 4);
            const float mu = sm * (1.f / 128.f);
            float q = 0.f;
#pragma unroll
            for (int j = 0; j < 16; ++j) { x[j] -= mu; q += x[j] * x[j]; }
            q += __shfl_xor(q, 1); q += __shfl_xor(q, 2); q += __shfl_xor(q, 4);
            const float rs = rsqrtf(q * (1.f / 128.f) + EPS);
            u32x4 w0, w1;
            w0.x = pk2(x[0] * rs * lgv[0] + lbv[0], x[1] * rs * lgv[1] + lbv[1]); w0.y = pk2(x[2] * rs * lgv[2] + lbv[2], x[3] * rs * lgv[3] + lbv[3]);
            w0.z = pk2(x[4] * rs * lgv[4] + lbv[4], x[5] * rs * lgv[5] + lbv[5]); w0.w = pk2(x[6] * rs * lgv[6] + lbv[6], x[7] * rs * lgv[7] + lbv[7]);
            w1.x = pk2(x[8] * rs * lgv[8] + lbv[8], x[9] * rs * lgv[9] + lbv[9]); w1.y = pk2(x[10] * rs * lgv[10] + lbv[10], x[11] * rs * lgv[11] + lbv[11]);
            w1.z = pk2(x[12] * rs * lgv[12] + lbv[12], x[13] * rs * lgv[13] + lbv[13]); w1.w = pk2(x[14] * rs * lgv[14] + lbv[14], x[15] * rs * lgv[15] + lbv[15]);
            *(u32x4*)(vs + tok * 320 + l8 * 32) = w0; *(u32x4*)(vs + tok * 320 + l8 * 32 + 16) = w1;
        }
        __syncthreads();
        const bf16_t* wsp = (const bf16_t*)(a.ws + WS_WSP) + (size_t)(layer * 4 + g) * 128 * 128;
        f32x16 acc[2][2];
#pragma unroll
        for (int mi = 0; mi < 2; ++mi)
#pragma unroll
            for (int ni = 0; ni < 2; ++ni)
#pragma unroll
                for (int r = 0; r < 16; ++r) acc[mi][ni][r] = 0.f;
#pragma unroll 2
        for (int ks = 0; ks < 8; ++ks) {
            bf16x8 af[2], bfr[2];
#pragma unroll
            for (int mi = 0; mi < 2; ++mi) af[mi] = *(const bf16x8*)(wsp + (wr * 64 + mi * 32 + fr) * 128 + ks * 16 + fh * 8);
#pragma unroll
            for (int ni = 0; ni < 2; ++ni) bfr[ni] = tr_frag_at(vs_a, 320, wc * 2 + ni, ks, lane);
#pragma unroll
            for (int mi = 0; mi < 2; ++mi)
#pragma unroll
                for (int ni = 0; ni < 2; ++ni) acc[mi][ni] = __builtin_amdgcn_mfma_f32_32x32x16_bf16(af[mi], bfr[ni], acc[mi][ni], 0, 0, 0);
        }
        __syncthreads();
        ACC_FOREACH(mi, ni, r, row, col) { *(bf16_t*)(vs + row * 272 + col * 2) = f2bf(acc[mi][ni][r]); }
        __syncthreads();
        {
            const int p = tid >> 1, c0 = (tid & 1) * 64;
            const float bs = a.in[I_BSP][(layer * 4 + g) * 128 + p];
            const bf16_t* zu = z + (size_t)(row0 + p) * DIN + OFF_AU + g * 128 + c0;
            bf16_t* mo = mix + (size_t)(row0 + p) * D + g * 128 + c0;
            u32x4 zuv[8];
#pragma unroll
            for (int j = 0; j < 8; ++j) zuv[j] = *(const u32x4*)(zu + 8 * j);
#pragma unroll 2
            for (int j = 0; j < 8; ++j) {
                float uf[8], sf[8];
                unpack8(zuv[j], uf); unpack8(*(const u32x4*)(vs + p * 272 + (c0 + 8 * j) * 2), sf);
                u32x4 w;
                w.x = pk2(gelu_f(uf[0]) * (sf[0] + bs), gelu_f(uf[1]) * (sf[1] + bs)); w.y = pk2(gelu_f(uf[2]) * (sf[2] + bs), gelu_f(uf[3]) * (sf[3] + bs));
                w.z = pk2(gelu_f(uf[4]) * (sf[4] + bs), gelu_f(uf[5]) * (sf[5] + bs)); w.w = pk2(gelu_f(uf[6]) * (sf[6] + bs), gelu_f(uf[7]) * (sf[7] + bs));
                *(u32x4*)(mo + 8 * j) = w;
            }
        }
        __syncthreads();
    }
}

constexpr int GLA_LA_STRIDE = 65, GLA_VT_RS = 320, GLA_KD_RS = 192, GLA_QK_RS = 144;
constexpr int GLA_OFF_LA = 0, GLA_OFF_QE = 16896, GLA_OFF_KE = 16896 + 9216, GLA_OFF_VT = 16896 + 2 * 9216, GLA_OFF_WU = GLA_OFF_VT + 64 * GLA_VT_RS, GLA_OFF_TOT = GLA_OFF_WU + 2 * 4352, GLA_OFF_END = GLA_OFF_TOT + 1280;
static_assert(64 * GLA_LA_STRIDE * 4 <= GLA_OFF_QE && GLA_OFF_END <= 65536 + 768 && 64 * 132 * 4 <= GLA_OFF_VT && 64 * GLA_KD_RS <= 2 * 9216, "GLA LDS map");
DEV void gla_chunk_coords(int ci, int& row0, int& b, int& slot) {
    if (ci < 512) { row0 = ci * 64; b = ci >> 5; slot = 4 + (ci & 31); } else { const int c = ci - 512; row0 = TL + c * 64; b = c >> 2; slot = c & 3; }
}
DEV bf16x8 tr_frag(unsigned a0, unsigned a1) {
    u32x2 lo, hi;
    asm volatile("ds_read_b64_tr_b16 %0, %2\n\tds_read_b64_tr_b16 %1, %3\n\ts_waitcnt lgkmcnt(0)" : "=&v"(lo), "=&v"(hi) : "v"(a0), "v"(a1) : "memory");
    u32x4 w; w.x = lo.x; w.y = lo.y; w.z = hi.x; w.w = hi.y;
    return __builtin_bit_cast(bf16x8, w);
}
DEV bf16x8 tr_frag_at(unsigned base, int RS, int c, int ks, int lane) {
    const int h = lane >> 5, blk = (lane >> 4) & 1, q = (lane & 15) >> 2, p = lane & 3;
    const unsigned a0 = base + (unsigned)((16 * ks + 8 * h + q) * RS + (32 * c + 16 * blk + 4 * p) * 2);
    return tr_frag(a0, a0 + 4u * (unsigned)RS);
}
DEV void unpack8(const u32x4 v, float* f) {
    f[0] = __uint_as_float(v.x << 16); f[1] = __uint_as_float(v.x & 0xffff0000u); f[2] = __uint_as_float(v.y << 16); f[3] = __uint_as_float(v.y & 0xffff0000u);
    f[4] = __uint_as_float(v.z << 16); f[5] = __uint_as_float(v.z & 0xffff0000u); f[6] = __uint_as_float(v.w << 16); f[7] = __uint_as_float(v.w & 0xffff0000u);
}
DEV void gla_stage_gate(const KArgs& a, int layer, int dir, int h, float* swu, int tid) {
    bf16_t* hi = (bf16_t*)swu; bf16_t* lo = hi + 1024; float* bias = swu + 1024;
    for (int i = tid; i < 16 * 64; i += 256) {
        const int k = i >> 6, d = i & 63;
        const float w = a.in[I_WGU][((size_t)(layer * 2 + dir) * 16 + k) * 256 + h * 64 + d];
        const bf16_t wh = f2bf(w);
        hi[d * 16 + k] = wh; lo[d * 16 + k] = f2bf(w - bf2f(wh));
    }
    if (tid < 64) bias[tid] = a.in[I_BG][(layer * 2 + dir) * 256 + h * 64 + tid];
}
DEV void gla_logdecay(const bf16x8 zfrag, const float* swu, float* la, int tid) {
    const int lane = tid & 63, wid = tid >> 6, fr = lane & 31, fh = lane >> 5, dt = (wid & 1) * 32, tt = (wid >> 1) * 32;
    const bf16_t* hi = (const bf16_t*)swu; const bf16_t* lo = hi + 1024; const float* bias = swu + 1024;
    const bf16x8 bh = *(const bf16x8*)(hi + (dt + fr) * 16 + fh * 8), bl = *(const bf16x8*)(lo + (dt + fr) * 16 + fh * 8);
    f32x16 acc;
#pragma unroll
    for (int r = 0; r < 16; ++r) acc[r] = 0.f;
    acc = __builtin_amdgcn_mfma_f32_32x32x16_bf16(zfrag, bl, acc, 0, 0, 0);
    acc = __builtin_amdgcn_mfma_f32_32x32x16_bf16(zfrag, bh, acc, 0, 0, 0);
    const float bb = bias[dt + fr];
#pragma unroll
    for (int r = 0; r < 16; ++r) la[(tt + (r & 3) + 8 * (r >> 2) + 4 * fh) * GLA_LA_STRIDE + dt + fr] = logsigmoid_f(acc[r] + bb) * (1.f / 16.f);
}
DEV void gla_cumsum(float* la, float* tot, int dir, int tid) {
    const int d = tid & 63, sg = tid >> 6;
    float v[16];
#pragma unroll
    for (int t = 0; t < 16; ++t) v[t] = la[(sg * 16 + t) * GLA_LA_STRIDE + d];
    if (dir == 0) {
#pragma unroll
        for (int t = 1; t < 16; ++t) v[t] += v[t - 1];
        tot[sg * 64 + d] = v[15];
    } else {
#pragma unroll
        for (int t = 14; t >= 0; --t) v[t] += v[t + 1];
        tot[sg * 64 + d] = v[0];
    }
    __syncthreads();
    const float t0 = tot[d], t1 = tot[64 + d], t2 = tot[128 + d], t3 = tot[192 + d];
    float off;
    if (dir == 0) off = (sg > 0 ? t0 : 0.f) + (sg > 1 ? t1 : 0.f) + (sg > 2 ? t2 : 0.f);
    else off = (sg < 3 ? t3 : 0.f) + (sg < 2 ? t2 : 0.f) + (sg < 1 ? t1 : 0.f);
    if (sg == 0) tot[256 + d] = (t0 + t1) + (t2 + t3);
#pragma unroll
    for (int t = 0; t < 16; ++t) la[(sg * 16 + t) * GLA_LA_STRIDE + d] = v[t] + off;
    __syncthreads();
}
DEV void gla_store_v(const u32x4 (&vr)[4], unsigned char* vt, int tid) {
    const int i = tid >> 2, e0 = (tid & 3) * 32;
#pragma unroll
    for (int j = 0; j < 4; ++j) *(u32x4*)(vt + i * GLA_VT_RS + (e0 + 8 * j) * 2) = vr[j];
}

DEV void ph_gla_kv(const KArgs& a, int layer, unsigned char* lds) {
    const int tid = get_tid(), lane = tid & 63, wid = tid >> 6;
    const bf16_t* z = (const bf16_t*)(a.ws + WS_Z);
    bf16_t* kvo = (bf16_t*)(a.ws + WS_KV);
    float* dco = (float*)(a.ws + WS_DECAY);
    float* la = (float*)(lds + GLA_OFF_LA); unsigned char* kdt = lds + GLA_OFF_QE; unsigned char* vt = lds + GLA_OFF_VT;
    float* swu = (float*)(lds + GLA_OFF_WU); float* tot = (float*)(lds + GLA_OFF_TOT);
    const unsigned vt_a = (unsigned)(size_t)vt, kd_a = (unsigned)(size_t)kdt;
    const int vb = vblock(), h = vb & 3;
    gla_stage_gate(a, layer, 0, h, swu, tid); gla_stage_gate(a, layer, 1, h, swu + 1088, tid);
    __syncthreads();
    const int i = tid >> 2, d0 = (tid & 3) * 16, e0 = (tid & 3) * 32;
    for (int item = vb; item < 576 * 4; item += gridDim.x) {
        const int ci = item >> 2;
        int row0, b, slot; gla_chunk_coords(ci, row0, b, slot);
        const bf16_t* zr = z + (size_t)(row0 + i) * DIN;
        const bf16_t* zgp = z + (size_t)(row0 + (wid >> 1) * 32 + (lane & 31)) * DIN + OFF_BG + (lane >> 5) * 8;
        const bf16x8 zf0 = *(const bf16x8*)zgp, zf1 = *(const bf16x8*)(zgp + 16);
        const u32x4 kr0 = *(const u32x4*)(zr + OFF_BK + h * 64 + d0), kr1 = *(const u32x4*)(zr + OFF_BK + h * 64 + d0 + 8);
        u32x4 vr[4];
#pragma unroll
        for (int j = 0; j < 4; ++j) vr[j] = *(const u32x4*)(zr + OFF_BV + h * 128 + e0 + 8 * j);
        gla_store_v(vr, vt, tid);
#pragma unroll 1
        for (int dir = 0; dir < 2; ++dir) {
            gla_logdecay(dir ? zf1 : zf0, swu + dir * 1088, la, tid);
            __syncthreads();
            gla_cumsum(la, tot, dir, tid);
            const size_t tile = (size_t)(((dir * NB + b) * 4 + h) * 36 + slot);
            {
                float kf[16];
                unpack8(kr0, kf); unpack8(kr1, kf + 8);
#pragma unroll
                for (int dd = 0; dd < 16; ++dd) kf[dd] *= __expf(tot[256 + d0 + dd] - la[i * GLA_LA_STRIDE + d0 + dd]);
                u32x4 w0, w1;
                w0.x = pk2(kf[0], kf[1]); w0.y = pk2(kf[2], kf[3]); w0.z = pk2(kf[4], kf[5]); w0.w = pk2(kf[6], kf[7]);
                w1.x = pk2(kf[8], kf[9]); w1.y = pk2(kf[10], kf[11]); w1.z = pk2(kf[12], kf[13]); w1.w = pk2(kf[14], kf[15]);
                *(u32x4*)(kdt + i * GLA_KD_RS + d0 * 2) = w0; *(u32x4*)(kdt + i * GLA_KD_RS + d0 * 2 + 16) = w1;
                if (tid < 64) dco[tile * 64 + tid] = __expf(tot[256 + tid]);
            }
            __syncthreads();
            f32x16 acc[2];
#pragma unroll
            for (int nt = 0; nt < 2; ++nt)
#pragma unroll
                for (int r = 0; r < 16; ++r) acc[nt][r] = 0.f;
#pragma unroll
            for (int ks = 0; ks < 4; ++ks) {
                const bf16x8 af = tr_frag_at(vt_a, GLA_VT_RS, wid, ks, lane);
#pragma unroll
                for (int nt = 0; nt < 2; ++nt) { const bf16x8 bfr = tr_frag_at(kd_a, GLA_KD_RS, nt, ks, lane); acc[nt] = __builtin_amdgcn_mfma_f32_32x32x16_bf16(af, bfr, acc[nt], 0, 0, 0); }
            }
            bf16_t* out = kvo + tile * 8192;
#pragma unroll
            for (int nt = 0; nt < 2; ++nt)
#pragma unroll
                for (int r = 0; r < 16; ++r) { const int e = wid * 32 + (r & 3) + 8 * (r >> 2) + 4 * (lane >> 5); out[e * 64 + nt * 32 + (lane & 31)] = f2bf(acc[nt][r]); }
            __syncthreads();
        }
    }
}

DEV void ph_gla_scan(const KArgs& a) {
    const int tid = get_tid();
    const bf16_t* kv = (const bf16_t*)(a.ws + WS_KV);
    const float* dc = (const float*)(a.ws + WS_DECAY);
    bf16_t* sp = (bf16_t*)(a.ws + WS_HN);
    for (int item = blockIdx.x; item < 2 * NB * 4 * 8; item += gridDim.x) {
        const int dbh = item >> 3, sub = item & 7, dir = dbh >> 6;
        const int e = sub * 16 + (tid >> 4), dq = (tid & 15) * 4;
        f32x4 S = {0.f, 0.f, 0.f, 0.f};
#pragma unroll 1
        for (int s0 = 0; s0 < 36; s0 += 12) {
            u32x2 kvr[12]; f32x4 dcv[12];
#pragma unroll
            for (int q = 0; q < 12; ++q) {
                const int step = s0 + q, slot = dir == 0 ? step : (step < 4 ? 3 - step : 39 - step);
                const size_t tile = (size_t)dbh * 36 + slot;
                kvr[q] = __builtin_nontemporal_load((const u32x2*)(kv + tile * 8192 + e * 64 + dq)); dcv[q] = *(const f32x4*)(dc + tile * 64 + dq);
            }
#pragma unroll
            for (int q = 0; q < 12; ++q) {
                const int step = s0 + q, slot = dir == 0 ? step : (step < 4 ? 3 - step : 39 - step);
                const size_t tile = (size_t)dbh * 36 + slot;
                const f32x4 kvv = {__uint_as_float(kvr[q].x << 16), __uint_as_float(kvr[q].x & 0xffff0000u), __uint_as_float(kvr[q].y << 16), __uint_as_float(kvr[q].y & 0xffff0000u)};
                u32x2 w; w.x = pk2(S.x, S.y); w.y = pk2(S.z, S.w);
                *(u32x2*)(sp + tile * 8192 + e * 64 + dq) = w;
                S = dcv[q] * S + kvv;
            }
        }
    }
}

DEV void ph_gla_out(const KArgs& a, int layer, unsigned char* lds) {
    const int tid = get_tid(), lane = tid & 63, wid = tid >> 6, ih = wid >> 1, eh = wid & 1, fr = lane & 31, fh = lane >> 5;
    const bf16_t* z = (const bf16_t*)(a.ws + WS_Z);
    const bf16_t* sp = (const bf16_t*)(a.ws + WS_HN);
    bf16_t* mix = (bf16_t*)(a.ws + WS_MIX);
    float* la = (float*)(lds + GLA_OFF_LA); unsigned char* att = lds + GLA_OFF_LA; unsigned char* qet = lds + GLA_OFF_QE; unsigned char* ket = lds + GLA_OFF_KE; unsigned char* vt = lds + GLA_OFF_VT;
    float* swu = (float*)(lds + GLA_OFF_WU); float* tot = (float*)(lds + GLA_OFF_TOT); float* ob = (float*)lds;
    const unsigned vt_a = (unsigned)(size_t)vt;
    const int nchunks = layer == 0 ? 576 : 512;
    const int vb = vblock(), h = vb & 3;
    gla_stage_gate(a, layer, 0, h, swu, tid); gla_stage_gate(a, layer, 1, h, swu + 1088, tid);
    __syncthreads();
    const int i = tid >> 2, d0 = (tid & 3) * 16, e0 = (tid & 3) * 32;
    for (int item = vb; item < nchunks * 4; item += gridDim.x) {
        const int ci = item >> 2;
        int row0, b, slot; gla_chunk_coords(ci, row0, b, slot);
        const bf16_t* zr = z + (size_t)(row0 + i) * DIN;
        const bf16_t* zgp = z + (size_t)(row0 + (wid >> 1) * 32 + (lane & 31)) * DIN + OFF_BG + (lane >> 5) * 8;
        const bf16x8 zf0 = *(const bf16x8*)zgp, zf1 = *(const bf16x8*)(zgp + 16);
        const u32x4 qr0 = *(const u32x4*)(zr + OFF_BQ + h * 64 + d0), qr1 = *(const u32x4*)(zr + OFF_BQ + h * 64 + d0 + 8);
        const u32x4 kr0 = *(const u32x4*)(zr + OFF_BK + h * 64 + d0), kr1 = *(const u32x4*)(zr + OFF_BK + h * 64 + d0 + 8);
        u32x4 vr[4], rr4[4];
#pragma unroll
        for (int j = 0; j < 4; ++j) vr[j] = *(const u32x4*)(zr + OFF_BV + h * 128 + e0 + 8 * j);
#pragma unroll
        for (int j = 0; j < 4; ++j) rr4[j] = *(const u32x4*)(zr + OFF_BR + h * 128 + e0 + 8 * j);
        gla_store_v(vr, vt, tid);
        f32x16 acc[2];
#pragma unroll
        for (int nt = 0; nt < 2; ++nt)
#pragma unroll
            for (int r = 0; r < 16; ++r) acc[nt][r] = 0.f;
#pragma unroll 1
        for (int dir = 0; dir < 2; ++dir) {
            gla_logdecay(dir ? zf1 : zf0, swu + dir * 1088, la, tid);
            __syncthreads();
            gla_cumsum(la, tot, dir, tid);
            {
                float qf[16], kf[16];
                unpack8(qr0, qf); unpack8(qr1, qf + 8); unpack8(kr0, kf); unpack8(kr1, kf + 8);
#pragma unroll
                for (int dd = 0; dd < 16; ++dd) { const float bb = la[i * GLA_LA_STRIDE + d0 + dd]; qf[dd] *= 0.125f * __expf(bb); kf[dd] *= __expf(-bb); }
                u32x4 w0, w1;
                w0.x = pk2(qf[0], qf[1]); w0.y = pk2(qf[2], qf[3]); w0.z = pk2(qf[4], qf[5]); w0.w = pk2(qf[6], qf[7]);
                w1.x = pk2(qf[8], qf[9]); w1.y = pk2(qf[10], qf[11]); w1.z = pk2(qf[12], qf[13]); w1.w = pk2(qf[14], qf[15]);
                *(u32x4*)(qet + i * GLA_QK_RS + d0 * 2) = w0; *(u32x4*)(qet + i * GLA_QK_RS + d0 * 2 + 16) = w1;
                w0.x = pk2(kf[0], kf[1]); w0.y = pk2(kf[2], kf[3]); w0.z = pk2(kf[4], kf[5]); w0.w = pk2(kf[6], kf[7]);
                w1.x = pk2(kf[8], kf[9]); w1.y = pk2(kf[10], kf[11]); w1.z = pk2(kf[12], kf[13]); w1.w = pk2(kf[14], kf[15]);
                *(u32x4*)(ket + i * GLA_QK_RS + d0 * 2) = w0; *(u32x4*)(ket + i * GLA_QK_RS + d0 * 2 + 16) = w1;
            }
            const bf16_t* st = sp + (size_t)(((dir * NB + b) * 4 + h) * 36 + slot) * 8192;
            bf16x8 bs[4][2];
#pragma unroll
            for (int ks = 0; ks < 4; ++ks)
#pragma unroll
                for (int nt = 0; nt < 2; ++nt) bs[ks][nt] = *(const bf16x8*)(st + (eh * 64 + nt * 32 + fr) * 64 + ks * 16 + fh * 8);
            __syncthreads();
            bf16x8 aq[4];
#pragma unroll
            for (int ks = 0; ks < 4; ++ks) aq[ks] = *(const bf16x8*)(qet + (ih * 32 + fr) * GLA_QK_RS + (ks * 16 + fh * 8) * 2);
            {
                f32x16 sa;
#pragma unroll
                for (int r = 0; r < 16; ++r) sa[r] = 0.f;
#pragma unroll
                for (int ks = 0; ks < 4; ++ks) { const bf16x8 bk = *(const bf16x8*)(ket + (eh * 32 + fr) * GLA_QK_RS + (ks * 16 + fh * 8) * 2); sa = __builtin_amdgcn_mfma_f32_32x32x16_bf16(aq[ks], bk, sa, 0, 0, 0); }
                const int j = eh * 32 + fr;
#pragma unroll
                for (int r = 0; r < 16; ++r) {
                    const int ii = ih * 32 + (r & 3) + 8 * (r >> 2) + 4 * fh;
                    const bool keep = dir == 0 ? (j <= ii) : (j >= ii);
                    *(bf16_t*)(att + ii * GLA_QK_RS + j * 2) = f2bf(keep ? sa[r] : 0.f);
                }
            }
            __syncthreads();
#pragma unroll
            for (int ks = 0; ks < 4; ++ks) {
                const bf16x8 aa = *(const bf16x8*)(att + (ih * 32 + fr) * GLA_QK_RS + (ks * 16 + fh * 8) * 2);
#pragma unroll
                for (int nt = 0; nt < 2; ++nt) {
                    const bf16x8 bv = tr_frag_at(vt_a, GLA_VT_RS, eh * 2 + nt, ks, lane);
                    acc[nt] = __builtin_amdgcn_mfma_f32_32x32x16_bf16(aa, bv, acc[nt], 0, 0, 0);
                    acc[nt] = __builtin_amdgcn_mfma_f32_32x32x16_bf16(aq[ks], bs[ks][nt], acc[nt], 0, 0, 0);
                }
            }
            __syncthreads();
        }
#pragma unroll
        for (int nt = 0; nt < 2; ++nt)
#pragma unroll
            for (int r = 0; r < 16; ++r) ob[(ih * 32 + (r & 3) + 8 * (r >> 2) + 4 * fh) * 132 + eh * 64 + nt * 32 + fr] = acc[nt][r];
        __syncthreads();
        {
            float o[32]; float ss = 0.f;
#pragma unroll
            for (int j = 0; j < 8; ++j) { const f32x4 v = *(const f32x4*)(ob + i * 132 + e0 + 4 * j); o[4 * j] = v.x; o[4 * j + 1] = v.y; o[4 * j + 2] = v.z; o[4 * j + 3] = v.w; ss += v.x * v.x + v.y * v.y + v.z * v.z + v.w * v.w; }
            ss += __shfl_xor(ss, 1); ss += __shfl_xor(ss, 2);
            const float rstd = rsqrtf(ss * (1.f / 128.f) + EPS);
            const float* gg = a.in[I_GGLA] + layer * 512 + h * 128 + e0;
            bf16_t* mo = mix + (size_t)(row0 + i) * D + 512 + h * 128 + e0;
#pragma unroll
            for (int j = 0; j < 4; ++j) {
                float rf[8]; unpack8(rr4[j], rf);
                const f32x4 g0 = *(const f32x4*)(gg + 8 * j), g1 = *(const f32x4*)(gg + 8 * j + 4);
                u32x4 w;
                w.x = pk2(o[8 * j + 0] * rstd * g0.x * silu_f(rf[0]), o[8 * j + 1] * rstd * g0.y * silu_f(rf[1]));
                w.y = pk2(o[8 * j + 2] * rstd * g0.z * silu_f(rf[2]), o[8 * j + 3] * rstd * g0.w * silu_f(rf[3]));
                w.z = pk2(o[8 * j + 4] * rstd * g1.x * silu_f(rf[4]), o[8 * j + 5] * rstd * g1.y * silu_f(rf[5]));
                w.w = pk2(o[8 * j + 6] * rstd * g1.z * silu_f(rf[6]), o[8 * j + 7] * rstd * g1.w * silu_f(rf[7]));
                *(u32x4*)(mo + 8 * j) = w;
            }
        }
        __syncthreads();
    }
}

DEV void ph_router(const KArgs& a, int layer, int nrows, unsigned char* lds) {
    const int tid = get_tid();
    const bf16_t* hn = (const bf16_t*)(a.ws + WS_HN);
    const bf16_t* WT = (const bf16_t*)(a.ws + WS_WRT) + (size_t)layer * 128 * D;
    unsigned* cnt = (unsigned*)(a.ws + WS_CTL) + layer * NE;
    unsigned* list = (unsigned*)(a.ws + WS_LIST);
    float* gate = (float*)(a.ws + WS_GATE);
    float* lgs = (float*)lds;
    for (int t = vblock(); t < nrows / 128; t += gridDim.x) {
        const int row0 = t * 128;
        f32x16 acc[2][2];
        gemm_core(lds, D / 64, [&](int r) { return hn + (size_t)(row0 + r) * D; }, [&](int r) { return WT + (size_t)r * D; }, acc);
        ACC_FOREACH(mi, ni, r, row, col) { if (col < 72) lgs[row * 73 + col] = acc[mi][ni][r]; }
        __syncthreads();
        if (tid < 128) {
            const float* lr = lgs + tid * 73; const int r = row0 + tid;
            float lg[8];
#pragma unroll
            for (int j = 0; j < 8; ++j) lg[j] = lr[j] + a.in[I_BRG][layer * 8 + j];
            float m = lg[0]; int gi = 0;
#pragma unroll
            for (int j = 1; j < 8; ++j) if (lg[j] > m) { m = lg[j]; gi = j; }
            float sum = 0.f;
#pragma unroll
            for (int j = 0; j < 8; ++j) sum += __expf(lg[j] - m);
            const float ptop = 1.f / sum;
            float le[8];
#pragma unroll
            for (int j = 0; j < 8; ++j) le[j] = lr[8 + gi * 8 + j] + a.in[I_BRE][layer * 64 + gi * 8 + j];
            float l1 = le[0]; int i1 = 0;
#pragma unroll
            for (int j = 1; j < 8; ++j) if (le[j] > l1) { l1 = le[j]; i1 = j; }
            float l2 = -3.0e38f; int i2 = 0;
#pragma unroll
            for (int j = 0; j < 8; ++j) if (j != i1 && le[j] > l2) { l2 = le[j]; i2 = j; }
            const float e2 = __expf(l2 - l1), w1 = 1.f / (1.f + e2), w2 = e2 / (1.f + e2);
            const int ex1 = gi * 8 + i1, ex2 = gi * 8 + i2;
            const unsigned p1 = atomicAdd(cnt + ex1, 1u), p2 = atomicAdd(cnt + ex2, 1u);
            list[(size_t)ex1 * LCAP + p1] = (unsigned)(2 * r); list[(size_t)ex2 * LCAP + p2] = (unsigned)(2 * r + 1);
            gate[2 * r] = ptop * w1; gate[2 * r + 1] = ptop * w2;
        }
        __syncthreads();
    }
}

DEV void ph_moe(const KArgs& a, int layer, int sub, unsigned char* lds) {
    const int tid = get_tid();
    const unsigned* cnt = (const unsigned*)(a.ws + WS_CTL) + layer * NE;
    const unsigned* list = (const unsigned*)(a.ws + WS_LIST);
    const float* gate = (const float*)(a.ws + WS_GATE);
    bf16_t* ys = (bf16_t*)(a.ws + WS_KV);
    int (*s_off)[80] = (int (*)[80])(lds + 65536);
    constexpr int ntn = 8;
    if (tid == 0) { int o = 0, t = 0; for (int e = 0; e < NE; ++e) { const int c = (int)cnt[e]; s_off[0][e] = o; s_off[1][e] = t; o += c; t += ((c + 127) / 128) * ntn; } s_off[0][NE] = o; s_off[1][NE] = t; }
    __syncthreads();
    const int ntiles = s_off[1][NE];
    struct Cx { int e, p0, nt, c, ro; };
    auto prep = [&](int t) { Cx x; int e = 0;
#pragma unroll
        for (int st = 32; st >= 1; st >>= 1) if (s_off[1][e + st] <= t) e += st;
        const int local = t - s_off[1][e]; x.e = e; x.p0 = (local / ntn) * 128; x.nt = local % ntn; x.c = (int)cnt[e]; x.ro = s_off[0][e];
        return x; };
    const int wr = tid >> 7, wc = (tid >> 6) & 1, lane = tid & 63;
    const unsigned char* hn8 = a.ws + WS_HN8;
    unsigned char* H8 = a.ws + WS_Z;
    if (sub == 0) {
        gemm_stream<true>(lds, D / 128, vblock(), gridDim.x, ntiles, prep,
            [&](const Cx& x, int r) { const int n = x.nt * 64 + (r >> 6) * 32 + (r & 31);
                                return (const bf16_t*)(a.ws + ((r >> 5) & 1 ? WS_W3T : WS_W1T) + ((size_t)x.e * DE + n) * D); },
            [&](const Cx& x, int r) { const int p = x.p0 + r; const unsigned slot = list[(size_t)x.e * LCAP + (p < x.c ? p : 0)]; return (const bf16_t*)(hn8 + (size_t)(slot >> 1) * D); },
            [&](const Cx& x, const f32x16 (&acc)[2][2]) {
                const int p0 = x.p0, nt = x.nt, c = x.c, ro = x.ro;
#pragma unroll
                for (int ni = 0; ni < 2; ++ni) {
                    const int p = p0 + wc * 64 + ni * 32 + (lane & 31);
                    unsigned char* hr = H8 + (size_t)(ro + (p < c ? p : 0)) * DE + nt * 64 + wr * 32 + 8 * (lane >> 5);
#pragma unroll
                    for (int kp = 0; kp < 2; ++kp) {
                        float hv[8];
#pragma unroll
                        for (int q = 0; q < 8; ++q) hv[q] = silu_f(acc[0][ni][8 * kp + q] * W8_INV) * (acc[1][ni][8 * kp + q] * W8_INV);
                        const unsigned wa = pk4_fp8(hv[0], hv[1], hv[2], hv[3]), wb = pk4_fp8(hv[4], hv[5], hv[6], hv[7]);
                        auto rsw = __builtin_amdgcn_permlane32_swap(wa, wb, false, false);
                        u32x2 w; w.x = rsw[0]; w.y = rsw[1];
                        if (p < c) *(u32x2*)(hr + 16 * kp) = w;
                    }
                }
            });
    } else {
        gemm_stream<true>(lds, DE / 128, vblock(), gridDim.x, ntiles, prep,
            [&](const Cx& x, int r) { return (const bf16_t*)(a.ws + WS_W2T + ((size_t)x.e * D + x.nt * 128 + r) * DE); },
            [&](const Cx& x, int r) { const int p = x.p0 + r; return (const bf16_t*)(H8 + (size_t)(x.ro + (p < x.c ? p : 0)) * DE); },
            [&](const Cx& x, const f32x16 (&acc)[2][2]) {
                const int e = x.e, p0 = x.p0, nt = x.nt, c = x.c;
                unsigned slotv[2]; float gtv[2];
#pragma unroll
                for (int ni = 0; ni < 2; ++ni) { const int p = p0 + wc * 64 + ni * 32 + (lane & 31); slotv[ni] = list[(size_t)e * LCAP + (p < c ? p : 0)]; }
#pragma unroll
                for (int ni = 0; ni < 2; ++ni) gtv[ni] = gate[slotv[ni]] * W8_INV;
#pragma unroll
                for (int ni = 0; ni < 2; ++ni) {
                    const int p = p0 + wc * 64 + ni * 32 + (lane & 31);
                    const unsigned slot = slotv[ni]; const float gt = gtv[ni] * YS_SCALE;
                    unsigned char* yo = (unsigned char*)ys + (size_t)slot * D + nt * 128 + wr * 64 + 8 * (lane >> 5);
#pragma unroll
                    for (int mi = 0; mi < 2; ++mi)
#pragma unroll
                        for (int kp = 0; kp < 2; ++kp) {
                            const unsigned wa = pk4_fp8(gt * acc[mi][ni][8 * kp], gt * acc[mi][ni][8 * kp + 1], gt * acc[mi][ni][8 * kp + 2], gt * acc[mi][ni][8 * kp + 3]);
                            const unsigned wb = pk4_fp8(gt * acc[mi][ni][8 * kp + 4], gt * acc[mi][ni][8 * kp + 5], gt * acc[mi][ni][8 * kp + 6], gt * acc[mi][ni][8 * kp + 7]);
                            auto rsw = __builtin_amdgcn_permlane32_swap(wa, wb, false, false);
                            u32x2 w; w.x = rsw[0]; w.y = rsw[1];
                            if (p < c) *(u32x2*)(yo + mi * 32 + 16 * kp) = w;
                        }
                }
            });
    }
}

#define XB_TMO      128
#define XB_XCNT(j)  (256  + 64 * (j))
#define XB_XSUB(j)  (1280 + 64 * (j))
#define XB_XGEN(j)  (2304 + 64 * (j))
#define XB_TOP      3328
#define XB_TOPGEN   3392
#define XCD_BAR_WORDS 3456
#define XB_SPIN_CAP (1u << 18)
#define LAS __attribute__((address_space(3)))
DEV unsigned xb_ld(unsigned* p)              { return __hip_atomic_load(p, __ATOMIC_RELAXED, __HIP_MEMORY_SCOPE_AGENT); }
DEV unsigned xb_add(unsigned* p, unsigned v) { return __hip_atomic_fetch_add(p, v, __ATOMIC_RELAXED, __HIP_MEMORY_SCOPE_AGENT); }
DEV unsigned xb_xcc_id() { return (unsigned)__builtin_amdgcn_s_getreg((3 << 11) | 20) & 0xFu; }
#define XB_SPIN(cond, bar) do { unsigned _sp = 0; while (cond) { __builtin_amdgcn_s_sleep(1); \
    if ((++_sp & 255u) == 0u) { if (xb_ld(&(bar)[XB_TMO])) break; if (_sp > XB_SPIN_CAP) { atomicAdd(&(bar)[XB_TMO], 1u); break; } } } } while (0)
struct XcdBarrier { unsigned* bar; unsigned x; volatile LAS unsigned* st; };
DEV XcdBarrier xcd_barrier_post(unsigned* bar, volatile LAS unsigned* st) {
    XcdBarrier b; b.bar = bar; b.x = xb_xcc_id(); b.st = st;
    if (threadIdx.x == 0) (void)xb_add(&bar[XB_XCNT(b.x)], 1u);
    return b;
}
DEV void xcd_barrier_complete(unsigned* bar, unsigned x, unsigned& nloc, unsigned& nx) {
    const unsigned G = gridDim.x * gridDim.y * gridDim.z;
    unsigned sum, cnt, mine, sp = 0u;
    for (;;) {
        sum = 0u; cnt = 0u; mine = 0u;
#pragma unroll
        for (unsigned j = 0; j < 16; ++j) { const unsigned c = xb_ld(&bar[XB_XCNT(j)]); sum += c; cnt += (c > 0u) ? 1u : 0u; mine = (j == x) ? c : mine; }
        if (sum == G) break;
        __builtin_amdgcn_s_sleep(1);
        if ((++sp & 255u) == 0u) { if (xb_ld(&bar[XB_TMO])) break; if (sp > XB_SPIN_CAP) { atomicAdd(&bar[XB_TMO], 1u); break; } }
    }
    nloc = mine > 0u ? mine : 1u; nx = cnt > 0u ? cnt : 1u;
}
DEV void xcd_barrier(const XcdBarrier& b) {
    asm volatile("s_waitcnt vmcnt(0)" ::: "memory");
    __syncthreads();
    if (threadIdx.x == 0) {
        unsigned* bar = b.bar;
        __builtin_amdgcn_s_waitcnt(0);
        unsigned nloc = b.st[0], nx = b.st[1];
        if (nloc == 0u) { xcd_barrier_complete(bar, b.x, nloc, nx); b.st[0] = nloc; b.st[1] = nx; }
        const unsigned old = xb_add(&bar[XB_XSUB(b.x)], 1u);
        const unsigned gen = old / nloc;
        if (old + 1u == (gen + 1u) * nloc) {
            __builtin_amdgcn_fence(__ATOMIC_RELEASE, "agent");
            asm volatile("s_waitcnt vmcnt(0)" ::: "memory");
            const unsigned og = xb_add(&bar[XB_TOP], 1u);
            const unsigned tg = og / nx;
            if (og + 1u == (tg + 1u) * nx) xb_add(&bar[XB_TOPGEN], 1u);
            else XB_SPIN(xb_ld(&bar[XB_TOPGEN]) == tg, bar);
            __builtin_amdgcn_fence(__ATOMIC_ACQUIRE, "agent");
            xb_add(&bar[XB_XGEN(b.x)], 1u);
            asm volatile("s_waitcnt vmcnt(0)" ::: "memory");
        } else {
            XB_SPIN(xb_ld(&bar[XB_XGEN(b.x)]) == gen, bar);
            __builtin_amdgcn_fence(__ATOMIC_ACQUIRE, "agent");
            asm volatile("s_waitcnt vmcnt(0)" ::: "memory");
        }
    }
    __syncthreads();
}

constexpr int NPH_LAYER = 10, NPH = 1 + 2 * NPH_LAYER + 1;
__global__ void __launch_bounds__(256, 2) mega(KArgs a) {
    __shared__ __attribute__((aligned(16))) unsigned char lds[65536 + 1024];
    uint4& xb_words = *(uint4*)(lds + 65536 + 768);
    cg::grid_group grid = cg::this_grid();
    const int lo = a.ph_lo, hi = a.ph_hi;
    if (threadIdx.x == 0) xb_words = make_uint4(0u, 0u, 0u, 0u);
    __syncthreads();
    const XcdBarrier xb = xcd_barrier_post((unsigned*)(a.ws + WS_CTL + 65536), (volatile LAS unsigned*)&xb_words);
    if (threadIdx.x == 0) {
        const unsigned hwid = (unsigned)__builtin_amdgcn_s_getreg((31 << 11) | 4), key = xb.x * 256u + ((hwid >> 8) & 0xffu);
        ((volatile unsigned*)&xb_words)[2] = atomicAdd((unsigned*)(a.ws + WS_CTL + 16384) + key, 1u);
    }
    __syncthreads();
    const int cu_role = __builtin_amdgcn_readfirstlane((int)(((volatile unsigned*)&xb_words)[2] & 1u));
#define GEMM_PRIO_ON()  (cu_role ? __builtin_amdgcn_s_setprio(2) : (void)0)
#define GEMM_PRIO_OFF() __builtin_amdgcn_s_setprio(0)
    if (hi < 0) grid.sync();
#define PHASE(k, call) do { const int k_ = (k); if (lo <= k_ && k_ < hi) { call; if (k_ + 1 < hi) xcd_barrier(xb); } } while (0)
    PHASE(0, (ph_prep(a, lds), convert_shared(a, lds)));
#pragma unroll 1
    for (int l = 0; l < 2; ++l) {
        const int base = 1 + l * NPH_LAYER;
        const int nrows = l == 0 ? TA : TL;
        PHASE(base + 0, ph_norm(a, l, 0, l > 0, l - 1, l == 0, TA));
        PHASE(base + 1, (GEMM_PRIO_ON(), ph_inproj(a, l, lds), GEMM_PRIO_OFF()));
        PHASE(base + 2, (blockIdx.x < (gridDim.x >> 1) ? (convert_experts(a, l, lds), __syncthreads(), ph_spatial(a, l, nrows, lds), ph_gla_kv(a, l, lds))
                                                        : (ph_spatial(a, l, nrows, lds), ph_gla_kv(a, l, lds), __syncthreads(), convert_experts(a, l, lds))));
        PHASE(base + 3, ph_gla_scan(a));
        PHASE(base + 4, ph_gla_out(a, l, lds));
        PHASE(base + 5, (GEMM_PRIO_ON(), ph_outproj(a, l, nrows, lds), GEMM_PRIO_OFF()));
        PHASE(base + 6, ph_norm(a, l, 1, false, 0, false, nrows));
        PHASE(base + 7, ph_router(a, l, nrows, lds));
        PHASE(base + 8, (GEMM_PRIO_ON(), ph_moe(a, l, 0, lds), GEMM_PRIO_OFF()));
        PHASE(base + 9, (GEMM_PRIO_ON(), ph_moe(a, l, 1, lds), GEMM_PRIO_OFF()));
    }
    PHASE(NPH - 1, ph_norm(a, 0, 2, true, 1, false, TL));
#undef PHASE
}

extern "C" void kernel_launch(void* const* d_in, const int* in_sizes, int n_in, void* d_out, int out_size, void* d_ws, size_t ws_size, hipStream_t stream) {
    static int grid = 0;
    if (grid == 0) {
        int dev = 0, cus = 0, per_cu = 0;
        hipGetDevice(&dev);
        hipDeviceGetAttribute(&cus, hipDeviceAttributeMultiprocessorCount, dev);
        hipOccupancyMaxActiveBlocksPerMultiprocessor(&per_cu, (const void*)mega, 256, 0);
        if (per_cu < 1) per_cu = 1;
        if (per_cu > 2) per_cu = 2;
        grid = cus * per_cu;
        if (n_in != 25 || ws_size < WS_END) { fprintf(stderr, "kernel_launch: unexpected n_in %d or ws_size %zu (need %zu)\n", n_in, ws_size, (size_t)WS_END); }
    }
    KArgs a{};
    for (int i = 0; i < 25; ++i) a.in[i] = (const float*)d_in[i];
    a.out = (float*)d_out; a.ws = (unsigned char*)d_ws;
    hipMemsetAsync(d_ws, 0, WS_MOD + 2 * 17 * 6144 * 4, stream);
#if ONE_LAUNCH
    a.ph_lo = 0; a.ph_hi = NPH;
    void* args[] = {&a};
    hipError_t e = hipLaunchCooperativeKernel((const void*)mega, dim3(grid), dim3(256), args, 0, stream);
    if (e != hipSuccess) fprintf(stderr, "cooperative launch failed: %s (grid %d)\n", hipGetErrorString(e), grid);
#else
    for (int ph = 0; ph < NPH; ++ph) {
        a.ph_lo = ph; a.ph_hi = ph + 1;
        hipLaunchKernelGGL(mega, dim3(grid), dim3(256), 0, stream, a);
    }
#endif
}
```

```cpp
#include <hip/hip_runtime.h>
#include <hip/hip_cooperative_groups.h>
#include <cstdio>
#include <cstdint>
namespace cg = cooperative_groups;

#ifndef ONE_LAUNCH
#define ONE_LAUNCH 1
#endif

#define DEV __device__ __forceinline__
typedef unsigned short bf16_t;
typedef float f32x4 __attribute__((ext_vector_type(4)));
typedef unsigned u32x2 __attribute__((ext_vector_type(2)));
typedef unsigned u32x4 __attribute__((ext_vector_type(4)));
typedef short bf16x8 __attribute__((ext_vector_type(8)));
typedef float f32x16 __attribute__((ext_vector_type(16)));

constexpr int D = 1024, NB = 16, SEQ = 2048, CTXL = 256;
constexpr int TL = NB * SEQ, TC = NB * CTXL, TA = TL + TC;
constexpr int DIN = 2592, OFF_AU = 0, OFF_AV = 512, OFF_BQ = 1024, OFF_BR = 1280, OFF_BK = 1792, OFF_BV = 2048, OFF_BG = 2560;
constexpr int NE = 64, DE = 512, LCAP = 2 * TA;
constexpr float EPS = 1e-6f;

constexpr size_t MiB = 1u << 20;
constexpr size_t WS_CTL = 0, WS_MOD = 1 * MiB, WS_WRT = 2 * MiB, WS_WSP = 2 * MiB + 512 * 1024, WS_WINT = 3 * MiB, WS_WOUTT = 14 * MiB,
                 WS_W1T = 18 * MiB, WS_W3T = 82 * MiB, WS_W2T = 146 * MiB, WS_H = 210 * MiB, WS_HN = 354 * MiB, WS_Z = 426 * MiB, WS_MIX = 609 * MiB,
                 WS_KV = 681 * MiB, WS_LIST = 825 * MiB, WS_GATE = 843 * MiB, WS_DECAY = 844 * MiB, WS_HN8 = 846 * MiB, WS_END = 884 * MiB;
static_assert(WS_WINT + (size_t)2 * DIN * D * 2 <= WS_WOUTT && WS_WOUTT + (size_t)2 * D * D * 2 <= WS_W1T && WS_W1T + (size_t)NE * DE * D * 2 <= WS_W3T && WS_W2T + (size_t)NE * DE * D * 2 <= WS_H, "ws map (weights)");
static_assert(WS_H + (size_t)TA * D * 4 <= WS_HN && WS_HN + (size_t)TA * D * 2 <= WS_Z && WS_Z + (size_t)TA * DIN * 2 <= WS_MIX &&
              WS_MIX + (size_t)TA * D * 2 <= WS_KV && WS_KV + (size_t)2 * TA * 512 * 4 <= WS_LIST && WS_LIST + (size_t)NE * LCAP * 4 <= WS_GATE, "ws map");

struct KArgs { const float* in[25]; float* out; unsigned char* ws; int ph_lo, ph_hi; };
enum { I_X = 0, I_C, I_CTX, I_CCTX, I_WMOD, I_BMOD, I_GN1, I_WIN, I_LNG, I_LNB, I_WSP, I_BSP, I_WGU, I_BG, I_GGLA, I_WOUT, I_GN2, I_WRG, I_BRG, I_WRE, I_BRE, I_W1, I_W3, I_W2, I_GF };

DEV float bf2f(bf16_t v) { return __uint_as_float((unsigned)v << 16); }
typedef __bf16 bf16x2_t __attribute__((ext_vector_type(2)));
DEV bf16_t f2bf(float f) { return __builtin_bit_cast(bf16_t, (__bf16)f); }
DEV unsigned pk2(float lo, float hi) { bf16x2_t v; v.x = (__bf16)lo; v.y = (__bf16)hi; return __builtin_bit_cast(unsigned, v); }
DEV u32x4 widen_pair(u32x2 a, u32x2 b) {
    auto r0 = __builtin_amdgcn_permlane32_swap(a.x, b.x, false, false); auto r1 = __builtin_amdgcn_permlane32_swap(a.y, b.y, false, false);
    u32x4 o; o.x = r0[0]; o.y = r1[0]; o.z = r0[1]; o.w = r1[1]; return o;
}
constexpr float W8_SCALE = 32.f, W8_INV = 1.f / 32.f, YS_SCALE = 16.f, YS_INV = 1.f / 16.f;
DEV unsigned pk4_fp8(float a, float b, float c, float d) { int w = 0; w = __builtin_amdgcn_cvt_pk_fp8_f32(a, b, w, false); w = __builtin_amdgcn_cvt_pk_fp8_f32(c, d, w, true); return (unsigned)w; }
DEV float silu_f(float x) { return x * __builtin_amdgcn_rcpf(1.f + __expf(-x)); }
DEV float gelu_f(float x) { const float x2 = x * x; const float u2 = x * (1.5957691216057308f + 0.07135481627f * x2); return x * __builtin_amdgcn_rcpf(1.f + __expf(-u2)); }
DEV float logsigmoid_f(float x) { return fminf(x, 0.f) - __logf(1.f + __expf(-fabsf(x))); }
DEV float wave_sum(float v) {
#pragma unroll
    for (int o = 1; o < 64; o <<= 1) v += __shfl_xor(v, o);
    return v;
}
DEV int get_tid() { int t = threadIdx.x; asm volatile("" : "+v"(t)); return t; }
DEV int mod_index(int row) { return row < TL ? (row >> 11) : 16; }

DEV void ph_prep(const KArgs& a, unsigned char* lds) {
    const int tid = get_tid(), lane = tid & 63, wid = tid >> 6;
    float* slab = (float*)lds + wid * 17 * 64;
    float* red = (float*)lds + 4 * 17 * 64;
    float* mod = (float*)(a.ws + WS_MOD);
    const float* c = a.in[I_C]; const float* cctx = a.in[I_CCTX];
    for (int item = blockIdx.x; item < 2 * 96 * 2; item += gridDim.x) {
        const int kh = item & 1, it2 = item >> 1, l = it2 / 96, j0 = (it2 % 96) * 64, j = j0 + lane;
        const float* W = a.in[I_WMOD] + (size_t)l * D * 6144;
        float acc[17];
#pragma unroll
        for (int i = 0; i < 17; ++i) acc[i] = 0.f;
#pragma unroll 1
        for (int ks = 0; ks < 2; ++ks) {
            const int kb = kh * 512 + wid * 128 + ks * 64;
#pragma unroll
            for (int bi = 0; bi < 17; ++bi) { const float x = (bi < 16) ? c[bi * D + kb + lane] : cctx[kb + lane]; slab[bi * 64 + lane] = silu_f(x); }
            __syncthreads();
#pragma unroll 1
            for (int k8 = 0; k8 < 64; k8 += 16) {
                float w[16];
#pragma unroll
                for (int u = 0; u < 16; ++u) w[u] = __builtin_nontemporal_load(W + (size_t)(kb + k8 + u) * 6144 + j);
#pragma unroll
                for (int u = 0; u < 16; ++u)
#pragma unroll
                    for (int bi = 0; bi < 17; ++bi) acc[bi] += slab[bi * 64 + k8 + u] * w[u];
            }
            __syncthreads();
        }
#pragma unroll
        for (int bi = 0; bi < 17; ++bi) red[(wid * 17 + bi) * 64 + lane] = acc[bi];
        __syncthreads();
        for (int idx = tid; idx < 17 * 64; idx += 256) {
            const int bi = idx >> 6, ln = idx & 63;
            const float sv = red[(0 * 17 + bi) * 64 + ln] + red[(1 * 17 + bi) * 64 + ln] + red[(2 * 17 + bi) * 64 + ln] + red[(3 * 17 + bi) * 64 + ln] + (kh == 0 ? a.in[I_BMOD][l * 6144 + j0 + ln] : 0.f);
            atomicAdd(mod + (size_t)(l * 17 + bi) * 6144 + j0 + ln, sv);
        }
        __syncthreads();
    }
}

DEV void ph_norm(const KArgs& a, int layer, int which  , bool combine, int comb_layer, bool from_input, int nrows) {
    const int tid = get_tid(), lane = tid & 63, wid = tid >> 6;
    float* hws = (float*)(a.ws + WS_H);
    bf16_t* hn = (bf16_t*)(a.ws + WS_HN);
    const bf16_t* ys = (const bf16_t*)(a.ws + WS_KV);
    const float* mod = (const float*)(a.ws + WS_MOD);
    const float* g = which == 0 ? a.in[I_GN1] + layer * D : (which == 1 ? a.in[I_GN2] + layer * D : a.in[I_GF]);
    const int nw = gridDim.x * 4;
    for (int r = blockIdx.x * 4 + wid; r < nrows; r += nw) {
        const int bi = mod_index(r);
        const float* src = from_input ? (r < TL ? a.in[I_X] + (size_t)r * D : a.in[I_CTX] + (size_t)(r - TL) * D) : hws + (size_t)r * D;
        f32x4 v[4];
#pragma unroll
        for (int j = 0; j < 4; ++j) v[j] = __builtin_nontemporal_load((const f32x4*)(src + (lane + 64 * j) * 4));
        if (combine) {
            const float* g2 = mod + (size_t)(comb_layer * 17 + bi) * 6144 + 5 * D;
            unsigned y0v[4], y1v[4]; f32x4 ggv[4];
#pragma unroll
            for (int j = 0; j < 4; ++j) { const int k = (lane + 64 * j) * 4; y0v[j] = __builtin_nontemporal_load((const unsigned*)((const unsigned char*)ys + (size_t)(2 * r) * D + k)); y1v[j] = __builtin_nontemporal_load((const unsigned*)((const unsigned char*)ys + (size_t)(2 * r + 1) * D + k)); ggv[j] = *(const f32x4*)(g2 + k); }
#pragma unroll
            for (int j = 0; j < 4; ++j) {
                const int k = (lane + 64 * j) * 4;
                const int y0 = (int)y0v[j], y1 = (int)y1v[j];
                const f32x4 gg = ggv[j] * YS_INV;
                v[j].x += gg.x * (__builtin_amdgcn_cvt_f32_fp8(y0, 0) + __builtin_amdgcn_cvt_f32_fp8(y1, 0));
                v[j].y += gg.y * (__builtin_amdgcn_cvt_f32_fp8(y0, 1) + __builtin_amdgcn_cvt_f32_fp8(y1, 1));
                v[j].z += gg.z * (__builtin_amdgcn_cvt_f32_fp8(y0, 2) + __builtin_amdgcn_cvt_f32_fp8(y1, 2));
                v[j].w += gg.w * (__builtin_amdgcn_cvt_f32_fp8(y0, 3) + __builtin_amdgcn_cvt_f32_fp8(y1, 3));
                if (which != 2) __builtin_nontemporal_store(v[j], (f32x4*)(hws + (size_t)r * D + k));
            }
        }
        float ss = 0.f;
#pragma unroll
        for (int j = 0; j < 4; ++j) ss += v[j].x * v[j].x + v[j].y * v[j].y + v[j].z * v[j].z + v[j].w * v[j].w;
        const float rstd = rsqrtf(wave_sum(ss) * (1.f / D) + EPS);
        if (which == 2) {
            f32x4 gv[4];
#pragma unroll
            for (int j = 0; j < 4; ++j) gv[j] = *(const f32x4*)(g + (lane + 64 * j) * 4);
#pragma unroll
            for (int j = 0; j < 4; ++j) { const int k = (lane + 64 * j) * 4; f32x4 o = v[j] * rstd * gv[j]; __builtin_nontemporal_store(o, (f32x4*)(a.out + (size_t)r * D + k)); }
        } else {
            const float* sh = mod + (size_t)(layer * 17 + bi) * 6144 + (which == 0 ? 0 : 3 * D);
            const float* sc = sh + D;
            f32x4 gv[4], s1v[4], s0v[4];
#pragma unroll
            for (int j = 0; j < 4; ++j) { const int k = (lane + 64 * j) * 4; gv[j] = *(const f32x4*)(g + k); s1v[j] = *(const f32x4*)(sc + k); s0v[j] = *(const f32x4*)(sh + k); }
#pragma unroll
            for (int j = 0; j < 4; ++j) {
                const int k = (lane + 64 * j) * 4;
                const f32x4 gg = gv[j], s1 = s1v[j], s0 = s0v[j];
                const f32x4 o = v[j] * rstd * gg * (1.f + s1) + s0;
                u32x2 w; w.x = pk2(o.x, o.y); w.y = pk2(o.z, o.w);
                *(u32x2*)(hn + (size_t)r * D + k) = w;
                if (which == 1) *(unsigned*)(a.ws + WS_HN8 + (size_t)r * D + k) = pk4_fp8(o.x, o.y, o.z, o.w);
            }
        }
    }
}


DEV void transpose_item(const float* W, int K, int N, bf16_t* WT, float* scr, int kb, int nb, int lane) {
    const int k0 = kb * 64, n0 = nb * 32;
    float wv[32];
#pragma unroll
    for (int i = 0; i < 32; ++i) wv[i] = __builtin_nontemporal_load(W + (size_t)(k0 + 2 * i + (lane >> 5)) * N + n0 + (lane & 31));
#pragma unroll
    for (int i = 0; i < 32; ++i) scr[(2 * i + (lane >> 5)) * 33 + (lane & 31)] = wv[i];
    asm volatile("s_waitcnt lgkmcnt(0)" ::: "memory");
    const int c = lane & 7;
#pragma unroll
    for (int j = 0; j < 4; ++j) {
        const int n = (lane >> 3) + 8 * j; const float* sp = scr + (8 * c) * 33 + n;
        u32x4 o; o.x = pk2(sp[0 * 33], sp[1 * 33]); o.y = pk2(sp[2 * 33], sp[3 * 33]); o.z = pk2(sp[4 * 33], sp[5 * 33]); o.w = pk2(sp[6 * 33], sp[7 * 33]);
        *(u32x4*)(WT + (size_t)(n0 + n) * K + k0 + 8 * c) = o;
    }
    asm volatile("s_waitcnt lgkmcnt(0)" ::: "memory");
}
DEV void transpose_item8(const float* W, int K, int N, unsigned char* WT, float* scr, int kb, int nb, int lane) {
    const int k0 = kb * 64, n0 = nb * 32;
    float wv[32];
#pragma unroll
    for (int i = 0; i < 32; ++i) wv[i] = __builtin_nontemporal_load(W + (size_t)(k0 + 2 * i + (lane >> 5)) * N + n0 + (lane & 31));
#pragma unroll
    for (int i = 0; i < 32; ++i) scr[(2 * i + (lane >> 5)) * 33 + (lane & 31)] = wv[i] * W8_SCALE;
    asm volatile("s_waitcnt lgkmcnt(0)" ::: "memory");
    const int n = lane >> 1, kh = (lane & 1) * 32;
    const float* sp = scr + kh * 33 + n;
    u32x4 o0, o1;
    o0.x = pk4_fp8(sp[0 * 33], sp[1 * 33], sp[2 * 33], sp[3 * 33]); o0.y = pk4_fp8(sp[4 * 33], sp[5 * 33], sp[6 * 33], sp[7 * 33]);
    o0.z = pk4_fp8(sp[8 * 33], sp[9 * 33], sp[10 * 33], sp[11 * 33]); o0.w = pk4_fp8(sp[12 * 33], sp[13 * 33], sp[14 * 33], sp[15 * 33]);
    o1.x = pk4_fp8(sp[16 * 33], sp[17 * 33], sp[18 * 33], sp[19 * 33]); o1.y = pk4_fp8(sp[20 * 33], sp[21 * 33], sp[22 * 33], sp[23 * 33]);
    o1.z = pk4_fp8(sp[24 * 33], sp[25 * 33], sp[26 * 33], sp[27 * 33]); o1.w = pk4_fp8(sp[28 * 33], sp[29 * 33], sp[30 * 33], sp[31 * 33]);
    unsigned char* dp = WT + (size_t)(n0 + n) * K + k0 + kh;
    __builtin_nontemporal_store(o0, (u32x4*)dp); __builtin_nontemporal_store(o1, (u32x4*)(dp + 16));
    asm volatile("s_waitcnt lgkmcnt(0)" ::: "memory");
}
DEV void convert_experts(const KArgs& a, int layer, unsigned char* lds) {
    const int tid = get_tid(), lane = tid & 63, wid = tid >> 6;
    float* scr = (float*)lds + wid * (64 * 33);
    const int gw = blockIdx.x * 4 + wid, ngw = gridDim.x * 4;
    for (int it = gw; it < NE * 3 * 256; it += ngw) {
        const int mat = it >> 8, sub = it & 255, e = mat / 3, which = mat % 3;
        if (which < 2) {
            const float* W = a.in[which == 0 ? I_W1 : I_W3] + ((size_t)layer * NE + e) * D * DE;
            unsigned char* WT = a.ws + (which == 0 ? WS_W1T : WS_W3T) + (size_t)e * DE * D;
            transpose_item8(W, D, DE, WT, scr, sub >> 4, sub & 15, lane);
        } else {
            const float* W = a.in[I_W2] + ((size_t)layer * NE + e) * DE * D;
            unsigned char* WT = a.ws + WS_W2T + (size_t)e * D * DE;
            transpose_item8(W, DE, D, WT, scr, sub >> 5, sub & 31, lane);
        }
    }
}
DEV void convert_shared(const KArgs& a, unsigned char* lds) {
    const int tid = get_tid(), lane = tid & 63, wid = tid >> 6;
    float* scr = (float*)lds + wid * (64 * 33);
    const int gw = blockIdx.x * 4 + wid, ngw = gridDim.x * 4;
    constexpr int I_IN = 16 * 81, I_OUT = 16 * 32;
    for (int it = gw; it < 2 * I_IN + 2 * I_OUT; it += ngw) {
        if (it < 2 * I_IN) { const int l = it / I_IN, sub = it % I_IN; transpose_item(a.in[I_WIN] + (size_t)l * D * DIN, D, DIN, (bf16_t*)(a.ws + WS_WINT) + (size_t)l * DIN * D, scr, sub / 81, sub % 81, lane); }
        else { const int r = it - 2 * I_IN, l = r / I_OUT, sub = r % I_OUT; transpose_item(a.in[I_WOUT] + (size_t)l * D * D, D, D, (bf16_t*)(a.ws + WS_WOUTT) + (size_t)l * D * D, scr, sub >> 5, sub & 31, lane); }
    }
    bf16_t* wrt = (bf16_t*)(a.ws + WS_WRT); bf16_t* wsp = (bf16_t*)(a.ws + WS_WSP);
    const int gt = blockIdx.x * 256 + tid, ngt = gridDim.x * 256;
    for (int i = gt; i < 2 * 128 * D; i += ngt) {
        const int l = i >> 17, n = (i >> 10) & 127, k = i & 1023;
        float v = 0.f;
        if (n < 8) v = a.in[I_WRG][((size_t)l * D + k) * 8 + n]; else if (n < 72) v = a.in[I_WRE][((size_t)l * D + k) * 64 + (n - 8)];
        wrt[i] = f2bf(v);
    }
    for (int i = gt; i < 2 * 4 * 128 * 128; i += ngt) wsp[i] = f2bf(a.in[I_WSP][i]);
}

DEV void glds16(const bf16_t* src, unsigned char* dst) { __builtin_amdgcn_global_load_lds((const unsigned*)src, (__attribute__((address_space(3))) unsigned*)dst, 16, 0, 0); }
template <class ARow, class BRow>
DEV void gemm_core(unsigned char* lds, int nk, ARow arow, BRow brow, f32x16 (&acc)[2][2]) {
    const int tid = get_tid(), lane = tid & 63, wid = tid >> 6, wr = wid >> 1, wc = wid & 1;
    const int srow = tid >> 3, sch = (tid & 7) ^ ((tid >> 4) & 7);
    const bf16_t* ap[4]; const bf16_t* bp[4];
#pragma unroll
    for (int i = 0; i < 4; ++i) { ap[i] = arow(i * 32 + srow) + sch * 8; bp[i] = brow(i * 32 + srow) + sch * 8; }
#pragma unroll
    for (int mi = 0; mi < 2; ++mi)
#pragma unroll
        for (int ni = 0; ni < 2; ++ni)
#pragma unroll
            for (int r = 0; r < 16; ++r) acc[mi][ni][r] = 0.f;
    unsigned char* dst = lds + __builtin_amdgcn_readfirstlane(tid & ~63) * 16;
    const int fr = lane & 31, fh = lane >> 5, g = (fr >> 1) & 7;
    const unsigned char* ra = lds + (wr * 64 + fr) * 128;
    const unsigned char* rb = lds + 16384 + (wc * 64 + fr) * 128;
#pragma unroll
    for (int i = 0; i < 4; ++i) { glds16(ap[i], dst + i * 4096); glds16(bp[i], dst + 16384 + i * 4096); }
    if (nk > 1) {
#pragma unroll
        for (int i = 0; i < 4; ++i) { glds16(ap[i] + 64, dst + 32768 + i * 4096); glds16(bp[i] + 64, dst + 32768 + 16384 + i * 4096); }
    }
    for (int kt = 0; kt < nk; ++kt) {
        const int cur = (kt & 1) * 32768;
        if (kt + 1 < nk) asm volatile("s_waitcnt vmcnt(8)" ::: "memory"); else asm volatile("s_waitcnt vmcnt(0)" ::: "memory");
        __builtin_amdgcn_s_barrier();
        asm volatile("" ::: "memory");
        bf16x8 af[4][2], bfr[4][2];
#pragma unroll
        for (int ks = 0; ks < 4; ++ks) {
            const int co = ((ks * 2 + fh) ^ g) << 4;
#pragma unroll
            for (int mi = 0; mi < 2; ++mi) af[ks][mi] = *(const bf16x8*)(ra + cur + mi * 4096 + co);
#pragma unroll
            for (int ni = 0; ni < 2; ++ni) bfr[ks][ni] = *(const bf16x8*)(rb + cur + ni * 4096 + co);
        }
        asm volatile("s_waitcnt lgkmcnt(0)" ::: "memory");
        __builtin_amdgcn_s_barrier();
        asm volatile("" ::: "memory");
        if (kt + 2 < nk) {
            const int ko = (kt + 2) * 64;
#pragma unroll
            for (int i = 0; i < 4; ++i) { glds16(ap[i] + ko, dst + cur + i * 4096); glds16(bp[i] + ko, dst + cur + 16384 + i * 4096); }
        }
#pragma unroll
        for (int ks = 0; ks < 4; ++ks)
#pragma unroll
            for (int mi = 0; mi < 2; ++mi)
#pragma unroll
                for (int ni = 0; ni < 2; ++ni) acc[mi][ni] = __builtin_amdgcn_mfma_f32_32x32x16_bf16(af[ks][mi], bfr[ks][ni], acc[mi][ni], 0, 0, 0);
    }
    __builtin_amdgcn_s_barrier();
    asm volatile("" ::: "memory");
}
template <bool FP8 = false, class Prep, class ARow, class BRow, class Epi>
DEV void gemm_stream(unsigned char* lds, int nk, int t0, int tstep, int tend, Prep prep, ARow arow, BRow brow, Epi epi) {
    const int tid = get_tid(), lane = tid & 63, wid = tid >> 6, wr = wid >> 1, wc = wid & 1;
    const int srow = tid >> 3, sch = (tid & 7) ^ ((tid >> 4) & 7);
    if (t0 >= tend) return;
    auto cx = prep(t0);
    auto nx = cx;
    const bf16_t* ap[4]; const bf16_t* bp[4];
#pragma unroll
    for (int i = 0; i < 4; ++i) { ap[i] = arow(cx, i * 32 + srow) + sch * 8; bp[i] = brow(cx, i * 32 + srow) + sch * 8; }
    unsigned char* dst = lds + __builtin_amdgcn_readfirstlane(tid & ~63) * 16;
    const int fr = lane & 31, fh = lane >> 5, g = (fr >> 1) & 7;
    const unsigned char* ra = lds + (wr * 64 + fr) * 128;
    const unsigned char* rb = lds + 16384 + (wc * 64 + fr) * 128;
#pragma unroll
    for (int i = 0; i < 4; ++i) { glds16(ap[i], dst + i * 4096); glds16(bp[i], dst + 16384 + i * 4096); }
#pragma unroll
    for (int i = 0; i < 4; ++i) { glds16(ap[i] + 64, dst + 32768 + i * 4096); glds16(bp[i] + 64, dst + 32768 + 16384 + i * 4096); }
    for (int t = t0; t < tend; t += tstep) {
        const bool has_next = t + tstep < tend;
        f32x16 acc[2][2];
#pragma unroll
        for (int mi = 0; mi < 2; ++mi)
#pragma unroll
            for (int ni = 0; ni < 2; ++ni)
#pragma unroll
                for (int r = 0; r < 16; ++r) acc[mi][ni][r] = 0.f;
        for (int kt = 0; kt < nk; ++kt) {
            const int cur = (kt & 1) * 32768;
            if (kt + 1 < nk || has_next) asm volatile("s_waitcnt vmcnt(8)" ::: "memory"); else asm volatile("s_waitcnt vmcnt(0)" ::: "memory");
            __builtin_amdgcn_s_barrier();
            asm volatile("" ::: "memory");
            bf16x8 af[4][2], bfr[4][2];
            long a8[8][2], b8[8][2];
            if (!FP8) {
#pragma unroll
            for (int ks = 0; ks < 4; ++ks) {
                const int co = ((ks * 2 + fh) ^ g) << 4;
#pragma unroll
                for (int mi = 0; mi < 2; ++mi) af[ks][mi] = *(const bf16x8*)(ra + cur + mi * 4096 + co);
#pragma unroll
                for (int ni = 0; ni < 2; ++ni) bfr[ks][ni] = *(const bf16x8*)(rb + cur + ni * 4096 + co);
            }
            } else {
#pragma unroll
            for (int ks = 0; ks < 8; ++ks) {
                const int co = ((ks ^ g) << 4) + fh * 8;
#pragma unroll
                for (int mi = 0; mi < 2; ++mi) a8[ks][mi] = *(const long*)(ra + cur + mi * 4096 + co);
#pragma unroll
                for (int ni = 0; ni < 2; ++ni) b8[ks][ni] = *(const long*)(rb + cur + ni * 4096 + co);
            }
            }
            asm volatile("s_waitcnt lgkmcnt(0)" ::: "memory");
            __builtin_amdgcn_sched_barrier(0);
            __builtin_amdgcn_s_barrier();
            asm volatile("" ::: "memory");
            __builtin_amdgcn_sched_barrier(0);
            int ko = -1;
            if (kt + 2 < nk) ko = (kt + 2) * 64;
            else if (has_next) {
                if (kt + 2 == nk) {
                    nx = prep(t + tstep);
#pragma unroll
                    for (int i = 0; i < 4; ++i) { ap[i] = arow(nx, i * 32 + srow) + sch * 8; bp[i] = brow(nx, i * 32 + srow) + sch * 8; }
                }
                ko = (kt + 2 - nk) * 64;
            }
            if (FP8) {
#pragma unroll
                for (int ks = 0; ks < 8; ++ks) {
                    if (ko >= 0) { if (ks & 1) glds16(bp[ks >> 1] + ko, dst + cur + 16384 + (ks >> 1) * 4096); else glds16(ap[ks >> 1] + ko, dst + cur + (ks >> 1) * 4096); }
                    acc[0][0] = __builtin_amdgcn_mfma_f32_32x32x16_fp8_fp8(a8[ks][0], b8[ks][0], acc[0][0], 0, 0, 0);
                    acc[0][1] = __builtin_amdgcn_mfma_f32_32x32x16_fp8_fp8(a8[ks][0], b8[ks][1], acc[0][1], 0, 0, 0);
                    acc[1][0] = __builtin_amdgcn_mfma_f32_32x32x16_fp8_fp8(a8[ks][1], b8[ks][0], acc[1][0], 0, 0, 0);
                    acc[1][1] = __builtin_amdgcn_mfma_f32_32x32x16_fp8_fp8(a8[ks][1], b8[ks][1], acc[1][1], 0, 0, 0);
                    __builtin_amdgcn_sched_barrier(0);
                }
            } else
#pragma unroll
            for (int ks = 0; ks < 4; ++ks) {
                if (ko >= 0) { glds16(ap[ks] + ko, dst + cur + ks * 4096); }
                acc[0][0] = __builtin_amdgcn_mfma_f32_32x32x16_bf16(af[ks][0], bfr[ks][0], acc[0][0], 0, 0, 0);
                acc[0][1] = __builtin_amdgcn_mfma_f32_32x32x16_bf16(af[ks][0], bfr[ks][1], acc[0][1], 0, 0, 0);
                __builtin_amdgcn_sched_barrier(0);
                if (ko >= 0) { glds16(bp[ks] + ko, dst + cur + 16384 + ks * 4096); }
                acc[1][0] = __builtin_amdgcn_mfma_f32_32x32x16_bf16(af[ks][1], bfr[ks][0], acc[1][0], 0, 0, 0);
                acc[1][1] = __builtin_amdgcn_mfma_f32_32x32x16_bf16(af[ks][1], bfr[ks][1], acc[1][1], 0, 0, 0);
                __builtin_amdgcn_sched_barrier(0);
            }
        }
        epi(cx, acc);
        cx = nx;
    }
    __builtin_amdgcn_s_barrier();
    asm volatile("" ::: "memory");
}
DEV int vblock() { const int G = gridDim.x, bx = blockIdx.x; return (G % 8 == 0) ? (bx % 8) * (G / 8) + bx / 8 : bx; }
#define ACC_FOREACH(mi, ni, r, row, col) \
    _Pragma("unroll") for (int mi = 0; mi < 2; ++mi) _Pragma("unroll") for (int ni = 0; ni < 2; ++ni) _Pragma("unroll") for (int r = 0; r < 16; ++r) \
        for (int row = (tid >> 7) * 64 + mi * 32 + (r & 3) + 8 * (r >> 2) + 4 * ((tid & 63) >> 5), col = ((tid >> 6) & 1) * 64 + ni * 32 + (tid & 31), once_ = 1; once_; once_ = 0)

template <class ARow, class Epi>
DEV void gemm_naive_tile(float* lds, int K, ARow arow, const float* W, int ldw, int col0, int ncols, Epi epi) {
    const int tid = get_tid(), ty = tid >> 4, tx = tid & 15;
    float* sA = lds;
    float* sB = lds + 16 * 68;
    const int ar = tid >> 2, kq = (tid & 3) * 4;
    const bf16_t* ap = arow(ar);
    const int kr = tid >> 4, c4 = (tid & 15) * 4;
    const bool cok = (col0 + c4) < ncols;
    float acc[4][4];
#pragma unroll
    for (int i = 0; i < 4; ++i)
#pragma unroll
        for (int j = 0; j < 4; ++j) acc[i][j] = 0.f;
    for (int k0 = 0; k0 < K; k0 += 16) {
        const u32x2 av = *(const u32x2*)(ap + k0 + kq);
        f32x4 wv = {0.f, 0.f, 0.f, 0.f};
        if (cok) wv = *(const f32x4*)(W + (size_t)(k0 + kr) * ldw + col0 + c4);
        sA[(kq + 0) * 68 + ar] = __uint_as_float(av.x << 16);
        sA[(kq + 1) * 68 + ar] = __uint_as_float(av.x & 0xffff0000u);
        sA[(kq + 2) * 68 + ar] = __uint_as_float(av.y << 16);
        sA[(kq + 3) * 68 + ar] = __uint_as_float(av.y & 0xffff0000u);
        *(f32x4*)(sB + kr * 64 + c4) = wv;
        __syncthreads();
#pragma unroll 4
        for (int k = 0; k < 16; ++k) {
            const f32x4 a4 = *(const f32x4*)(sA + k * 68 + ty * 4), b4 = *(const f32x4*)(sB + k * 64 + tx * 4);
            const float aa[4] = {a4.x, a4.y, a4.z, a4.w}, bb[4] = {b4.x, b4.y, b4.z, b4.w};
#pragma unroll
            for (int i = 0; i < 4; ++i)
#pragma unroll
                for (int j = 0; j < 4; ++j) acc[i][j] += aa[i] * bb[j];
        }
        __syncthreads();
    }
#pragma unroll
    for (int i = 0; i < 4; ++i)
#pragma unroll
        for (int j = 0; j < 4; ++j) { const int col = col0 + tx * 4 + j; if (col < ncols) epi(ty * 4 + i, col, acc[i][j]); }
}

DEV void ph_inproj(const KArgs& a, int layer, unsigned char* lds) {
    const int tid = get_tid();
    const bf16_t* hn = (const bf16_t*)(a.ws + WS_HN);
    bf16_t* z = (bf16_t*)(a.ws + WS_Z);
    const bf16_t* WT = (const bf16_t*)(a.ws + WS_WINT) + (size_t)layer * DIN * D;
    constexpr int ntn = (DIN + 127) / 128, nlat = (TL / 128) * ntn, ncn = ntn - OFF_BK / 128;
    const int ntiles = layer == 0 ? (TA / 128) * ntn : nlat + (TC / 128) * ncn;
    struct Cx { int row0, col0; };
    auto prep = [&](int t) { Cx c;
        if (layer == 0 || t < nlat) { c.row0 = (t / ntn) * 128; c.col0 = (t % ntn) * 128; }
        else { const int u = t - nlat; c.row0 = TL + (u / ncn) * 128; c.col0 = OFF_BK + (u % ncn) * 128; }
        return c; };
    gemm_stream(lds, D / 64, vblock(), gridDim.x, ntiles, prep,
        [&](const Cx& c, int r) { int n = c.col0 + r; n = n < DIN ? n : DIN - 1; return WT + (size_t)n * D; },
        [&](const Cx& c, int r) { return hn + (size_t)(c.row0 + r) * D; },
        [&](const Cx& c, const f32x16 (&acc)[2][2]) {
            const int row0 = c.row0, col0 = c.col0;
            const int wr = tid >> 7, wc = (tid >> 6) & 1, lane = tid & 63;
#pragma unroll
            for (int ni = 0; ni < 2; ++ni) {
                bf16_t* zr = z + (size_t)(row0 + wc * 64 + ni * 32 + (lane & 31)) * DIN + col0;
#pragma unroll
                for (int mi = 0; mi < 2; ++mi)
#pragma unroll
                    for (int kp = 0; kp < 2; ++kp) {
                        u32x2 wa, wb;
                        wa.x = pk2(acc[mi][ni][8 * kp], acc[mi][ni][8 * kp + 1]); wa.y = pk2(acc[mi][ni][8 * kp + 2], acc[mi][ni][8 * kp + 3]);
                        wb.x = pk2(acc[mi][ni][8 * kp + 4], acc[mi][ni][8 * kp + 5]); wb.y = pk2(acc[mi][ni][8 * kp + 6], acc[mi][ni][8 * kp + 7]);
                        const u32x4 w = widen_pair(wa, wb);
                        const int n = wr * 64 + mi * 32 + 16 * kp + 8 * (lane >> 5);
                        if (col0 + n < DIN) *(u32x4*)(zr + n) = w;
                    }
            }
        });
}

DEV void ph_outproj(const KArgs& a, int layer, int nrows, unsigned char* lds) {
    const int tid = get_tid();
    const bf16_t* mix = (const bf16_t*)(a.ws + WS_MIX);
    float* hws = (float*)(a.ws + WS_H);
    const float* mod = (const float*)(a.ws + WS_MOD);
    const bf16_t* WT = (const bf16_t*)(a.ws + WS_WOUTT) + (size_t)layer * D * D;
    constexpr int ntn = D / 128;
    gemm_stream(lds, D / 64, vblock(), gridDim.x, (nrows / 128) * ntn, [](int t) { return t; },
        [&](int t, int r) { return mix + (size_t)((t / ntn) * 128 + r) * D; },
        [&](int t, int r) { return WT + (size_t)((t % ntn) * 128 + r) * D; },
        [&](int t, const f32x16 (&acc)[2][2]) {
            const int row0 = (t / ntn) * 128, col0 = (t % ntn) * 128;
            const int bi = mod_index(row0);
            const float* g1 = mod + (size_t)(layer * 17 + bi) * 6144 + 2 * D + col0;
            const int wr = tid >> 7, wc = (tid >> 6) & 1, lane = tid & 63;
            const float g1a = g1[wc * 64 + (lane & 31)], g1b = g1[wc * 64 + 32 + (lane & 31)];
            const float* resb = (layer == 0 ? (row0 < TL ? a.in[I_X] + (size_t)row0 * D : a.in[I_CTX] + (size_t)(row0 - TL) * D) : hws + (size_t)row0 * D) + col0 + wc * 64 + (lane & 31);
            float* outb = hws + (size_t)row0 * D + col0 + wc * 64 + (lane & 31);
            float resc[8], resn[8];
#define OP_RO(b) ((size_t)(wr * 64 + ((b) >> 2) * 32 + 16 * ((b) & 1) + 4 * (lane >> 5)) * D + (((b) >> 1) & 1) * 32)
#pragma unroll
            for (int r = 0; r < 8; ++r) resc[r] = __builtin_nontemporal_load(resb + OP_RO(0) + (size_t)((r & 3) + 8 * (r >> 2)) * D);
#pragma unroll
            for (int b = 0; b < 8; ++b) {
                const int mi = b >> 2, ni = (b >> 1) & 1, hq = b & 1;
                if (b + 1 < 8) {
#pragma unroll
                    for (int r = 0; r < 8; ++r) resn[r] = __builtin_nontemporal_load(resb + OP_RO(b + 1) + (size_t)((r & 3) + 8 * (r >> 2)) * D);
                }
                asm volatile("" ::: "memory");
#pragma unroll
                for (int r = 0; r < 8; ++r) outb[OP_RO(b) + (size_t)((r & 3) + 8 * (r >> 2)) * D] = resc[r] + (ni ? g1b : g1a) * acc[mi][ni][8 * hq + r];
                asm volatile("" ::: "memory");
#pragma unroll
                for (int r = 0; r < 8; ++r) resc[r] = resn[r];
            }
#undef OP_RO
        });
}

DEV bf16x8 tr_frag_at(unsigned base, int RS, int c, int ks, int lane);
DEV void unpack8(const u32x4 v, float* f);
DEV void ph_spatial(const KArgs& a, int layer, int nrows, unsigned char* lds) {
    const int tid = get_tid(), lane = tid & 63, wid = tid >> 6, wr = wid >> 1, wc = wid & 1, fr = lane & 31, fh = lane >> 5;
    const bf16_t* z = (const bf16_t*)(a.ws + WS_Z);
    bf16_t* mix = (bf16_t*)(a.ws + WS_MIX);
    unsigned char* vs = lds;
    const unsigned vs_a = (unsigned)(size_t)vs;
    const int nitems = (nrows / 128) * 4;
    for (int item = vblock(); item < nitems; item += gridDim.x) {
        const int ci = item >> 2, g = item & 3, row0 = ci * 128;
        const int l8 = tid & 7, tk = tid >> 3;
        float lgv[16], lbv[16];
#pragma unroll
        for (int j = 0; j < 4; ++j) {
            const f32x4 g4 = *(const f32x4*)(a.in[I_LNG] + layer * 512 + g * 128 + l8 * 16 + 4 * j), b4 = *(const f32x4*)(a.in[I_LNB] + layer * 512 + g * 128 + l8 * 16 + 4 * j);
            lgv[4 * j] = g4.x; lgv[4 * j + 1] = g4.y; lgv[4 * j + 2] = g4.z; lgv[4 * j + 3] = g4.w; lbv[4 * j] = b4.x; lbv[4 * j + 1] = b4.y; lbv[4 * j + 2] = b4.z; lbv[4 * j + 3] = b4.w;
        }
#pragma unroll 2
        for (int pass = 0; pass < 4; ++pass) {
            const int tok = pass * 32 + tk;
            const bf16_t* zp = z + (size_t)(row0 + tok) * DIN + OFF_AV + g * 128 + l8 * 16;
            float x[16];
            unpack8(*(const u32x4*)zp, x); unpack8(*(const u32x4*)(zp + 8), x + 8);
            float sm = 0.f;
#pragma unroll
            for (int j = 0; j < 16; ++j) { x[j] = gelu_f(x[j]); sm += x[j]; }
            sm += __shfl_xor(sm, 1); sm += __shfl_xor(sm, 2); sm += __shfl_xor(sm, 4);
            const float mu = sm * (1.f / 128.f);
            float q = 0.f;
#pragma unroll
            for (int j = 0; j < 16; ++j) { x[j] -= mu; q += x[j] * x[j]; }
            q += __shfl_xor(q, 1); q += __shfl_xor(q, 2); q += __shfl_xor(q, 4);
            const float rs = rsqrtf(q * (1.f / 128.f) + EPS);
            u32x4 w0, w1;
            w0.x = pk2(x[0] * rs * lgv[0] + lbv[0], x[1] * rs * lgv[1] + lbv[1]); w0.y = pk2(x[2] * rs * lgv[2] + lbv[2], x[3] * rs * lgv[3] + lbv[3]);
            w0.z = pk2(x[4] * rs * lgv[4] + lbv[4], x[5] * rs * lgv[5] + lbv[5]); w0.w = pk2(x[6] * rs * lgv[6] + lbv[6], x[7] * rs * lgv[7] + lbv[7]);
            w1.x = pk2(x[8] * rs * lgv[8] + lbv[8], x[9] * rs * lgv[9] + lbv[9]); w1.y = pk2(x[10] * rs * lgv[10] + lbv[10], x[11] * rs * lgv[11] + lbv[11]);
            w1.z = pk2(x[12] * rs * lgv[12] + lbv[12], x[13] * rs * lgv[13] + lbv[13]); w1.w = pk2(x[14] * rs * lgv[14] + lbv[14], x[15] * rs * lgv[15] + lbv[15]);
            *(u32x4*)(vs + tok * 320 + l8 * 32) = w0; *(u32x4*)(vs + tok * 320 + l8 * 32 + 16) = w1;
        }
        __syncthreads();
        const bf16_t* wsp = (const bf16_t*)(a.ws + WS_WSP) + (size_t)(layer * 4 + g) * 128 * 128;
        f32x16 acc[2][2];
#pragma unroll
        for (int mi = 0; mi < 2; ++mi)
#pragma unroll
            for (int ni = 0; ni < 2; ++ni)
#pragma unroll
                for (int r = 0; r < 16; ++r) acc[mi][ni][r] = 0.f;
#pragma unroll 2
        for (int ks = 0; ks < 8; ++ks) {
            bf16x8 af[2], bfr[2];
#pragma unroll
            for (int mi = 0; mi < 2; ++mi) af[mi] = *(const bf16x8*)(wsp + (wr * 64 + mi * 32 + fr) * 128 + ks * 16 + fh * 8);
#pragma unroll
            for (int ni = 0; ni < 2; ++ni) bfr[ni] = tr_frag_at(vs_a, 320, wc * 2 + ni, ks, lane);
#pragma unroll
            for (int mi = 0; mi < 2; ++mi)
#pragma unroll
                for (int ni = 0; ni < 2; ++ni) acc[mi][ni] = __builtin_amdgcn_mfma_f32_32x32x16_bf16(af[mi], bfr[ni], acc[mi][ni], 0, 0, 0);
        }
        __syncthreads();
        ACC_FOREACH(mi, ni, r, row, col) { *(bf16_t*)(vs + row * 272 + col * 2) = f2bf(acc[mi][ni][r]); }
        __syncthreads();
        {
            const int p = tid >> 1, c0 = (tid & 1) * 64;
            const float bs = a.in[I_BSP][(layer * 4 + g) * 128 + p];
            const bf16_t* zu = z + (size_t)(row0 + p) * DIN + OFF_AU + g * 128 + c0;
            bf16_t* mo = mix + (size_t)(row0 + p) * D + g * 128 + c0;
            u32x4 zuv[8];
#pragma unroll
            for (int j = 0; j < 8; ++j) zuv[j] = *(const u32x4*)(zu + 8 * j);
#pragma unroll 2
            for (int j = 0; j < 8; ++j) {
                float uf[8], sf[8];
                unpack8(zuv[j], uf); unpack8(*(const u32x4*)(vs + p * 272 + (c0 + 8 * j) * 2), sf);
                u32x4 w;
                w.x = pk2(gelu_f(uf[0]) * (sf[0] + bs), gelu_f(uf[1]) * (sf[1] + bs)); w.y = pk2(gelu_f(uf[2]) * (sf[2] + bs), gelu_f(uf[3]) * (sf[3] + bs));
                w.z = pk2(gelu_f(uf[4]) * (sf[4] + bs), gelu_f(uf[5]) * (sf[5] + bs)); w.w = pk2(gelu_f(uf[6]) * (sf[6] + bs), gelu_f(uf[7]) * (sf[7] + bs));
                *(u32x4*)(mo + 8 * j) = w;
            }
        }
        __syncthreads();
    }
}

constexpr int GLA_LA_STRIDE = 65, GLA_VT_RS = 320, GLA_KD_RS = 192, GLA_QK_RS = 144;
constexpr int GLA_OFF_LA = 0, GLA_OFF_QE = 16896, GLA_OFF_KE = 16896 + 9216, GLA_OFF_VT = 16896 + 2 * 9216, GLA_OFF_WU = GLA_OFF_VT + 64 * GLA_VT_RS, GLA_OFF_TOT = GLA_OFF_WU + 2 * 4352, GLA_OFF_END = GLA_OFF_TOT + 1280;
static_assert(64 * GLA_LA_STRIDE * 4 <= GLA_OFF_QE && GLA_OFF_END <= 65536 + 768 && 64 * 132 * 4 <= GLA_OFF_VT && 64 * GLA_KD_RS <= 2 * 9216, "GLA LDS map");
DEV void gla_chunk_coords(int ci, int& row0, int& b, int& slot) {
    if (ci < 512) { row0 = ci * 64; b = ci >> 5; slot = 4 + (ci & 31); } else { const int c = ci - 512; row0 = TL + c * 64; b = c >> 2; slot = c & 3; }
}
DEV bf16x8 tr_frag(unsigned a0, unsigned a1) {
    u32x2 lo, hi;
    asm volatile("ds_read_b64_tr_b16 %0, %2\n\tds_read_b64_tr_b16 %1, %3\n\ts_waitcnt lgkmcnt(0)" : "=&v"(lo), "=&v"(hi) : "v"(a0), "v"(a1) : "memory");
    u32x4 w; w.x = lo.x; w.y = lo.y; w.z = hi.x; w.w = hi.y;
    return __builtin_bit_cast(bf16x8, w);
}
DEV bf16x8 tr_frag_at(unsigned base, int RS, int c, int ks, int lane) {
    const int h = lane >> 5, blk = (lane >> 4) & 1, q = (lane & 15) >> 2, p = lane & 3;
    const unsigned a0 = base + (unsigned)((16 * ks + 8 * h + q) * RS + (32 * c + 16 * blk + 4 * p) * 2);
    return tr_frag(a0, a0 + 4u * (unsigned)RS);
}
DEV void unpack8(const u32x4 v, float* f) {
    f[0] = __uint_as_float(v.x << 16); f[1] = __uint_as_float(v.x & 0xffff0000u); f[2] = __uint_as_float(v.y << 16); f[3] = __uint_as_float(v.y & 0xffff0000u);
    f[4] = __uint_as_float(v.z << 16); f[5] = __uint_as_float(v.z & 0xffff0000u); f[6] = __uint_as_float(v.w << 16); f[7] = __uint_as_float(v.w & 0xffff0000u);
}
DEV void gla_stage_gate(const KArgs& a, int layer, int dir, int h, float* swu, int tid) {
    bf16_t* hi = (bf16_t*)swu; bf16_t* lo = hi + 1024; float* bias = swu + 1024;
    for (int i = tid; i < 16 * 64; i += 256) {
        const int k = i >> 6, d = i & 63;
        const float w = a.in[I_WGU][((size_t)(layer * 2 + dir) * 16 + k) * 256 + h * 64 + d];
        const bf16_t wh = f2bf(w);
        hi[d * 16 + k] = wh; lo[d * 16 + k] = f2bf(w - bf2f(wh));
    }
    if (tid < 64) bias[tid] = a.in[I_BG][(layer * 2 + dir) * 256 + h * 64 + tid];
}
DEV void gla_logdecay(const bf16x8 zfrag, const float* swu, float* la, int tid) {
    const int lane = tid & 63, wid = tid >> 6, fr = lane & 31, fh = lane >> 5, dt = (wid & 1) * 32, tt = (wid >> 1) * 32;
    const bf16_t* hi = (const bf16_t*)swu; const bf16_t* lo = hi + 1024; const float* bias = swu + 1024;
    const bf16x8 bh = *(const bf16x8*)(hi + (dt + fr) * 16 + fh * 8), bl = *(const bf16x8*)(lo + (dt + fr) * 16 + fh * 8);
    f32x16 acc;
#pragma unroll
    for (int r = 0; r < 16; ++r) acc[r] = 0.f;
    acc = __builtin_amdgcn_mfma_f32_32x32x16_bf16(zfrag, bl, acc, 0, 0, 0);
    acc = __builtin_amdgcn_mfma_f32_32x32x16_bf16(zfrag, bh, acc, 0, 0, 0);
    const float bb = bias[dt + fr];
#pragma unroll
    for (int r = 0; r < 16; ++r) la[(tt + (r & 3) + 8 * (r >> 2) + 4 * fh) * GLA_LA_STRIDE + dt + fr] = logsigmoid_f(acc[r] + bb) * (1.f / 16.f);
}
DEV void gla_cumsum(float* la, float* tot, int dir, int tid) {
    const int d = tid & 63, sg = tid >> 6;
    float v[16];
#pragma unroll
    for (int t = 0; t < 16; ++t) v[t] = la[(sg * 16 + t) * GLA_LA_STRIDE + d];
    if (dir == 0) {
#pragma unroll
        for (int t = 1; t < 16; ++t) v[t] += v[t - 1];
        tot[sg * 64 + d] = v[15];
    } else {
#pragma unroll
        for (int t = 14; t >= 0; --t) v[t] += v[t + 1];
        tot[sg * 64 + d] = v[0];
    }
    __syncthreads();
    const float t0 = tot[d], t1 = tot[64 + d], t2 = tot[128 + d], t3 = tot[192 + d];
    float off;
    if (dir == 0) off = (sg > 0 ? t0 : 0.f) + (sg > 1 ? t1 : 0.f) + (sg > 2 ? t2 : 0.f);
    else off = (sg < 3 ? t3 : 0.f) + (sg < 2 ? t2 : 0.f) + (sg < 1 ? t1 : 0.f);
    if (sg == 0) tot[256 + d] = (t0 + t1) + (t2 + t3);
#pragma unroll
    for (int t = 0; t < 16; ++t) la[(sg * 16 + t) * GLA_LA_STRIDE + d] = v[t] + off;
    __syncthreads();
}
DEV void gla_store_v(const u32x4 (&vr)[4], unsigned char* vt, int tid) {
    const int i = tid >> 2, e0 = (tid & 3) * 32;
#pragma unroll
    for (int j = 0; j < 4; ++j) *(u32x4*)(vt + i * GLA_VT_RS + (e0 + 8 * j) * 2) = vr[j];
}

DEV void ph_gla_kv(const KArgs& a, int layer, unsigned char* lds) {
    const int tid = get_tid(), lane = tid & 63, wid = tid >> 6;
    const bf16_t* z = (const bf16_t*)(a.ws + WS_Z);
    bf16_t* kvo = (bf16_t*)(a.ws + WS_KV);
    float* dco = (float*)(a.ws + WS_DECAY);
    float* la = (float*)(lds + GLA_OFF_LA); unsigned char* kdt = lds + GLA_OFF_QE; unsigned char* vt = lds + GLA_OFF_VT;
    float* swu = (float*)(lds + GLA_OFF_WU); float* tot = (float*)(lds + GLA_OFF_TOT);
    const unsigned vt_a = (unsigned)(size_t)vt, kd_a = (unsigned)(size_t)kdt;
    const int vb = vblock(), h = vb & 3;
    gla_stage_gate(a, layer, 0, h, swu, tid); gla_stage_gate(a, layer, 1, h, swu + 1088, tid);
    __syncthreads();
    const int i = tid >> 2, d0 = (tid & 3) * 16, e0 = (tid & 3) * 32;
    for (int item = vb; item < 576 * 4; item += gridDim.x) {
        const int ci = item >> 2;
        int row0, b, slot; gla_chunk_coords(ci, row0, b, slot);
        const bf16_t* zr = z + (size_t)(row0 + i) * DIN;
        const bf16_t* zgp = z + (size_t)(row0 + (wid >> 1) * 32 + (lane & 31)) * DIN + OFF_BG + (lane >> 5) * 8;
        const bf16x8 zf0 = *(const bf16x8*)zgp, zf1 = *(const bf16x8*)(zgp + 16);
        const u32x4 kr0 = *(const u32x4*)(zr + OFF_BK + h * 64 + d0), kr1 = *(const u32x4*)(zr + OFF_BK + h * 64 + d0 + 8);
        u32x4 vr[4];
#pragma unroll
        for (int j = 0; j < 4; ++j) vr[j] = *(const u32x4*)(zr + OFF_BV + h * 128 + e0 + 8 * j);
        gla_store_v(vr, vt, tid);
#pragma unroll 1
        for (int dir = 0; dir < 2; ++dir) {
            gla_logdecay(dir ? zf1 : zf0, swu + dir * 1088, la, tid);
            __syncthreads();
            gla_cumsum(la, tot, dir, tid);
            const size_t tile = (size_t)(((dir * NB + b) * 4 + h) * 36 + slot);
            {
                float kf[16];
                unpack8(kr0, kf); unpack8(kr1, kf + 8);
#pragma unroll
                for (int dd = 0; dd < 16; ++dd) kf[dd] *= __expf(tot[256 + d0 + dd] - la[i * GLA_LA_STRIDE + d0 + dd]);
                u32x4 w0, w1;
                w0.x = pk2(kf[0], kf[1]); w0.y = pk2(kf[2], kf[3]); w0.z = pk2(kf[4], kf[5]); w0.w = pk2(kf[6], kf[7]);
                w1.x = pk2(kf[8], kf[9]); w1.y = pk2(kf[10], kf[11]); w1.z = pk2(kf[12], kf[13]); w1.w = pk2(kf[14], kf[15]);
                *(u32x4*)(kdt + i * GLA_KD_RS + d0 * 2) = w0; *(u32x4*)(kdt + i * GLA_KD_RS + d0 * 2 + 16) = w1;
                if (tid < 64) dco[tile * 64 + tid] = __expf(tot[256 + tid]);
            }
            __syncthreads();
            f32x16 acc[2];
#pragma unroll
            for (int nt = 0; nt < 2; ++nt)
#pragma unroll
                for (int r = 0; r < 16; ++r) acc[nt][r] = 0.f;
#pragma unroll
            for (int ks = 0; ks < 4; ++ks) {
                const bf16x8 af = tr_frag_at(vt_a, GLA_VT_RS, wid, ks, lane);
#pragma unroll
                for (int nt = 0; nt < 2; ++nt) { const bf16x8 bfr = tr_frag_at(kd_a, GLA_KD_RS, nt, ks, lane); acc[nt] = __builtin_amdgcn_mfma_f32_32x32x16_bf16(af, bfr, acc[nt], 0, 0, 0); }
            }
            bf16_t* out = kvo + tile * 8192;
#pragma unroll
            for (int nt = 0; nt < 2; ++nt)
#pragma unroll
                for (int r = 0; r < 16; ++r) { const int e = wid * 32 + (r & 3) + 8 * (r >> 2) + 4 * (lane >> 5); out[e * 64 + nt * 32 + (lane & 31)] = f2bf(acc[nt][r]); }
            __syncthreads();
        }
    }
}

DEV void ph_gla_scan(const KArgs& a) {
    const int tid = get_tid();
    const bf16_t* kv = (const bf16_t*)(a.ws + WS_KV);
    const float* dc = (const float*)(a.ws + WS_DECAY);
    bf16_t* sp = (bf16_t*)(a.ws + WS_HN);
    for (int item = blockIdx.x; item < 2 * NB * 4 * 8; item += gridDim.x) {
        const int dbh = item >> 3, sub = item & 7, dir = dbh >> 6;
        const int e = sub * 16 + (tid >> 4), dq = (tid & 15) * 4;
        f32x4 S = {0.f, 0.f, 0.f, 0.f};
#pragma unroll 1
        for (int s0 = 0; s0 < 36; s0 += 12) {
            u32x2 kvr[12]; f32x4 dcv[12];
#pragma unroll
            for (int q = 0; q < 12; ++q) {
                const int step = s0 + q, slot = dir == 0 ? step : (step < 4 ? 3 - step : 39 - step);
                const size_t tile = (size_t)dbh * 36 + slot;
                kvr[q] = __builtin_nontemporal_load((const u32x2*)(kv + tile * 8192 + e * 64 + dq)); dcv[q] = *(const f32x4*)(dc + tile * 64 + dq);
            }
#pragma unroll
            for (int q = 0; q < 12; ++q) {
                const int step = s0 + q, slot = dir == 0 ? step : (step < 4 ? 3 - step : 39 - step);
                const size_t tile = (size_t)dbh * 36 + slot;
                const f32x4 kvv = {__uint_as_float(kvr[q].x << 16), __uint_as_float(kvr[q].x & 0xffff0000u), __uint_as_float(kvr[q].y << 16), __uint_as_float(kvr[q].y & 0xffff0000u)};
                u32x2 w; w.x = pk2(S.x, S.y); w.y = pk2(S.z, S.w);
                *(u32x2*)(sp + tile * 8192 + e * 64 + dq) = w;
                S = dcv[q] * S + kvv;
            }
        }
    }
}

DEV void ph_gla_out(const KArgs& a, int layer, unsigned char* lds) {
    const int tid = get_tid(), lane = tid & 63, wid = tid >> 6, ih = wid >> 1, eh = wid & 1, fr = lane & 31, fh = lane >> 5;
    const bf16_t* z = (const bf16_t*)(a.ws + WS_Z);
    const bf16_t* sp = (const bf16_t*)(a.ws + WS_HN);
    bf16_t* mix = (bf16_t*)(a.ws + WS_MIX);
    float* la = (float*)(lds + GLA_OFF_LA); unsigned char* att = lds + GLA_OFF_LA; unsigned char* qet = lds + GLA_OFF_QE; unsigned char* ket = lds + GLA_OFF_KE; unsigned char* vt = lds + GLA_OFF_VT;
    float* swu = (float*)(lds + GLA_OFF_WU); float* tot = (float*)(lds + GLA_OFF_TOT); float* ob = (float*)lds;
    const unsigned vt_a = (unsigned)(size_t)vt;
    const int nchunks = layer == 0 ? 576 : 512;
    const int vb = vblock(), h = vb & 3;
    gla_stage_gate(a, layer, 0, h, swu, tid); gla_stage_gate(a, layer, 1, h, swu + 1088, tid);
    __syncthreads();
    const int i = tid >> 2, d0 = (tid & 3) * 16, e0 = (tid & 3) * 32;
    for (int item = vb; item < nchunks * 4; item += gridDim.x) {
        const int ci = item >> 2;
        int row0, b, slot; gla_chunk_coords(ci, row0, b, slot);
        const bf16_t* zr = z + (size_t)(row0 + i) * DIN;
        const bf16_t* zgp = z + (size_t)(row0 + (wid >> 1) * 32 + (lane & 31)) * DIN + OFF_BG + (lane >> 5) * 8;
        const bf16x8 zf0 = *(const bf16x8*)zgp, zf1 = *(const bf16x8*)(zgp + 16);
        const u32x4 qr0 = *(const u32x4*)(zr + OFF_BQ + h * 64 + d0), qr1 = *(const u32x4*)(zr + OFF_BQ + h * 64 + d0 + 8);
        const u32x4 kr0 = *(const u32x4*)(zr + OFF_BK + h * 64 + d0), kr1 = *(const u32x4*)(zr + OFF_BK + h * 64 + d0 + 8);
        u32x4 vr[4], rr4[4];
#pragma unroll
        for (int j = 0; j < 4; ++j) vr[j] = *(const u32x4*)(zr + OFF_BV + h * 128 + e0 + 8 * j);
#pragma unroll
        for (int j = 0; j < 4; ++j) rr4[j] = *(const u32x4*)(zr + OFF_BR + h * 128 + e0 + 8 * j);
        gla_store_v(vr, vt, tid);
        f32x16 acc[2];
#pragma unroll
        for (int nt = 0; nt < 2; ++nt)
#pragma unroll
            for (int r = 0; r < 16; ++r) acc[nt][r] = 0.f;
#pragma unroll 1
        for (int dir = 0; dir < 2; ++dir) {
            gla_logdecay(dir ? zf1 : zf0, swu + dir * 1088, la, tid);
            __syncthreads();
            gla_cumsum(la, tot, dir, tid);
            {
                float qf[16], kf[16];
                unpack8(qr0, qf); unpack8(qr1, qf + 8); unpack8(kr0, kf); unpack8(kr1, kf + 8);
#pragma unroll
                for (int dd = 0; dd < 16; ++dd) { const float bb = la[i * GLA_LA_STRIDE + d0 + dd]; qf[dd] *= 0.125f * __expf(bb); kf[dd] *= __expf(-bb); }
                u32x4 w0, w1;
                w0.x = pk2(qf[0], qf[1]); w0.y = pk2(qf[2], qf[3]); w0.z = pk2(qf[4], qf[5]); w0.w = pk2(qf[6], qf[7]);
                w1.x = pk2(qf[8], qf[9]); w1.y = pk2(qf[10], qf[11]); w1.z = pk2(qf[12], qf[13]); w1.w = pk2(qf[14], qf[15]);
                *(u32x4*)(qet + i * GLA_QK_RS + d0 * 2) = w0; *(u32x4*)(qet + i * GLA_QK_RS + d0 * 2 + 16) = w1;
                w0.x = pk2(kf[0], kf[1]); w0.y = pk2(kf[2], kf[3]); w0.z = pk2(kf[4], kf[5]); w0.w = pk2(kf[6], kf[7]);
                w1.x = pk2(kf[8], kf[9]); w1.y = pk2(kf[10], kf[11]); w1.z = pk2(kf[12], kf[13]); w1.w = pk2(kf[14], kf[15]);
                *(u32x4*)(ket + i * GLA_QK_RS + d0 * 2) = w0; *(u32x4*)(ket + i * GLA_QK_RS + d0 * 2 + 16) = w1;
            }
            const bf16_t* st = sp + (size_t)(((dir * NB + b) * 4 + h) * 36 + slot) * 8192;
            bf16x8 bs[4][2];
#pragma unroll
            for (int ks = 0; ks < 4; ++ks)
#pragma unroll
                for (int nt = 0; nt < 2; ++nt) bs[ks][nt] = *(const bf16x8*)(st + (eh * 64 + nt * 32 + fr) * 64 + ks * 16 + fh * 8);
            __syncthreads();
            bf16x8 aq[4];
#pragma unroll
            for (int ks = 0; ks < 4; ++ks) aq[ks] = *(const bf16x8*)(qet + (ih * 32 + fr) * GLA_QK_RS + (ks * 16 + fh * 8) * 2);
            {
                f32x16 sa;
#pragma unroll
                for (int r = 0; r < 16; ++r) sa[r] = 0.f;
#pragma unroll
                for (int ks = 0; ks < 4; ++ks) { const bf16x8 bk = *(const bf16x8*)(ket + (eh * 32 + fr) * GLA_QK_RS + (ks * 16 + fh * 8) * 2); sa = __builtin_amdgcn_mfma_f32_32x32x16_bf16(aq[ks], bk, sa, 0, 0, 0); }
                const int j = eh * 32 + fr;
#pragma unroll
                for (int r = 0; r < 16; ++r) {
                    const int ii = ih * 32 + (r & 3) + 8 * (r >> 2) + 4 * fh;
                    const bool keep = dir == 0 ? (j <= ii) : (j >= ii);
                    *(bf16_t*)(att + ii * GLA_QK_RS + j * 2) = f2bf(keep ? sa[r] : 0.f);
                }
            }
            __syncthreads();
#pragma unroll
            for (int ks = 0; ks < 4; ++ks) {
                const bf16x8 aa = *(const bf16x8*)(att + (ih * 32 + fr) * GLA_QK_RS + (ks * 16 + fh * 8) * 2);
#pragma unroll
                for (int nt = 0; nt < 2; ++nt) {
                    const bf16x8 bv = tr_frag_at(vt_a, GLA_VT_RS, eh * 2 + nt, ks, lane);
                    acc[nt] = __builtin_amdgcn_mfma_f32_32x32x16_bf16(aa, bv, acc[nt], 0, 0, 0);
                    acc[nt] = __builtin_amdgcn_mfma_f32_32x32x16_bf16(aq[ks], bs[ks][nt], acc[nt], 0, 0, 0);
                }
            }
            __syncthreads();
        }
#pragma unroll
        for (int nt = 0; nt < 2; ++nt)
#pragma unroll
            for (int r = 0; r < 16; ++r) ob[(ih * 32 + (r & 3) + 8 * (r >> 2) + 4 * fh) * 132 + eh * 64 + nt * 32 + fr] = acc[nt][r];
        __syncthreads();
        {
            float o[32]; float ss = 0.f;
#pragma unroll
            for (int j = 0; j < 8; ++j) { const f32x4 v = *(const f32x4*)(ob + i * 132 + e0 + 4 * j); o[4 * j] = v.x; o[4 * j + 1] = v.y; o[4 * j + 2] = v.z; o[4 * j + 3] = v.w; ss += v.x * v.x + v.y * v.y + v.z * v.z + v.w * v.w; }
            ss += __shfl_xor(ss, 1); ss += __shfl_xor(ss, 2);
            const float rstd = rsqrtf(ss * (1.f / 128.f) + EPS);
            const float* gg = a.in[I_GGLA] + layer * 512 + h * 128 + e0;
            bf16_t* mo = mix + (size_t)(row0 + i) * D + 512 + h * 128 + e0;
#pragma unroll
            for (int j = 0; j < 4; ++j) {
                float rf[8]; unpack8(rr4[j], rf);
                const f32x4 g0 = *(const f32x4*)(gg + 8 * j), g1 = *(const f32x4*)(gg + 8 * j + 4);
                u32x4 w;
                w.x = pk2(o[8 * j + 0] * rstd * g0.x * silu_f(rf[0]), o[8 * j + 1] * rstd * g0.y * silu_f(rf[1]));
                w.y = pk2(o[8 * j + 2] * rstd * g0.z * silu_f(rf[2]), o[8 * j + 3] * rstd * g0.w * silu_f(rf[3]));
                w.z = pk2(o[8 * j + 4] * rstd * g1.x * silu_f(rf[4]), o[8 * j + 5] * rstd * g1.y * silu_f(rf[5]));
                w.w = pk2(o[8 * j + 6] * rstd * g1.z * silu_f(rf[6]), o[8 * j + 7] * rstd * g1.w * silu_f(rf[7]));
                *(u32x4*)(mo + 8 * j) = w;
            }
        }
        __syncthreads();
    }
}

DEV void ph_router(const KArgs& a, int layer, int nrows, unsigned char* lds) {
    const int tid = get_tid();
    const bf16_t* hn = (const bf16_t*)(a.ws + WS_HN);
    const bf16_t* WT = (const bf16_t*)(a.ws + WS_WRT) + (size_t)layer * 128 * D;
    unsigned* cnt = (unsigned*)(a.ws + WS_CTL) + layer * NE;
    unsigned* list = (unsigned*)(a.ws + WS_LIST);
    float* gate = (float*)(a.ws + WS_GATE);
    float* lgs = (float*)lds;
    for (int t = vblock(); t < nrows / 128; t += gridDim.x) {
        const int row0 = t * 128;
        f32x16 acc[2][2];
        gemm_core(lds, D / 64, [&](int r) { return hn + (size_t)(row0 + r) * D; }, [&](int r) { return WT + (size_t)r * D; }, acc);
        ACC_FOREACH(mi, ni, r, row, col) { if (col < 72) lgs[row * 73 + col] = acc[mi][ni][r]; }
        __syncthreads();
        if (tid < 128) {
            const float* lr = lgs + tid * 73; const int r = row0 + tid;
            float lg[8];
#pragma unroll
            for (int j = 0; j < 8; ++j) lg[j] = lr[j] + a.in[I_BRG][layer * 8 + j];
            float m = lg[0]; int gi = 0;
#pragma unroll
            for (int j = 1; j < 8; ++j) if (lg[j] > m) { m = lg[j]; gi = j; }
            float sum = 0.f;
#pragma unroll
            for (int j = 0; j < 8; ++j) sum += __expf(lg[j] - m);
            const float ptop = 1.f / sum;
            float le[8];
#pragma unroll
            for (int j = 0; j < 8; ++j) le[j] = lr[8 + gi * 8 + j] + a.in[I_BRE][layer * 64 + gi * 8 + j];
            float l1 = le[0]; int i1 = 0;
#pragma unroll
            for (int j = 1; j < 8; ++j) if (le[j] > l1) { l1 = le[j]; i1 = j; }
            float l2 = -3.0e38f; int i2 = 0;
#pragma unroll
            for (int j = 0; j < 8; ++j) if (j != i1 && le[j] > l2) { l2 = le[j]; i2 = j; }
            const float e2 = __expf(l2 - l1), w1 = 1.f / (1.f + e2), w2 = e2 / (1.f + e2);
            const int ex1 = gi * 8 + i1, ex2 = gi * 8 + i2;
            const unsigned p1 = atomicAdd(cnt + ex1, 1u), p2 = atomicAdd(cnt + ex2, 1u);
            list[(size_t)ex1 * LCAP + p1] = (unsigned)(2 * r); list[(size_t)ex2 * LCAP + p2] = (unsigned)(2 * r + 1);
            gate[2 * r] = ptop * w1; gate[2 * r + 1] = ptop * w2;
        }
        __syncthreads();
    }
}

DEV void ph_moe(const KArgs& a, int layer, int sub, unsigned char* lds) {
    const int tid = get_tid();
    const unsigned* cnt = (const unsigned*)(a.ws + WS_CTL) + layer * NE;
    const unsigned* list = (const unsigned*)(a.ws + WS_LIST);
    const float* gate = (const float*)(a.ws + WS_GATE);
    bf16_t* ys = (bf16_t*)(a.ws + WS_KV);
    int (*s_off)[80] = (int (*)[80])(lds + 65536);
    constexpr int ntn = 8;
    if (tid < NE) s_off[0][tid] = (int)cnt[tid];
    __syncthreads();
    if (tid == 0) { int o = 0, t = 0; for (int e = 0; e < NE; ++e) { const int c = s_off[0][e]; s_off[0][e] = o; s_off[1][e] = t; o += c; t += ((c + 127) / 128) * ntn; } s_off[0][NE] = o; s_off[1][NE] = t; }
    __syncthreads();
    const int ntiles = s_off[1][NE];
    struct Cx { int e, p0, nt, c, ro; };
    auto prep = [&](int t) { Cx x; int e = 0;
#pragma unroll
        for (int st = 32; st >= 1; st >>= 1) if (s_off[1][e + st] <= t) e += st;
        const int local = t - s_off[1][e]; x.e = e; x.p0 = (local / ntn) * 128; x.nt = local % ntn; x.c = (int)cnt[e]; x.ro = s_off[0][e];
        return x; };
    const int wr = tid >> 7, wc = (tid >> 6) & 1, lane = tid & 63;
    const unsigned char* hn8 = a.ws + WS_HN8;
    unsigned char* H8 = a.ws + WS_Z;
    if (sub == 0) {
        gemm_stream<true>(lds, D / 128, vblock(), gridDim.x, ntiles, prep,
            [&](const Cx& x, int r) { const int n = x.nt * 64 + (r >> 6) * 32 + (r & 31);
                                return (const bf16_t*)(a.ws + ((r >> 5) & 1 ? WS_W3T : WS_W1T) + ((size_t)x.e * DE + n) * D); },
            [&](const Cx& x, int r) { const int p = x.p0 + r; const unsigned slot = list[(size_t)x.e * LCAP + (p < x.c ? p : 0)]; return (const bf16_t*)(hn8 + (size_t)(slot >> 1) * D); },
            [&](const Cx& x, const f32x16 (&acc)[2][2]) {
                const int p0 = x.p0, nt = x.nt, c = x.c, ro = x.ro;
#pragma unroll
                for (int ni = 0; ni < 2; ++ni) {
                    const int p = p0 + wc * 64 + ni * 32 + (lane & 31);
                    unsigned char* hr = H8 + (size_t)(ro + (p < c ? p : 0)) * DE + nt * 64 + wr * 32 + 8 * (lane >> 5);
#pragma unroll
                    for (int kp = 0; kp < 2; ++kp) {
                        float hv[8];
#pragma unroll
                        for (int q = 0; q < 8; ++q) hv[q] = silu_f(acc[0][ni][8 * kp + q] * W8_INV) * (acc[1][ni][8 * kp + q] * W8_INV);
                        const unsigned wa = pk4_fp8(hv[0], hv[1], hv[2], hv[3]), wb = pk4_fp8(hv[4], hv[5], hv[6], hv[7]);
                        auto rsw = __builtin_amdgcn_permlane32_swap(wa, wb, false, false);
                        u32x2 w; w.x = rsw[0]; w.y = rsw[1];
                        if (p < c) *(u32x2*)(hr + 16 * kp) = w;
                    }
                }
            });
    } else {
        gemm_stream<true>(lds, DE / 128, vblock(), gridDim.x, ntiles, prep,
            [&](const Cx& x, int r) { return (const bf16_t*)(a.ws + WS_W2T + ((size_t)x.e * D + x.nt * 128 + r) * DE); },
            [&](const Cx& x, int r) { const int p = x.p0 + r; return (const bf16_t*)(H8 + (size_t)(x.ro + (p < x.c ? p : 0)) * DE); },
            [&](const Cx& x, const f32x16 (&acc)[2][2]) {
                const int e = x.e, p0 = x.p0, nt = x.nt, c = x.c;
                unsigned slotv[2]; float gtv[2];
#pragma unroll
                for (int ni = 0; ni < 2; ++ni) { const int p = p0 + wc * 64 + ni * 32 + (lane & 31); slotv[ni] = list[(size_t)e * LCAP + (p < c ? p : 0)]; }
#pragma unroll
                for (int ni = 0; ni < 2; ++ni) gtv[ni] = gate[slotv[ni]] * W8_INV;
#pragma unroll
                for (int ni = 0; ni < 2; ++ni) {
                    const int p = p0 + wc * 64 + ni * 32 + (lane & 31);
                    const unsigned slot = slotv[ni]; const float gt = gtv[ni] * YS_SCALE;
                    unsigned char* yo = (unsigned char*)ys + (size_t)slot * D + nt * 128 + wr * 64 + 8 * (lane >> 5);
#pragma unroll
                    for (int mi = 0; mi < 2; ++mi)
#pragma unroll
                        for (int kp = 0; kp < 2; ++kp) {
                            const unsigned wa = pk4_fp8(gt * acc[mi][ni][8 * kp], gt * acc[mi][ni][8 * kp + 1], gt * acc[mi][ni][8 * kp + 2], gt * acc[mi][ni][8 * kp + 3]);
                            const unsigned wb = pk4_fp8(gt * acc[mi][ni][8 * kp + 4], gt * acc[mi][ni][8 * kp + 5], gt * acc[mi][ni][8 * kp + 6], gt * acc[mi][ni][8 * kp + 7]);
                            auto rsw = __builtin_amdgcn_permlane32_swap(wa, wb, false, false);
                            u32x2 w; w.x = rsw[0]; w.y = rsw[1];
                            if (p < c) *(u32x2*)(yo + mi * 32 + 16 * kp) = w;
                        }
                }
            });
    }
}

#define XB_TMO      128
#define XB_XCNT(j)  (256  + 64 * (j))
#define XB_XSUB(j)  (1280 + 64 * (j))
#define XB_XGEN(j)  (2304 + 64 * (j))
#define XB_TOP      3328
#define XB_TOPGEN   3392
#define XCD_BAR_WORDS 3456
#define XB_SPIN_CAP (1u << 18)
#define LAS __attribute__((address_space(3)))
DEV unsigned xb_ld(unsigned* p)              { return __hip_atomic_load(p, __ATOMIC_RELAXED, __HIP_MEMORY_SCOPE_AGENT); }
DEV unsigned xb_add(unsigned* p, unsigned v) { return __hip_atomic_fetch_add(p, v, __ATOMIC_RELAXED, __HIP_MEMORY_SCOPE_AGENT); }
DEV unsigned xb_xcc_id() { return (unsigned)__builtin_amdgcn_s_getreg((3 << 11) | 20) & 0xFu; }
#define XB_SPIN(cond, bar) do { unsigned _sp = 0; while (cond) { __builtin_amdgcn_s_sleep(1); \
    if ((++_sp & 255u) == 0u) { if (xb_ld(&(bar)[XB_TMO])) break; if (_sp > XB_SPIN_CAP) { atomicAdd(&(bar)[XB_TMO], 1u); break; } } } } while (0)
struct XcdBarrier { unsigned* bar; unsigned x; volatile LAS unsigned* st; };
DEV XcdBarrier xcd_barrier_post(unsigned* bar, volatile LAS unsigned* st) {
    XcdBarrier b; b.bar = bar; b.x = xb_xcc_id(); b.st = st;
    if (threadIdx.x == 0) (void)xb_add(&bar[XB_XCNT(b.x)], 1u);
    return b;
}
DEV void xcd_barrier_complete(unsigned* bar, unsigned x, unsigned& nloc, unsigned& nx) {
    const unsigned G = gridDim.x * gridDim.y * gridDim.z;
    unsigned sum, cnt, mine, sp = 0u;
    for (;;) {
        sum = 0u; cnt = 0u; mine = 0u;
#pragma unroll
        for (unsigned j = 0; j < 16; ++j) { const unsigned c = xb_ld(&bar[XB_XCNT(j)]); sum += c; cnt += (c > 0u) ? 1u : 0u; mine = (j == x) ? c : mine; }
        if (sum == G) break;
        __builtin_amdgcn_s_sleep(1);
        if ((++sp & 255u) == 0u) { if (xb_ld(&bar[XB_TMO])) break; if (sp > XB_SPIN_CAP) { atomicAdd(&bar[XB_TMO], 1u); break; } }
    }
    nloc = mine > 0u ? mine : 1u; nx = cnt > 0u ? cnt : 1u;
}
DEV void xcd_barrier(const XcdBarrier& b) {
    asm volatile("s_waitcnt vmcnt(0)" ::: "memory");
    __syncthreads();
    if (threadIdx.x == 0) {
        unsigned* bar = b.bar;
        __builtin_amdgcn_s_waitcnt(0);
        unsigned nloc = b.st[0], nx = b.st[1];
        if (nloc == 0u) { xcd_barrier_complete(bar, b.x, nloc, nx); b.st[0] = nloc; b.st[1] = nx; }
        const unsigned old = xb_add(&bar[XB_XSUB(b.x)], 1u);
        const unsigned gen = old / nloc;
        if (old + 1u == (gen + 1u) * nloc) {
            __builtin_amdgcn_fence(__ATOMIC_RELEASE, "agent");
            asm volatile("s_waitcnt vmcnt(0)" ::: "memory");
            const unsigned og = xb_add(&bar[XB_TOP], 1u);
            const unsigned tg = og / nx;
            if (og + 1u == (tg + 1u) * nx) xb_add(&bar[XB_TOPGEN], 1u);
            else XB_SPIN(xb_ld(&bar[XB_TOPGEN]) == tg, bar);
            __builtin_amdgcn_fence(__ATOMIC_ACQUIRE, "agent");
            xb_add(&bar[XB_XGEN(b.x)], 1u);
            asm volatile("s_waitcnt vmcnt(0)" ::: "memory");
        } else {
            XB_SPIN(xb_ld(&bar[XB_XGEN(b.x)]) == gen, bar);
            __builtin_amdgcn_fence(__ATOMIC_ACQUIRE, "agent");
            asm volatile("s_waitcnt vmcnt(0)" ::: "memory");
        }
    }
    __syncthreads();
}

constexpr int NPH_LAYER = 10, NPH = 1 + 2 * NPH_LAYER + 1;
__global__ void __launch_bounds__(256, 2) mega(KArgs a) {
    __shared__ __attribute__((aligned(16))) unsigned char lds[65536 + 1024];
    uint4& xb_words = *(uint4*)(lds + 65536 + 768);
    cg::grid_group grid = cg::this_grid();
    const int lo = a.ph_lo, hi = a.ph_hi;
    if (threadIdx.x == 0) xb_words = make_uint4(0u, 0u, 0u, 0u);
    __syncthreads();
    const XcdBarrier xb = xcd_barrier_post((unsigned*)(a.ws + WS_CTL + 65536), (volatile LAS unsigned*)&xb_words);
    if (threadIdx.x == 0) {
        const unsigned hwid = (unsigned)__builtin_amdgcn_s_getreg((31 << 11) | 4), key = xb.x * 256u + ((hwid >> 8) & 0xffu);
        ((volatile unsigned*)&xb_words)[2] = atomicAdd((unsigned*)(a.ws + WS_CTL + 16384) + key, 1u);
    }
    __syncthreads();
    const int cu_role = __builtin_amdgcn_readfirstlane((int)(((volatile unsigned*)&xb_words)[2] & 1u));
#define GEMM_PRIO_ON()  (cu_role ? __builtin_amdgcn_s_setprio(2) : (void)0)
#define GEMM_PRIO_OFF() __builtin_amdgcn_s_setprio(0)
    if (hi < 0) grid.sync();
#define PHASE(k, call) do { const int k_ = (k); if (lo <= k_ && k_ < hi) { call; if (k_ + 1 < hi) xcd_barrier(xb); } } while (0)
    PHASE(0, (ph_prep(a, lds), convert_shared(a, lds)));
#pragma unroll 1
    for (int l = 0; l < 2; ++l) {
        const int base = 1 + l * NPH_LAYER;
        const int nrows = l == 0 ? TA : TL;
        PHASE(base + 0, ph_norm(a, l, 0, l > 0, l - 1, l == 0, TA));
        PHASE(base + 1, (GEMM_PRIO_ON(), ph_inproj(a, l, lds), GEMM_PRIO_OFF()));
        PHASE(base + 2, (blockIdx.x < (gridDim.x >> 1) ? (convert_experts(a, l, lds), __syncthreads(), ph_spatial(a, l, nrows, lds), ph_gla_kv(a, l, lds))
                                                        : (ph_spatial(a, l, nrows, lds), ph_gla_kv(a, l, lds), __syncthreads(), convert_experts(a, l, lds))));
        PHASE(base + 3, ph_gla_scan(a));
        PHASE(base + 4, ph_gla_out(a, l, lds));
        PHASE(base + 5, (GEMM_PRIO_ON(), ph_outproj(a, l, nrows, lds), GEMM_PRIO_OFF()));
        PHASE(base + 6, ph_norm(a, l, 1, false, 0, false, nrows));
        PHASE(base + 7, ph_router(a, l, nrows, lds));
        PHASE(base + 8, (GEMM_PRIO_ON(), ph_moe(a, l, 0, lds), GEMM_PRIO_OFF()));
        PHASE(base + 9, (GEMM_PRIO_ON(), ph_moe(a, l, 1, lds), GEMM_PRIO_OFF()));
    }
    PHASE(NPH - 1, ph_norm(a, 0, 2, true, 1, false, TL));
#undef PHASE
}

extern "C" void kernel_launch(void* const* d_in, const int* in_sizes, int n_in, void* d_out, int out_size, void* d_ws, size_t ws_size, hipStream_t stream) {
    static int grid = 0;
    if (grid == 0) {
        int dev = 0, cus = 0, per_cu = 0;
        hipGetDevice(&dev);
        hipDeviceGetAttribute(&cus, hipDeviceAttributeMultiprocessorCount, dev);
        hipOccupancyMaxActiveBlocksPerMultiprocessor(&per_cu, (const void*)mega, 256, 0);
        if (per_cu < 1) per_cu = 1;
        if (per_cu > 2) per_cu = 2;
        grid = cus * per_cu;
        if (n_in != 25 || ws_size < WS_END) { fprintf(stderr, "kernel_launch: unexpected n_in %d or ws_size %zu (need %zu)\n", n_in, ws_size, (size_t)WS_END); }
    }
    KArgs a{};
    for (int i = 0; i < 25; ++i) a.in[i] = (const float*)d_in[i];
    a.out = (float*)d_out; a.ws = (unsigned char*)d_ws;
    hipMemsetAsync(d_ws, 0, WS_MOD + 2 * 17 * 6144 * 4, stream);
#if ONE_LAUNCH
    a.ph_lo = 0; a.ph_hi = NPH;
    void* args[] = {&a};
    hipError_t e = hipLaunchCooperativeKernel((const void*)mega, dim3(grid), dim3(256), args, 0, stream);
    if (e != hipSuccess) fprintf(stderr, "cooperative launch failed: %s (grid %d)\n", hipGetErrorString(e), grid);
#else
    for (int ph = 0; ph < NPH; ++ph) {
        a.ph_lo = ph; a.ph_hi = ph + 1;
        hipLaunchKernelGGL(mega, dim3(grid), dim3(256), 0, stream, a);
    }
#endif
}
```

```cpp
#include <hip/hip_runtime.h>
#include <hip/hip_cooperative_groups.h>
#include <cstdio>
#include <cstdint>
namespace cg = cooperative_groups;

#ifndef ONE_LAUNCH
#define ONE_LAUNCH 1
#endif

#define DEV __device__ __forceinline__
typedef unsigned short bf16_t;
typedef float f32x4 __attribute__((ext_vector_type(4)));
typedef unsigned u32x2 __attribute__((ext_vector_type(2)));
typedef unsigned u32x4 __attribute__((ext_vector_type(4)));
typedef short bf16x8 __attribute__((ext_vector_type(8)));
typedef float f32x16 __attribute__((ext_vector_type(16)));
typedef long i64x2 __attribute__((ext_vector_type(2)));

constexpr int D = 1024, NB = 16, SEQ = 2048, CTXL = 256;
constexpr int TL = NB * SEQ, TC = NB * CTXL, TA = TL + TC;
constexpr int DIN = 2592, OFF_AU = 0, OFF_AV = 512, OFF_BQ = 1024, OFF_BR = 1280, OFF_BK = 1792, OFF_BV = 2048, OFF_BG = 2560;
constexpr int NE = 64, DE = 512, LCAP = 2 * TA;
constexpr float EPS = 1e-6f;

constexpr size_t MiB = 1u << 20;
constexpr size_t WS_CTL = 0, WS_MOD = 1 * MiB, WS_WRT = 2 * MiB, WS_WSP = 2 * MiB + 512 * 1024, WS_WINT = 3 * MiB, WS_WOUTT = 14 * MiB,
                 WS_W1T = 18 * MiB, WS_W3T = 82 * MiB, WS_W2T = 146 * MiB, WS_H = 210 * MiB, WS_HN = 354 * MiB, WS_Z = 426 * MiB, WS_MIX = 609 * MiB,
                 WS_KV = 681 * MiB, WS_LIST = 825 * MiB, WS_GATE = 843 * MiB, WS_DECAY = 844 * MiB, WS_HN8 = 846 * MiB, WS_END = 884 * MiB;
static_assert(WS_WINT + (size_t)2 * DIN * D * 2 <= WS_WOUTT && WS_WOUTT + (size_t)2 * D * D * 2 <= WS_W1T && WS_W1T + (size_t)NE * DE * D * 2 <= WS_W3T && WS_W2T + (size_t)NE * DE * D * 2 <= WS_H, "ws map (weights)");
static_assert(WS_H + (size_t)TA * D * 4 <= WS_HN && WS_HN + (size_t)TA * D * 2 <= WS_Z && WS_Z + (size_t)TA * DIN * 2 <= WS_MIX &&
              WS_MIX + (size_t)TA * D * 2 <= WS_KV && WS_KV + (size_t)2 * TA * 512 * 4 <= WS_LIST && WS_LIST + (size_t)NE * LCAP * 4 <= WS_GATE, "ws map");

struct KArgs { const float* in[25]; float* out; unsigned char* ws; int ph_lo, ph_hi; };
enum { I_X = 0, I_C, I_CTX, I_CCTX, I_WMOD, I_BMOD, I_GN1, I_WIN, I_LNG, I_LNB, I_WSP, I_BSP, I_WGU, I_BG, I_GGLA, I_WOUT, I_GN2, I_WRG, I_BRG, I_WRE, I_BRE, I_W1, I_W3, I_W2, I_GF };

DEV float bf2f(bf16_t v) { return __uint_as_float((unsigned)v << 16); }
typedef __bf16 bf16x2_t __attribute__((ext_vector_type(2)));
DEV bf16_t f2bf(float f) { return __builtin_bit_cast(bf16_t, (__bf16)f); }
DEV unsigned pk2(float lo, float hi) { bf16x2_t v; v.x = (__bf16)lo; v.y = (__bf16)hi; return __builtin_bit_cast(unsigned, v); }
DEV u32x4 widen_pair(u32x2 a, u32x2 b) {
    auto r0 = __builtin_amdgcn_permlane32_swap(a.x, b.x, false, false); auto r1 = __builtin_amdgcn_permlane32_swap(a.y, b.y, false, false);
    u32x4 o; o.x = r0[0]; o.y = r1[0]; o.z = r0[1]; o.w = r1[1]; return o;
}
constexpr float W8_SCALE = 32.f, W8_INV = 1.f / 32.f, YS_SCALE = 16.f, YS_INV = 1.f / 16.f;
DEV unsigned pk4_fp8(float a, float b, float c, float d) { int w = 0; w = __builtin_amdgcn_cvt_pk_fp8_f32(a, b, w, false); w = __builtin_amdgcn_cvt_pk_fp8_f32(c, d, w, true); return (unsigned)w; }
DEV float silu_f(float x) { return x * __builtin_amdgcn_rcpf(1.f + __expf(-x)); }
DEV float gelu_f(float x) { const float x2 = x * x; const float u2 = x * (1.5957691216057308f + 0.07135481627f * x2); return x * __builtin_amdgcn_rcpf(1.f + __expf(-u2)); }
DEV float logsigmoid_f(float x) { return fminf(x, 0.f) - __logf(1.f + __expf(-fabsf(x))); }
DEV float wave_sum(float v) {
#pragma unroll
    for (int o = 1; o < 64; o <<= 1) v += __shfl_xor(v, o);
    return v;
}
DEV int get_tid() { int t = threadIdx.x; asm volatile("" : "+v"(t)); return t; }
DEV int mod_index(int row) { return row < TL ? (row >> 11) : 16; }

DEV void ph_prep(const KArgs& a, unsigned char* lds) {
    const int tid = get_tid(), lane = tid & 63, wid = tid >> 6;
    float* slab = (float*)lds + wid * 17 * 64;
    float* red = (float*)lds + 4 * 17 * 64;
    float* mod = (float*)(a.ws + WS_MOD);
    const float* c = a.in[I_C]; const float* cctx = a.in[I_CCTX];
    for (int item = blockIdx.x; item < 2 * 96 * 2; item += gridDim.x) {
        const int kh = item & 1, it2 = item >> 1, l = it2 / 96, j0 = (it2 % 96) * 64, j = j0 + lane;
        const float* W = a.in[I_WMOD] + (size_t)l * D * 6144;
        float acc[17];
#pragma unroll
        for (int i = 0; i < 17; ++i) acc[i] = 0.f;
#pragma unroll 1
        for (int ks = 0; ks < 2; ++ks) {
            const int kb = kh * 512 + wid * 128 + ks * 64;
#pragma unroll
            for (int bi = 0; bi < 17; ++bi) { const float x = (bi < 16) ? c[bi * D + kb + lane] : cctx[kb + lane]; slab[bi * 64 + lane] = silu_f(x); }
            __syncthreads();
#pragma unroll 1
            for (int k8 = 0; k8 < 64; k8 += 16) {
                float w[16];
#pragma unroll
                for (int u = 0; u < 16; ++u) w[u] = __builtin_nontemporal_load(W + (size_t)(kb + k8 + u) * 6144 + j);
#pragma unroll
                for (int u = 0; u < 16; ++u)
#pragma unroll
                    for (int bi = 0; bi < 17; ++bi) acc[bi] += slab[bi * 64 + k8 + u] * w[u];
            }
            __syncthreads();
        }
#pragma unroll
        for (int bi = 0; bi < 17; ++bi) red[(wid * 17 + bi) * 64 + lane] = acc[bi];
        __syncthreads();
        for (int idx = tid; idx < 17 * 64; idx += 256) {
            const int bi = idx >> 6, ln = idx & 63;
            const float sv = red[(0 * 17 + bi) * 64 + ln] + red[(1 * 17 + bi) * 64 + ln] + red[(2 * 17 + bi) * 64 + ln] + red[(3 * 17 + bi) * 64 + ln] + (kh == 0 ? a.in[I_BMOD][l * 6144 + j0 + ln] : 0.f);
            atomicAdd(mod + (size_t)(l * 17 + bi) * 6144 + j0 + ln, sv);
        }
        __syncthreads();
    }
}

DEV void ph_norm(const KArgs& a, int layer, int which  , bool combine, int comb_layer, bool from_input, int nrows) {
    const int tid = get_tid(), lane = tid & 63, wid = tid >> 6;
    float* hws = (float*)(a.ws + WS_H);
    bf16_t* hn = (bf16_t*)(a.ws + WS_HN);
    const bf16_t* ys = (const bf16_t*)(a.ws + WS_KV);
    const float* mod = (const float*)(a.ws + WS_MOD);
    const float* g = which == 0 ? a.in[I_GN1] + layer * D : (which == 1 ? a.in[I_GN2] + layer * D : a.in[I_GF]);
    const int nw = gridDim.x * 4;
    for (int r = blockIdx.x * 4 + wid; r < nrows; r += nw) {
        const int bi = mod_index(r);
        const float* src = from_input ? (r < TL ? a.in[I_X] + (size_t)r * D : a.in[I_CTX] + (size_t)(r - TL) * D) : hws + (size_t)r * D;
        f32x4 v[4];
#pragma unroll
        for (int j = 0; j < 4; ++j) v[j] = __builtin_nontemporal_load((const f32x4*)(src + (lane + 64 * j) * 4));
        if (combine) {
            const float* g2 = mod + (size_t)(comb_layer * 17 + bi) * 6144 + 5 * D;
            unsigned y0v[4], y1v[4]; f32x4 ggv[4];
#pragma unroll
            for (int j = 0; j < 4; ++j) { const int k = (lane + 64 * j) * 4; y0v[j] = __builtin_nontemporal_load((const unsigned*)((const unsigned char*)ys + (size_t)(2 * r) * D + k)); y1v[j] = __builtin_nontemporal_load((const unsigned*)((const unsigned char*)ys + (size_t)(2 * r + 1) * D + k)); ggv[j] = *(const f32x4*)(g2 + k); }
#pragma unroll
            for (int j = 0; j < 4; ++j) {
                const int k = (lane + 64 * j) * 4;
                const int y0 = (int)y0v[j], y1 = (int)y1v[j];
                const f32x4 gg = ggv[j] * YS_INV;
                v[j].x += gg.x * (__builtin_amdgcn_cvt_f32_fp8(y0, 0) + __builtin_amdgcn_cvt_f32_fp8(y1, 0));
                v[j].y += gg.y * (__builtin_amdgcn_cvt_f32_fp8(y0, 1) + __builtin_amdgcn_cvt_f32_fp8(y1, 1));
                v[j].z += gg.z * (__builtin_amdgcn_cvt_f32_fp8(y0, 2) + __builtin_amdgcn_cvt_f32_fp8(y1, 2));
                v[j].w += gg.w * (__builtin_amdgcn_cvt_f32_fp8(y0, 3) + __builtin_amdgcn_cvt_f32_fp8(y1, 3));
                if (which != 2) __builtin_nontemporal_store(v[j], (f32x4*)(hws + (size_t)r * D + k));
            }
        }
        float ss = 0.f;
#pragma unroll
        for (int j = 0; j < 4; ++j) ss += v[j].x * v[j].x + v[j].y * v[j].y + v[j].z * v[j].z + v[j].w * v[j].w;
        const float rstd = rsqrtf(wave_sum(ss) * (1.f / D) + EPS);
        if (which == 2) {
            f32x4 gv[4];
#pragma unroll
            for (int j = 0; j < 4; ++j) gv[j] = *(const f32x4*)(g + (lane + 64 * j) * 4);
#pragma unroll
            for (int j = 0; j < 4; ++j) { const int k = (lane + 64 * j) * 4; f32x4 o = v[j] * rstd * gv[j]; __builtin_nontemporal_store(o, (f32x4*)(a.out + (size_t)r * D + k)); }
        } else {
            const float* sh = mod + (size_t)(layer * 17 + bi) * 6144 + (which == 0 ? 0 : 3 * D);
            const float* sc = sh + D;
            f32x4 gv[4], s1v[4], s0v[4];
#pragma unroll
            for (int j = 0; j < 4; ++j) { const int k = (lane + 64 * j) * 4; gv[j] = *(const f32x4*)(g + k); s1v[j] = *(const f32x4*)(sc + k); s0v[j] = *(const f32x4*)(sh + k); }
#pragma unroll
            for (int j = 0; j < 4; ++j) {
                const int k = (lane + 64 * j) * 4;
                const f32x4 gg = gv[j], s1 = s1v[j], s0 = s0v[j];
                const f32x4 o = v[j] * rstd * gg * (1.f + s1) + s0;
                u32x2 w; w.x = pk2(o.x, o.y); w.y = pk2(o.z, o.w);
                *(u32x2*)(hn + (size_t)r * D + k) = w;
                if (which == 1) *(unsigned*)(a.ws + WS_HN8 + (size_t)r * D + k) = pk4_fp8(o.x, o.y, o.z, o.w);
            }
        }
    }
}


DEV void transpose_item(const float* W, int K, int N, bf16_t* WT, float* scr, int kb, int nb, int lane) {
    const int k0 = kb * 64, n0 = nb * 32;
    float wv[32];
#pragma unroll
    for (int i = 0; i < 32; ++i) wv[i] = __builtin_nontemporal_load(W + (size_t)(k0 + 2 * i + (lane >> 5)) * N + n0 + (lane & 31));
#pragma unroll
    for (int i = 0; i < 32; ++i) scr[(2 * i + (lane >> 5)) * 33 + (lane & 31)] = wv[i];
    asm volatile("s_waitcnt lgkmcnt(0)" ::: "memory");
    const int c = lane & 7;
#pragma unroll
    for (int j = 0; j < 4; ++j) {
        const int n = (lane >> 3) + 8 * j; const float* sp = scr + (8 * c) * 33 + n;
        u32x4 o; o.x = pk2(sp[0 * 33], sp[1 * 33]); o.y = pk2(sp[2 * 33], sp[3 * 33]); o.z = pk2(sp[4 * 33], sp[5 * 33]); o.w = pk2(sp[6 * 33], sp[7 * 33]);
        *(u32x4*)(WT + (size_t)(n0 + n) * K + k0 + 8 * c) = o;
    }
    asm volatile("s_waitcnt lgkmcnt(0)" ::: "memory");
}
DEV void transpose_item8(const float* W, int K, int N, unsigned char* WT, float* scr, int kb, int nb, int lane) {
    const int k0 = kb * 64, n0 = nb * 32;
    float wv[32];
#pragma unroll
    for (int i = 0; i < 32; ++i) wv[i] = __builtin_nontemporal_load(W + (size_t)(k0 + 2 * i + (lane >> 5)) * N + n0 + (lane & 31));
#pragma unroll
    for (int i = 0; i < 32; ++i) scr[(2 * i + (lane >> 5)) * 33 + (lane & 31)] = wv[i] * W8_SCALE;
    asm volatile("s_waitcnt lgkmcnt(0)" ::: "memory");
    const int n = lane >> 1, kh = (lane & 1) * 32;
    const float* sp = scr + kh * 33 + n;
    u32x4 o0, o1;
    o0.x = pk4_fp8(sp[0 * 33], sp[1 * 33], sp[2 * 33], sp[3 * 33]); o0.y = pk4_fp8(sp[4 * 33], sp[5 * 33], sp[6 * 33], sp[7 * 33]);
    o0.z = pk4_fp8(sp[8 * 33], sp[9 * 33], sp[10 * 33], sp[11 * 33]); o0.w = pk4_fp8(sp[12 * 33], sp[13 * 33], sp[14 * 33], sp[15 * 33]);
    o1.x = pk4_fp8(sp[16 * 33], sp[17 * 33], sp[18 * 33], sp[19 * 33]); o1.y = pk4_fp8(sp[20 * 33], sp[21 * 33], sp[22 * 33], sp[23 * 33]);
    o1.z = pk4_fp8(sp[24 * 33], sp[25 * 33], sp[26 * 33], sp[27 * 33]); o1.w = pk4_fp8(sp[28 * 33], sp[29 * 33], sp[30 * 33], sp[31 * 33]);
    unsigned char* dp = WT + (size_t)(n0 + n) * K + k0 + kh;
    __builtin_nontemporal_store(o0, (u32x4*)dp); __builtin_nontemporal_store(o1, (u32x4*)(dp + 16));
    asm volatile("s_waitcnt lgkmcnt(0)" ::: "memory");
}
DEV void convert_experts(const KArgs& a, int layer, unsigned char* lds) {
    const int tid = get_tid(), lane = tid & 63, wid = tid >> 6;
    float* scr = (float*)lds + wid * (64 * 33);
    const int gw = blockIdx.x * 4 + wid, ngw = gridDim.x * 4;
    for (int it = gw; it < NE * 3 * 256; it += ngw) {
        const int mat = it >> 8, sub = it & 255, e = mat / 3, which = mat % 3;
        if (which < 2) {
            const float* W = a.in[which == 0 ? I_W1 : I_W3] + ((size_t)layer * NE + e) * D * DE;
            unsigned char* WT = a.ws + (which == 0 ? WS_W1T : WS_W3T) + (size_t)e * DE * D;
            transpose_item8(W, D, DE, WT, scr, sub >> 4, sub & 15, lane);
        } else {
            const float* W = a.in[I_W2] + ((size_t)layer * NE + e) * DE * D;
            unsigned char* WT = a.ws + WS_W2T + (size_t)e * D * DE;
            transpose_item8(W, DE, D, WT, scr, sub >> 5, sub & 31, lane);
        }
    }
}
DEV void convert_shared(const KArgs& a, unsigned char* lds) {
    const int tid = get_tid(), lane = tid & 63, wid = tid >> 6;
    float* scr = (float*)lds + wid * (64 * 33);
    const int gw = blockIdx.x * 4 + wid, ngw = gridDim.x * 4;
    constexpr int I_IN = 16 * 81, I_OUT = 16 * 32;
    for (int it = gw; it < 2 * I_IN + 2 * I_OUT; it += ngw) {
        if (it < 2 * I_IN) { const int l = it / I_IN, sub = it % I_IN; transpose_item(a.in[I_WIN] + (size_t)l * D * DIN, D, DIN, (bf16_t*)(a.ws + WS_WINT) + (size_t)l * DIN * D, scr, sub / 81, sub % 81, lane); }
        else { const int r = it - 2 * I_IN, l = r / I_OUT, sub = r % I_OUT; transpose_item(a.in[I_WOUT] + (size_t)l * D * D, D, D, (bf16_t*)(a.ws + WS_WOUTT) + (size_t)l * D * D, scr, sub >> 5, sub & 31, lane); }
    }
    bf16_t* wrt = (bf16_t*)(a.ws + WS_WRT); bf16_t* wsp = (bf16_t*)(a.ws + WS_WSP);
    const int gt = blockIdx.x * 256 + tid, ngt = gridDim.x * 256;
    for (int i = gt; i < 2 * 128 * D; i += ngt) {
        const int l = i >> 17, n = (i >> 10) & 127, k = i & 1023;
        float v = 0.f;
        if (n < 8) v = a.in[I_WRG][((size_t)l * D + k) * 8 + n]; else if (n < 72) v = a.in[I_WRE][((size_t)l * D + k) * 64 + (n - 8)];
        wrt[i] = f2bf(v);
    }
    for (int i = gt; i < 2 * 4 * 128 * 128; i += ngt) wsp[i] = f2bf(a.in[I_WSP][i]);
}

DEV void glds16(const bf16_t* src, unsigned char* dst) { __builtin_amdgcn_global_load_lds((const unsigned*)src, (__attribute__((address_space(3))) unsigned*)dst, 16, 0, 0); }
template <class ARow, class BRow>
DEV void gemm_core(unsigned char* lds, int nk, ARow arow, BRow brow, f32x16 (&acc)[2][2]) {
    const int tid = get_tid(), lane = tid & 63, wid = tid >> 6, wr = wid >> 1, wc = wid & 1;
    const int srow = tid >> 3, sch = (tid & 7) ^ ((tid >> 4) & 7);
    const bf16_t* ap[4]; const bf16_t* bp[4];
#pragma unroll
    for (int i = 0; i < 4; ++i) { ap[i] = arow(i * 32 + srow) + sch * 8; bp[i] = brow(i * 32 + srow) + sch * 8; }
#pragma unroll
    for (int mi = 0; mi < 2; ++mi)
#pragma unroll
        for (int ni = 0; ni < 2; ++ni)
#pragma unroll
            for (int r = 0; r < 16; ++r) acc[mi][ni][r] = 0.f;
    unsigned char* dst = lds + __builtin_amdgcn_readfirstlane(tid & ~63) * 16;
    const int fr = lane & 31, fh = lane >> 5, g = (fr >> 1) & 7;
    const unsigned char* ra = lds + (wr * 64 + fr) * 128;
    const unsigned char* rb = lds + 16384 + (wc * 64 + fr) * 128;
#pragma unroll
    for (int i = 0; i < 4; ++i) { glds16(ap[i], dst + i * 4096); glds16(bp[i], dst + 16384 + i * 4096); }
    if (nk > 1) {
#pragma unroll
        for (int i = 0; i < 4; ++i) { glds16(ap[i] + 64, dst + 32768 + i * 4096); glds16(bp[i] + 64, dst + 32768 + 16384 + i * 4096); }
    }
    for (int kt = 0; kt < nk; ++kt) {
        const int cur = (kt & 1) * 32768;
        if (kt + 1 < nk) asm volatile("s_waitcnt vmcnt(8)" ::: "memory"); else asm volatile("s_waitcnt vmcnt(0)" ::: "memory");
        __builtin_amdgcn_s_barrier();
        asm volatile("" ::: "memory");
        bf16x8 af[4][2], bfr[4][2];
#pragma unroll
        for (int ks = 0; ks < 4; ++ks) {
            const int co = ((ks * 2 + fh) ^ g) << 4;
#pragma unroll
            for (int mi = 0; mi < 2; ++mi) af[ks][mi] = *(const bf16x8*)(ra + cur + mi * 4096 + co);
#pragma unroll
            for (int ni = 0; ni < 2; ++ni) bfr[ks][ni] = *(const bf16x8*)(rb + cur + ni * 4096 + co);
        }
        asm volatile("s_waitcnt lgkmcnt(0)" ::: "memory");
        __builtin_amdgcn_s_barrier();
        asm volatile("" ::: "memory");
        if (kt + 2 < nk) {
            const int ko = (kt + 2) * 64;
#pragma unroll
            for (int i = 0; i < 4; ++i) { glds16(ap[i] + ko, dst + cur + i * 4096); glds16(bp[i] + ko, dst + cur + 16384 + i * 4096); }
        }
#pragma unroll
        for (int ks = 0; ks < 4; ++ks)
#pragma unroll
            for (int mi = 0; mi < 2; ++mi)
#pragma unroll
                for (int ni = 0; ni < 2; ++ni) acc[mi][ni] = __builtin_amdgcn_mfma_f32_32x32x16_bf16(af[ks][mi], bfr[ks][ni], acc[mi][ni], 0, 0, 0);
    }
    __builtin_amdgcn_s_barrier();
    asm volatile("" ::: "memory");
}
template <bool FP8 = false, class Prep, class ARow, class BRow, class Epi>
DEV void gemm_stream(unsigned char* lds, int nk, int t0, int tstep, int tend, Prep prep, ARow arow, BRow brow, Epi epi) {
    const int tid = get_tid(), lane = tid & 63, wid = tid >> 6, wr = wid >> 1, wc = wid & 1;
    const int srow = tid >> 3, sch = (tid & 7) ^ ((tid >> 4) & 7);
    if (t0 >= tend) return;
    auto cx = prep(t0);
    auto nx = cx;
    const bf16_t* ap[4]; const bf16_t* bp[4];
#pragma unroll
    for (int i = 0; i < 4; ++i) { ap[i] = arow(cx, i * 32 + srow) + sch * 8; bp[i] = brow(cx, i * 32 + srow) + sch * 8; }
    unsigned char* dst = lds + __builtin_amdgcn_readfirstlane(tid & ~63) * 16;
    const int fr = lane & 31, fh = lane >> 5, g = (fr >> 1) & 7;
    const unsigned char* ra = lds + (wr * 64 + fr) * 128;
    const unsigned char* rb = lds + 16384 + (wc * 64 + fr) * 128;
#pragma unroll
    for (int i = 0; i < 4; ++i) { glds16(ap[i], dst + i * 4096); glds16(bp[i], dst + 16384 + i * 4096); }
#pragma unroll
    for (int i = 0; i < 4; ++i) { glds16(ap[i] + 64, dst + 32768 + i * 4096); glds16(bp[i] + 64, dst + 32768 + 16384 + i * 4096); }
    for (int t = t0; t < tend; t += tstep) {
        const bool has_next = t + tstep < tend;
        f32x16 acc[2][2];
#pragma unroll
        for (int mi = 0; mi < 2; ++mi)
#pragma unroll
            for (int ni = 0; ni < 2; ++ni)
#pragma unroll
                for (int r = 0; r < 16; ++r) acc[mi][ni][r] = 0.f;
        for (int kt = 0; kt < nk; ++kt) {
            const int cur = (kt & 1) * 32768;
            if (kt + 1 < nk || has_next) asm volatile("s_waitcnt vmcnt(8)" ::: "memory"); else asm volatile("s_waitcnt vmcnt(0)" ::: "memory");
            __builtin_amdgcn_s_barrier();
            asm volatile("" ::: "memory");
            bf16x8 af[4][2], bfr[4][2];
            i64x2 a8[4][2], b8[4][2];
            if (!FP8) {
#pragma unroll
            for (int ks = 0; ks < 4; ++ks) {
                const int co = ((ks * 2 + fh) ^ g) << 4;
#pragma unroll
                for (int mi = 0; mi < 2; ++mi) af[ks][mi] = *(const bf16x8*)(ra + cur + mi * 4096 + co);
#pragma unroll
                for (int ni = 0; ni < 2; ++ni) bfr[ks][ni] = *(const bf16x8*)(rb + cur + ni * 4096 + co);
            }
            } else {
#pragma unroll
            for (int q = 0; q < 4; ++q) {
                const int co = ((q * 2 + fh) ^ g) << 4;
#pragma unroll
                for (int mi = 0; mi < 2; ++mi) a8[q][mi] = *(const i64x2*)(ra + cur + mi * 4096 + co);
#pragma unroll
                for (int ni = 0; ni < 2; ++ni) b8[q][ni] = *(const i64x2*)(rb + cur + ni * 4096 + co);
            }
            }
            asm volatile("s_waitcnt lgkmcnt(0)" ::: "memory");
            __builtin_amdgcn_sched_barrier(0);
            __builtin_amdgcn_s_barrier();
            asm volatile("" ::: "memory");
            __builtin_amdgcn_sched_barrier(0);
            int ko = -1;
            if (kt + 2 < nk) ko = (kt + 2) * 64;
            else if (has_next) {
                if (kt + 2 == nk) {
                    nx = prep(t + tstep);
#pragma unroll
                    for (int i = 0; i < 4; ++i) { ap[i] = arow(nx, i * 32 + srow) + sch * 8; bp[i] = brow(nx, i * 32 + srow) + sch * 8; }
                }
                ko = (kt + 2 - nk) * 64;
            }
            if (FP8) {
#pragma unroll
                for (int ks = 0; ks < 8; ++ks) {
                    if (ko >= 0) { if (ks & 1) glds16(bp[ks >> 1] + ko, dst + cur + 16384 + (ks >> 1) * 4096); else glds16(ap[ks >> 1] + ko, dst + cur + (ks >> 1) * 4096); }
                    acc[0][0] = __builtin_amdgcn_mfma_f32_32x32x16_fp8_fp8(a8[ks >> 1][0][ks & 1], b8[ks >> 1][0][ks & 1], acc[0][0], 0, 0, 0);
                    acc[0][1] = __builtin_amdgcn_mfma_f32_32x32x16_fp8_fp8(a8[ks >> 1][0][ks & 1], b8[ks >> 1][1][ks & 1], acc[0][1], 0, 0, 0);
                    acc[1][0] = __builtin_amdgcn_mfma_f32_32x32x16_fp8_fp8(a8[ks >> 1][1][ks & 1], b8[ks >> 1][0][ks & 1], acc[1][0], 0, 0, 0);
                    acc[1][1] = __builtin_amdgcn_mfma_f32_32x32x16_fp8_fp8(a8[ks >> 1][1][ks & 1], b8[ks >> 1][1][ks & 1], acc[1][1], 0, 0, 0);
                    __builtin_amdgcn_sched_barrier(0);
                }
            } else
#pragma unroll
            for (int ks = 0; ks < 4; ++ks) {
                if (ko >= 0) { glds16(ap[ks] + ko, dst + cur + ks * 4096); }
                acc[0][0] = __builtin_amdgcn_mfma_f32_32x32x16_bf16(af[ks][0], bfr[ks][0], acc[0][0], 0, 0, 0);
                acc[0][1] = __builtin_amdgcn_mfma_f32_32x32x16_bf16(af[ks][0], bfr[ks][1], acc[0][1], 0, 0, 0);
                __builtin_amdgcn_sched_barrier(0);
                if (ko >= 0) { glds16(bp[ks] + ko, dst + cur + 16384 + ks * 4096); }
                acc[1][0] = __builtin_amdgcn_mfma_f32_32x32x16_bf16(af[ks][1], bfr[ks][0], acc[1][0], 0, 0, 0);
                acc[1][1] = __builtin_amdgcn_mfma_f32_32x32x16_bf16(af[ks][1], bfr[ks][1], acc[1][1], 0, 0, 0);
                __builtin_amdgcn_sched_barrier(0);
            }
        }
        epi(cx, acc);
        cx = nx;
    }
    __builtin_amdgcn_s_barrier();
    asm volatile("" ::: "memory");
}
DEV int vblock() { const int G = gridDim.x, bx = blockIdx.x; return (G % 8 == 0) ? (bx % 8) * (G / 8) + bx / 8 : bx; }
#define ACC_FOREACH(mi, ni, r, row, col) \
    _Pragma("unroll") for (int mi = 0; mi < 2; ++mi) _Pragma("unroll") for (int ni = 0; ni < 2; ++ni) _Pragma("unroll") for (int r = 0; r < 16; ++r) \
        for (int row = (tid >> 7) * 64 + mi * 32 + (r & 3) + 8 * (r >> 2) + 4 * ((tid & 63) >> 5), col = ((tid >> 6) & 1) * 64 + ni * 32 + (tid & 31), once_ = 1; once_; once_ = 0)

template <class ARow, class Epi>
DEV void gemm_naive_tile(float* lds, int K, ARow arow, const float* W, int ldw, int col0, int ncols, Epi epi) {
    const int tid = get_tid(), ty = tid >> 4, tx = tid & 15;
    float* sA = lds;
    float* sB = lds + 16 * 68;
    const int ar = tid >> 2, kq = (tid & 3) * 4;
    const bf16_t* ap = arow(ar);
    const int kr = tid >> 4, c4 = (tid & 15) * 4;
    const bool cok = (col0 + c4) < ncols;
    float acc[4][4];
#pragma unroll
    for (int i = 0; i < 4; ++i)
#pragma unroll
        for (int j = 0; j < 4; ++j) acc[i][j] = 0.f;
    for (int k0 = 0; k0 < K; k0 += 16) {
        const u32x2 av = *(const u32x2*)(ap + k0 + kq);
        f32x4 wv = {0.f, 0.f, 0.f, 0.f};
        if (cok) wv = *(const f32x4*)(W + (size_t)(k0 + kr) * ldw + col0 + c4);
        sA[(kq + 0) * 68 + ar] = __uint_as_float(av.x << 16);
        sA[(kq + 1) * 68 + ar] = __uint_as_float(av.x & 0xffff0000u);
        sA[(kq + 2) * 68 + ar] = __uint_as_float(av.y << 16);
        sA[(kq + 3) * 68 + ar] = __uint_as_float(av.y & 0xffff0000u);
        *(f32x4*)(sB + kr * 64 + c4) = wv;
        __syncthreads();
#pragma unroll 4
        for (int k = 0; k < 16; ++k) {
            const f32x4 a4 = *(const f32x4*)(sA + k * 68 + ty * 4), b4 = *(const f32x4*)(sB + k * 64 + tx * 4);
            const float aa[4] = {a4.x, a4.y, a4.z, a4.w}, bb[4] = {b4.x, b4.y, b4.z, b4.w};
#pragma unroll
            for (int i = 0; i < 4; ++i)
#pragma unroll
                for (int j = 0; j < 4; ++j) acc[i][j] += aa[i] * bb[j];
        }
        __syncthreads();
    }
#pragma unroll
    for (int i = 0; i < 4; ++i)
#pragma unroll
        for (int j = 0; j < 4; ++j) { const int col = col0 + tx * 4 + j; if (col < ncols) epi(ty * 4 + i, col, acc[i][j]); }
}

DEV void ph_inproj(const KArgs& a, int layer, unsigned char* lds) {
    const int tid = get_tid();
    const bf16_t* hn = (const bf16_t*)(a.ws + WS_HN);
    bf16_t* z = (bf16_t*)(a.ws + WS_Z);
    const bf16_t* WT = (const bf16_t*)(a.ws + WS_WINT) + (size_t)layer * DIN * D;
    constexpr int ntn = (DIN + 127) / 128, nlat = (TL / 128) * ntn, ncn = ntn - OFF_BK / 128;
    const int ntiles = layer == 0 ? (TA / 128) * ntn : nlat + (TC / 128) * ncn;
    struct Cx { int row0, col0; };
    auto prep = [&](int t) { Cx c;
        if (layer == 0 || t < nlat) { c.row0 = (t / ntn) * 128; c.col0 = (t % ntn) * 128; }
        else { const int u = t - nlat; c.row0 = TL + (u / ncn) * 128; c.col0 = OFF_BK + (u % ncn) * 128; }
        return c; };
    gemm_stream(lds, D / 64, vblock(), gridDim.x, ntiles, prep,
        [&](const Cx& c, int r) { int n = c.col0 + r; n = n < DIN ? n : DIN - 1; return WT + (size_t)n * D; },
        [&](const Cx& c, int r) { return hn + (size_t)(c.row0 + r) * D; },
        [&](const Cx& c, const f32x16 (&acc)[2][2]) {
            const int row0 = c.row0, col0 = c.col0;
            const int wr = tid >> 7, wc = (tid >> 6) & 1, lane = tid & 63;
#pragma unroll
            for (int ni = 0; ni < 2; ++ni) {
                bf16_t* zr = z + (size_t)(row0 + wc * 64 + ni * 32 + (lane & 31)) * DIN + col0;
#pragma unroll
                for (int mi = 0; mi < 2; ++mi)
#pragma unroll
                    for (int kp = 0; kp < 2; ++kp) {
                        u32x2 wa, wb;
                        wa.x = pk2(acc[mi][ni][8 * kp], acc[mi][ni][8 * kp + 1]); wa.y = pk2(acc[mi][ni][8 * kp + 2], acc[mi][ni][8 * kp + 3]);
                        wb.x = pk2(acc[mi][ni][8 * kp + 4], acc[mi][ni][8 * kp + 5]); wb.y = pk2(acc[mi][ni][8 * kp + 6], acc[mi][ni][8 * kp + 7]);
                        const u32x4 w = widen_pair(wa, wb);
                        const int n = wr * 64 + mi * 32 + 16 * kp + 8 * (lane >> 5);
                        if (col0 + n < DIN) *(u32x4*)(zr + n) = w;
                    }
            }
        });
}

DEV void ph_outproj(const KArgs& a, int layer, int nrows, unsigned char* lds) {
    const int tid = get_tid();
    const bf16_t* mix = (const bf16_t*)(a.ws + WS_MIX);
    float* hws = (float*)(a.ws + WS_H);
    const float* mod = (const float*)(a.ws + WS_MOD);
    const bf16_t* WT = (const bf16_t*)(a.ws + WS_WOUTT) + (size_t)layer * D * D;
    constexpr int ntn = D / 128;
    gemm_stream(lds, D / 64, vblock(), gridDim.x, (nrows / 128) * ntn, [](int t) { return t; },
        [&](int t, int r) { return mix + (size_t)((t / ntn) * 128 + r) * D; },
        [&](int t, int r) { return WT + (size_t)((t % ntn) * 128 + r) * D; },
        [&](int t, const f32x16 (&acc)[2][2]) {
            const int row0 = (t / ntn) * 128, col0 = (t % ntn) * 128;
            const int bi = mod_index(row0);
            const float* g1 = mod + (size_t)(layer * 17 + bi) * 6144 + 2 * D + col0;
            const int wr = tid >> 7, wc = (tid >> 6) & 1, lane = tid & 63;
            const float g1a = g1[wc * 64 + (lane & 31)], g1b = g1[wc * 64 + 32 + (lane & 31)];
            const float* resb = (layer == 0 ? (row0 < TL ? a.in[I_X] + (size_t)row0 * D : a.in[I_CTX] + (size_t)(row0 - TL) * D) : hws + (size_t)row0 * D) + col0 + wc * 64 + (lane & 31);
            float* outb = hws + (size_t)row0 * D + col0 + wc * 64 + (lane & 31);
            float resc[8], resn[8];
#define OP_RO(b) ((size_t)(wr * 64 + ((b) >> 2) * 32 + 16 * ((b) & 1) + 4 * (lane >> 5)) * D + (((b) >> 1) & 1) * 32)
#pragma unroll
            for (int r = 0; r < 8; ++r) resc[r] = __builtin_nontemporal_load(resb + OP_RO(0) + (size_t)((r & 3) + 8 * (r >> 2)) * D);
#pragma unroll
            for (int b = 0; b < 8; ++b) {
                const int mi = b >> 2, ni = (b >> 1) & 1, hq = b & 1;
                if (b + 1 < 8) {
#pragma unroll
                    for (int r = 0; r < 8; ++r) resn[r] = __builtin_nontemporal_load(resb + OP_RO(b + 1) + (size_t)((r & 3) + 8 * (r >> 2)) * D);
                }
                asm volatile("" ::: "memory");
#pragma unroll
                for (int r = 0; r < 8; ++r) outb[OP_RO(b) + (size_t)((r & 3) + 8 * (r >> 2)) * D] = resc[r] + (ni ? g1b : g1a) * acc[mi][ni][8 * hq + r];
                asm volatile("" ::: "memory");
#pragma unroll
                for (int r = 0; r < 8; ++r) resc[r] = resn[r];
            }
#undef OP_RO
        });
}

DEV bf16x8 tr_frag_at(unsigned base, int RS, int c, int ks, int lane);
DEV void unpack8(const u32x4 v, float* f);
DEV void ph_spatial(const KArgs& a, int layer, int nrows, unsigned char* lds) {
    const int tid = get_tid(), lane = tid & 63, wid = tid >> 6, wr = wid >> 1, wc = wid & 1, fr = lane & 31, fh = lane >> 5;
    const bf16_t* z = (const bf16_t*)(a.ws + WS_Z);
    bf16_t* mix = (bf16_t*)(a.ws + WS_MIX);
    unsigned char* vs = lds;
    const unsigned vs_a = (unsigned)(size_t)vs;
    const int nitems = (nrows / 128) * 4;
    for (int item = vblock(); item < nitems; item += gridDim.x) {
        const int ci = item >> 2, g = item & 3, row0 = ci * 128;
        const int l8 = tid & 7, tk = tid >> 3;
        float lgv[16], lbv[16];
#pragma unroll
        for (int j = 0; j < 4; ++j) {
            const f32x4 g4 = *(const f32x4*)(a.in[I_LNG] + layer * 512 + g * 128 + l8 * 16 + 4 * j), b4 = *(const f32x4*)(a.in[I_LNB] + layer * 512 + g * 128 + l8 * 16 + 4 * j);
            lgv[4 * j] = g4.x; lgv[4 * j + 1] = g4.y; lgv[4 * j + 2] = g4.z; lgv[4 * j + 3] = g4.w; lbv[4 * j] = b4.x; lbv[4 * j + 1] = b4.y; lbv[4 * j + 2] = b4.z; lbv[4 * j + 3] = b4.w;
        }
#pragma unroll 2
        for (int pass = 0; pass < 4; ++pass) {
            const int tok = pass * 32 + tk;
            const bf16_t* zp = z + (size_t)(row0 + tok) * DIN + OFF_AV + g * 128 + l8 * 16;
            float x[16];
            unpack8(*(const u32x4*)zp, x); unpack8(*(const u32x4*)(zp + 8), x + 8);
            float sm = 0.f;
#pragma unroll
            for (int j = 0; j < 16; ++j) { x[j] = gelu_f(x[j]); sm += x[j]; }
            sm += __shfl_xor(sm, 1); sm += __shfl_xor(sm, 2); sm += __shfl_xor(sm, 4);
            const float mu = sm * (1.f / 128.f);
            float q = 0.f;
#pragma unroll
            for (int j = 0; j < 16; ++j) { x[j] -= mu; q += x[j] * x[j]; }
            q += __shfl_xor(q, 1); q += __shfl_xor(q, 2); q += __shfl_xor(q, 4);
            const float rs = rsqrtf(q * (1.f / 128.f) + EPS);
            u32x4 w0, w1;
            w0.x = pk2(x[0] * rs * lgv[0] + lbv[0], x[1] * rs * lgv[1] + lbv[1]); w0.y = pk2(x[2] * rs * lgv[2] + lbv[2], x[3] * rs * lgv[3] + lbv[3]);
            w0.z = pk2(x[4] * rs * lgv[4] + lbv[4], x[5] * rs * lgv[5] + lbv[5]); w0.w = pk2(x[6] * rs * lgv[6] + lbv[6], x[7] * rs * lgv[7] + lbv[7]);
            w1.x = pk2(x[8] * rs * lgv[8] + lbv[8], x[9] * rs * lgv[9] + lbv[9]); w1.y = pk2(x[10] * rs * lgv[10] + lbv[10], x[11] * rs * lgv[11] + lbv[11]);
            w1.z = pk2(x[12] * rs * lgv[12] + lbv[12], x[13] * rs * lgv[13] + lbv[13]); w1.w = pk2(x[14] * rs * lgv[14] + lbv[14], x[15] * rs * lgv[15] + lbv[15]);
            *(u32x4*)(vs + tok * 320 + l8 * 32) = w0; *(u32x4*)(vs + tok * 320 + l8 * 32 + 16) = w1;
        }
        __syncthreads();
        const bf16_t* wsp = (const bf16_t*)(a.ws + WS_WSP) + (size_t)(layer * 4 + g) * 128 * 128;
        f32x16 acc[2][2];
#pragma unroll
        for (int mi = 0; mi < 2; ++mi)
#pragma unroll
            for (int ni = 0; ni < 2; ++ni)
#pragma unroll
                for (int r = 0; r < 16; ++r) acc[mi][ni][r] = 0.f;
#pragma unroll 2
        for (int ks = 0; ks < 8; ++ks) {
            bf16x8 af[2], bfr[2];
#pragma unroll
            for (int mi = 0; mi < 2; ++mi) af[mi] = *(const bf16x8*)(wsp + (wr * 64 + mi * 32 + fr) * 128 + ks * 16 + fh * 8);
#pragma unroll
            for (int ni = 0; ni < 2; ++ni) bfr[ni] = tr_frag_at(vs_a, 320, wc * 2 + ni, ks, lane);
#pragma unroll
            for (int mi = 0; mi < 2; ++mi)
#pragma unroll
                for (int ni = 0; ni < 2; ++ni) acc[mi][ni] = __builtin_amdgcn_mfma_f32_32x32x16_bf16(af[mi], bfr[ni], acc[mi][ni], 0, 0, 0);
        }
        __syncthreads();
        ACC_FOREACH(mi, ni, r, row, col) { *(bf16_t*)(vs + row * 272 + col * 2) = f2bf(acc[mi][ni][r]); }
        __syncthreads();
        {
            const int p = tid >> 1, c0 = (tid & 1) * 64;
            const float bs = a.in[I_BSP][(layer * 4 + g) * 128 + p];
            const bf16_t* zu = z + (size_t)(row0 + p) * DIN + OFF_AU + g * 128 + c0;
            bf16_t* mo = mix + (size_t)(row0 + p) * D + g * 128 + c0;
            u32x4 zuv[8];
#pragma unroll
            for (int j = 0; j < 8; ++j) zuv[j] = *(const u32x4*)(zu + 8 * j);
#pragma unroll 2
            for (int j = 0; j < 8; ++j) {
                float uf[8], sf[8];
                unpack8(zuv[j], uf); unpack8(*(const u32x4*)(vs + p * 272 + (c0 + 8 * j) * 2), sf);
                u32x4 w;
                w.x = pk2(gelu_f(uf[0]) * (sf[0] + bs), gelu_f(uf[1]) * (sf[1] + bs)); w.y = pk2(gelu_f(uf[2]) * (sf[2] + bs), gelu_f(uf[3]) * (sf[3] + bs));
                w.z = pk2(gelu_f(uf[4]) * (sf[4] + bs), gelu_f(uf[5]) * (sf[5] + bs)); w.w = pk2(gelu_f(uf[6]) * (sf[6] + bs), gelu_f(uf[7]) * (sf[7] + bs));
                *(u32x4*)(mo + 8 * j) = w;
            }
        }
        __syncthreads();
    }
}

constexpr int GLA_LA_STRIDE = 65, GLA_VT_RS = 320, GLA_KD_RS = 192, GLA_QK_RS = 144;
constexpr int GLA_OFF_LA = 0, GLA_OFF_QE = 16896, GLA_OFF_KE = 16896 + 9216, GLA_OFF_VT = 16896 + 2 * 9216, GLA_OFF_WU = GLA_OFF_VT + 64 * GLA_VT_RS, GLA_OFF_TOT = GLA_OFF_WU + 2 * 4352, GLA_OFF_END = GLA_OFF_TOT + 1280;
static_assert(64 * GLA_LA_STRIDE * 4 <= GLA_OFF_QE && GLA_OFF_END <= 65536 + 768 && 64 * 132 * 4 <= GLA_OFF_VT && 64 * GLA_KD_RS <= 2 * 9216, "GLA LDS map");
DEV void gla_chunk_coords(int ci, int& row0, int& b, int& slot) {
    if (ci < 512) { row0 = ci * 64; b = ci >> 5; slot = 4 + (ci & 31); } else { const int c = ci - 512; row0 = TL + c * 64; b = c >> 2; slot = c & 3; }
}
DEV bf16x8 tr_frag(unsigned a0, unsigned a1) {
    u32x2 lo, hi;
    asm volatile("ds_read_b64_tr_b16 %0, %2\n\tds_read_b64_tr_b16 %1, %3\n\ts_waitcnt lgkmcnt(0)" : "=&v"(lo), "=&v"(hi) : "v"(a0), "v"(a1) : "memory");
    u32x4 w; w.x = lo.x; w.y = lo.y; w.z = hi.x; w.w = hi.y;
    return __builtin_bit_cast(bf16x8, w);
}
DEV bf16x8 tr_frag_at(unsigned base, int RS, int c, int ks, int lane) {
    const int h = lane >> 5, blk = (lane >> 4) & 1, q = (lane & 15) >> 2, p = lane & 3;
    const unsigned a0 = base + (unsigned)((16 * ks + 8 * h + q) * RS + (32 * c + 16 * blk + 4 * p) * 2);
    return tr_frag(a0, a0 + 4u * (unsigned)RS);
}
DEV void unpack8(const u32x4 v, float* f) {
    f[0] = __uint_as_float(v.x << 16); f[1] = __uint_as_float(v.x & 0xffff0000u); f[2] = __uint_as_float(v.y << 16); f[3] = __uint_as_float(v.y & 0xffff0000u);
    f[4] = __uint_as_float(v.z << 16); f[5] = __uint_as_float(v.z & 0xffff0000u); f[6] = __uint_as_float(v.w << 16); f[7] = __uint_as_float(v.w & 0xffff0000u);
}
DEV void gla_stage_gate(const KArgs& a, int layer, int dir, int h, float* swu, int tid) {
    bf16_t* hi = (bf16_t*)swu; bf16_t* lo = hi + 1024; float* bias = swu + 1024;
    for (int i = tid; i < 16 * 64; i += 256) {
        const int k = i >> 6, d = i & 63;
        const float w = a.in[I_WGU][((size_t)(layer * 2 + dir) * 16 + k) * 256 + h * 64 + d];
        const bf16_t wh = f2bf(w);
        hi[d * 16 + k] = wh; lo[d * 16 + k] = f2bf(w - bf2f(wh));
    }
    if (tid < 64) bias[tid] = a.in[I_BG][(layer * 2 + dir) * 256 + h * 64 + tid];
}
DEV void gla_logdecay(const bf16x8 zfrag, const float* swu, float* la, int tid) {
    const int lane = tid & 63, wid = tid >> 6, fr = lane & 31, fh = lane >> 5, dt = (wid & 1) * 32, tt = (wid >> 1) * 32;
    const bf16_t* hi = (const bf16_t*)swu; const bf16_t* lo = hi + 1024; const float* bias = swu + 1024;
    const bf16x8 bh = *(const bf16x8*)(hi + (dt + fr) * 16 + fh * 8), bl = *(const bf16x8*)(lo + (dt + fr) * 16 + fh * 8);
    f32x16 acc;
#pragma unroll
    for (int r = 0; r < 16; ++r) acc[r] = 0.f;
    acc = __builtin_amdgcn_mfma_f32_32x32x16_bf16(zfrag, bl, acc, 0, 0, 0);
    acc = __builtin_amdgcn_mfma_f32_32x32x16_bf16(zfrag, bh, acc, 0, 0, 0);
    const float bb = bias[dt + fr];
#pragma unroll
    for (int r = 0; r < 16; ++r) la[(tt + (r & 3) + 8 * (r >> 2) + 4 * fh) * GLA_LA_STRIDE + dt + fr] = logsigmoid_f(acc[r] + bb) * (1.f / 16.f);
}
DEV void gla_cumsum(float* la, float* tot, int dir, int tid) {
    const int d = tid & 63, sg = tid >> 6;
    float v[16];
#pragma unroll
    for (int t = 0; t < 16; ++t) v[t] = la[(sg * 16 + t) * GLA_LA_STRIDE + d];
    if (dir == 0) {
#pragma unroll
        for (int t = 1; t < 16; ++t) v[t] += v[t - 1];
        tot[sg * 64 + d] = v[15];
    } else {
#pragma unroll
        for (int t = 14; t >= 0; --t) v[t] += v[t + 1];
        tot[sg * 64 + d] = v[0];
    }
    __syncthreads();
    const float t0 = tot[d], t1 = tot[64 + d], t2 = tot[128 + d], t3 = tot[192 + d];
    float off;
    if (dir == 0) off = (sg > 0 ? t0 : 0.f) + (sg > 1 ? t1 : 0.f) + (sg > 2 ? t2 : 0.f);
    else off = (sg < 3 ? t3 : 0.f) + (sg < 2 ? t2 : 0.f) + (sg < 1 ? t1 : 0.f);
    if (sg == 0) tot[256 + d] = (t0 + t1) + (t2 + t3);
#pragma unroll
    for (int t = 0; t < 16; ++t) la[(sg * 16 + t) * GLA_LA_STRIDE + d] = v[t] + off;
    __syncthreads();
}
DEV void gla_store_v(const u32x4 (&vr)[4], unsigned char* vt, int tid) {
    const int i = tid >> 2, e0 = (tid & 3) * 32;
#pragma unroll
    for (int j = 0; j < 4; ++j) *(u32x4*)(vt + i * GLA_VT_RS + (e0 + 8 * j) * 2) = vr[j];
}

DEV void ph_gla_kv(const KArgs& a, int layer, unsigned char* lds) {
    const int tid = get_tid(), lane = tid & 63, wid = tid >> 6;
    const bf16_t* z = (const bf16_t*)(a.ws + WS_Z);
    bf16_t* kvo = (bf16_t*)(a.ws + WS_KV);
    float* dco = (float*)(a.ws + WS_DECAY);
    float* la = (float*)(lds + GLA_OFF_LA); unsigned char* kdt = lds + GLA_OFF_QE; unsigned char* vt = lds + GLA_OFF_VT;
    float* swu = (float*)(lds + GLA_OFF_WU); float* tot = (float*)(lds + GLA_OFF_TOT);
    const unsigned vt_a = (unsigned)(size_t)vt, kd_a = (unsigned)(size_t)kdt;
    const int vb = vblock(), h = vb & 3;
    gla_stage_gate(a, layer, 0, h, swu, tid); gla_stage_gate(a, layer, 1, h, swu + 1088, tid);
    __syncthreads();
    const int i = tid >> 2, d0 = (tid & 3) * 16, e0 = (tid & 3) * 32;
    for (int item = vb; item < 576 * 4; item += gridDim.x) {
        const int ci = item >> 2;
        int row0, b, slot; gla_chunk_coords(ci, row0, b, slot);
        const bf16_t* zr = z + (size_t)(row0 + i) * DIN;
        const bf16_t* zgp = z + (size_t)(row0 + (wid >> 1) * 32 + (lane & 31)) * DIN + OFF_BG + (lane >> 5) * 8;
        const bf16x8 zf0 = *(const bf16x8*)zgp, zf1 = *(const bf16x8*)(zgp + 16);
        const u32x4 kr0 = *(const u32x4*)(zr + OFF_BK + h * 64 + d0), kr1 = *(const u32x4*)(zr + OFF_BK + h * 64 + d0 + 8);
        u32x4 vr[4];
#pragma unroll
        for (int j = 0; j < 4; ++j) vr[j] = *(const u32x4*)(zr + OFF_BV + h * 128 + e0 + 8 * j);
        gla_store_v(vr, vt, tid);
#pragma unroll 1
        for (int dir = 0; dir < 2; ++dir) {
            gla_logdecay(dir ? zf1 : zf0, swu + dir * 1088, la, tid);
            __syncthreads();
            gla_cumsum(la, tot, dir, tid);
            const size_t tile = (size_t)(((dir * NB + b) * 4 + h) * 36 + slot);
            {
                float kf[16];
                unpack8(kr0, kf); unpack8(kr1, kf + 8);
#pragma unroll
                for (int dd = 0; dd < 16; ++dd) kf[dd] *= __expf(tot[256 + d0 + dd] - la[i * GLA_LA_STRIDE + d0 + dd]);
                u32x4 w0, w1;
                w0.x = pk2(kf[0], kf[1]); w0.y = pk2(kf[2], kf[3]); w0.z = pk2(kf[4], kf[5]); w0.w = pk2(kf[6], kf[7]);
                w1.x = pk2(kf[8], kf[9]); w1.y = pk2(kf[10], kf[11]); w1.z = pk2(kf[12], kf[13]); w1.w = pk2(kf[14], kf[15]);
                *(u32x4*)(kdt + i * GLA_KD_RS + d0 * 2) = w0; *(u32x4*)(kdt + i * GLA_KD_RS + d0 * 2 + 16) = w1;
                if (tid < 64) dco[tile * 64 + tid] = __expf(tot[256 + tid]);
            }
            __syncthreads();
            f32x16 acc[2];
#pragma unroll
            for (int nt = 0; nt < 2; ++nt)
#pragma unroll
                for (int r = 0; r < 16; ++r) acc[nt][r] = 0.f;
#pragma unroll
            for (int ks = 0; ks < 4; ++ks) {
                const bf16x8 af = tr_frag_at(vt_a, GLA_VT_RS, wid, ks, lane);
#pragma unroll
                for (int nt = 0; nt < 2; ++nt) { const bf16x8 bfr = tr_frag_at(kd_a, GLA_KD_RS, nt, ks, lane); acc[nt] = __builtin_amdgcn_mfma_f32_32x32x16_bf16(af, bfr, acc[nt], 0, 0, 0); }
            }
            bf16_t* out = kvo + tile * 8192;
#pragma unroll
            for (int nt = 0; nt < 2; ++nt)
#pragma unroll
                for (int r = 0; r < 16; ++r) { const int e = wid * 32 + (r & 3) + 8 * (r >> 2) + 4 * (lane >> 5); out[e * 64 + nt * 32 + (lane & 31)] = f2bf(acc[nt][r]); }
            __syncthreads();
        }
    }
}

DEV void ph_gla_scan(const KArgs& a) {
    const int tid = get_tid();
    const bf16_t* kv = (const bf16_t*)(a.ws + WS_KV);
    const float* dc = (const float*)(a.ws + WS_DECAY);
    bf16_t* sp = (bf16_t*)(a.ws + WS_HN);
    for (int item = blockIdx.x; item < 2 * NB * 4 * 8; item += gridDim.x) {
        const int dbh = item >> 3, sub = item & 7, dir = dbh >> 6;
        const int e = sub * 16 + (tid >> 4), dq = (tid & 15) * 4;
        f32x4 S = {0.f, 0.f, 0.f, 0.f};
#pragma unroll 1
        for (int s0 = 0; s0 < 36; s0 += 12) {
            u32x2 kvr[12]; f32x4 dcv[12];
#pragma unroll
            for (int q = 0; q < 12; ++q) {
                const int step = s0 + q, slot = dir == 0 ? step : (step < 4 ? 3 - step : 39 - step);
                const size_t tile = (size_t)dbh * 36 + slot;
                kvr[q] = __builtin_nontemporal_load((const u32x2*)(kv + tile * 8192 + e * 64 + dq)); dcv[q] = *(const f32x4*)(dc + tile * 64 + dq);
            }
#pragma unroll
            for (int q = 0; q < 12; ++q) {
                const int step = s0 + q, slot = dir == 0 ? step : (step < 4 ? 3 - step : 39 - step);
                const size_t tile = (size_t)dbh * 36 + slot;
                const f32x4 kvv = {__uint_as_float(kvr[q].x << 16), __uint_as_float(kvr[q].x & 0xffff0000u), __uint_as_float(kvr[q].y << 16), __uint_as_float(kvr[q].y & 0xffff0000u)};
                u32x2 w; w.x = pk2(S.x, S.y); w.y = pk2(S.z, S.w);
                *(u32x2*)(sp + tile * 8192 + e * 64 + dq) = w;
                S = dcv[q] * S + kvv;
            }
        }
    }
}

DEV void ph_gla_out(const KArgs& a, int layer, unsigned char* lds) {
    const int tid = get_tid(), lane = tid & 63, wid = tid >> 6, ih = wid >> 1, eh = wid & 1, fr = lane & 31, fh = lane >> 5;
    const bf16_t* z = (const bf16_t*)(a.ws + WS_Z);
    const bf16_t* sp = (const bf16_t*)(a.ws + WS_HN);
    bf16_t* mix = (bf16_t*)(a.ws + WS_MIX);
    float* la = (float*)(lds + GLA_OFF_LA); unsigned char* att = lds + GLA_OFF_LA; unsigned char* qet = lds + GLA_OFF_QE; unsigned char* ket = lds + GLA_OFF_KE; unsigned char* vt = lds + GLA_OFF_VT;
    float* swu = (float*)(lds + GLA_OFF_WU); float* tot = (float*)(lds + GLA_OFF_TOT); float* ob = (float*)lds;
    const unsigned vt_a = (unsigned)(size_t)vt;
    const int nchunks = layer == 0 ? 576 : 512;
    const int vb = vblock(), h = vb & 3;
    gla_stage_gate(a, layer, 0, h, swu, tid); gla_stage_gate(a, layer, 1, h, swu + 1088, tid);
    __syncthreads();
    const int i = tid >> 2, d0 = (tid & 3) * 16, e0 = (tid & 3) * 32;
    for (int item = vb; item < nchunks * 4; item += gridDim.x) {
        const int ci = item >> 2;
        int row0, b, slot; gla_chunk_coords(ci, row0, b, slot);
        const bf16_t* zr = z + (size_t)(row0 + i) * DIN;
        const bf16_t* zgp = z + (size_t)(row0 + (wid >> 1) * 32 + (lane & 31)) * DIN + OFF_BG + (lane >> 5) * 8;
        const bf16x8 zf0 = *(const bf16x8*)zgp, zf1 = *(const bf16x8*)(zgp + 16);
        const u32x4 qr0 = *(const u32x4*)(zr + OFF_BQ + h * 64 + d0), qr1 = *(const u32x4*)(zr + OFF_BQ + h * 64 + d0 + 8);
        const u32x4 kr0 = *(const u32x4*)(zr + OFF_BK + h * 64 + d0), kr1 = *(const u32x4*)(zr + OFF_BK + h * 64 + d0 + 8);
        u32x4 vr[4], rr4[4];
#pragma unroll
        for (int j = 0; j < 4; ++j) vr[j] = *(const u32x4*)(zr + OFF_BV + h * 128 + e0 + 8 * j);
#pragma unroll
        for (int j = 0; j < 4; ++j) rr4[j] = *(const u32x4*)(zr + OFF_BR + h * 128 + e0 + 8 * j);
        gla_store_v(vr, vt, tid);
        f32x16 acc[2];
#pragma unroll
        for (int nt = 0; nt < 2; ++nt)
#pragma unroll
            for (int r = 0; r < 16; ++r) acc[nt][r] = 0.f;
#pragma unroll 1
        for (int dir = 0; dir < 2; ++dir) {
            gla_logdecay(dir ? zf1 : zf0, swu + dir * 1088, la, tid);
            __syncthreads();
            gla_cumsum(la, tot, dir, tid);
            {
                float qf[16], kf[16];
                unpack8(qr0, qf); unpack8(qr1, qf + 8); unpack8(kr0, kf); unpack8(kr1, kf + 8);
#pragma unroll
                for (int dd = 0; dd < 16; ++dd) { const float bb = la[i * GLA_LA_STRIDE + d0 + dd]; qf[dd] *= 0.125f * __expf(bb); kf[dd] *= __expf(-bb); }
                u32x4 w0, w1;
                w0.x = pk2(qf[0], qf[1]); w0.y = pk2(qf[2], qf[3]); w0.z = pk2(qf[4], qf[5]); w0.w = pk2(qf[6], qf[7]);
                w1.x = pk2(qf[8], qf[9]); w1.y = pk2(qf[10], qf[11]); w1.z = pk2(qf[12], qf[13]); w1.w = pk2(qf[14], qf[15]);
                *(u32x4*)(qet + i * GLA_QK_RS + d0 * 2) = w0; *(u32x4*)(qet + i * GLA_QK_RS + d0 * 2 + 16) = w1;
                w0.x = pk2(kf[0], kf[1]); w0.y = pk2(kf[2], kf[3]); w0.z = pk2(kf[4], kf[5]); w0.w = pk2(kf[6], kf[7]);
                w1.x = pk2(kf[8], kf[9]); w1.y = pk2(kf[10], kf[11]); w1.z = pk2(kf[12], kf[13]); w1.w = pk2(kf[14], kf[15]);
                *(u32x4*)(ket + i * GLA_QK_RS + d0 * 2) = w0; *(u32x4*)(ket + i * GLA_QK_RS + d0 * 2 + 16) = w1;
            }
            const bf16_t* st = sp + (size_t)(((dir * NB + b) * 4 + h) * 36 + slot) * 8192;
            bf16x8 bs[4][2];
#pragma unroll
            for (int ks = 0; ks < 4; ++ks)
#pragma unroll
                for (int nt = 0; nt < 2; ++nt) bs[ks][nt] = *(const bf16x8*)(st + (eh * 64 + nt * 32 + fr) * 64 + ks * 16 + fh * 8);
            __syncthreads();
            bf16x8 aq[4];
#pragma unroll
            for (int ks = 0; ks < 4; ++ks) aq[ks] = *(const bf16x8*)(qet + (ih * 32 + fr) * GLA_QK_RS + (ks * 16 + fh * 8) * 2);
            {
                f32x16 sa;
#pragma unroll
                for (int r = 0; r < 16; ++r) sa[r] = 0.f;
#pragma unroll
                for (int ks = 0; ks < 4; ++ks) { const bf16x8 bk = *(const bf16x8*)(ket + (eh * 32 + fr) * GLA_QK_RS + (ks * 16 + fh * 8) * 2); sa = __builtin_amdgcn_mfma_f32_32x32x16_bf16(aq[ks], bk, sa, 0, 0, 0); }
                const int j = eh * 32 + fr;
#pragma unroll
                for (int r = 0; r < 16; ++r) {
                    const int ii = ih * 32 + (r & 3) + 8 * (r >> 2) + 4 * fh;
                    const bool keep = dir == 0 ? (j <= ii) : (j >= ii);
                    *(bf16_t*)(att + ii * GLA_QK_RS + j * 2) = f2bf(keep ? sa[r] : 0.f);
                }
            }
            __syncthreads();
#pragma unroll
            for (int ks = 0; ks < 4; ++ks) {
                const bf16x8 aa = *(const bf16x8*)(att + (ih * 32 + fr) * GLA_QK_RS + (ks * 16 + fh * 8) * 2);
#pragma unroll
                for (int nt = 0; nt < 2; ++nt) {
                    const bf16x8 bv = tr_frag_at(vt_a, GLA_VT_RS, eh * 2 + nt, ks, lane);
                    acc[nt] = __builtin_amdgcn_mfma_f32_32x32x16_bf16(aa, bv, acc[nt], 0, 0, 0);
                    acc[nt] = __builtin_amdgcn_mfma_f32_32x32x16_bf16(aq[ks], bs[ks][nt], acc[nt], 0, 0, 0);
                }
            }
            __syncthreads();
        }
#pragma unroll
        for (int nt = 0; nt < 2; ++nt)
#pragma unroll
            for (int r = 0; r < 16; ++r) ob[(ih * 32 + (r & 3) + 8 * (r >> 2) + 4 * fh) * 132 + eh * 64 + nt * 32 + fr] = acc[nt][r];
        __syncthreads();
        {
            float o[32]; float ss = 0.f;
#pragma unroll
            for (int j = 0; j < 8; ++j) { const f32x4 v = *(const f32x4*)(ob + i * 132 + e0 + 4 * j); o[4 * j] = v.x; o[4 * j + 1] = v.y; o[4 * j + 2] = v.z; o[4 * j + 3] = v.w; ss += v.x * v.x + v.y * v.y + v.z * v.z + v.w * v.w; }
            ss += __shfl_xor(ss, 1); ss += __shfl_xor(ss, 2);
            const float rstd = rsqrtf(ss * (1.f / 128.f) + EPS);
            const float* gg = a.in[I_GGLA] + layer * 512 + h * 128 + e0;
            bf16_t* mo = mix + (size_t)(row0 + i) * D + 512 + h * 128 + e0;
#pragma unroll
            for (int j = 0; j < 4; ++j) {
                float rf[8]; unpack8(rr4[j], rf);
                const f32x4 g0 = *(const f32x4*)(gg + 8 * j), g1 = *(const f32x4*)(gg + 8 * j + 4);
                u32x4 w;
                w.x = pk2(o[8 * j + 0] * rstd * g0.x * silu_f(rf[0]), o[8 * j + 1] * rstd * g0.y * silu_f(rf[1]));
                w.y = pk2(o[8 * j + 2] * rstd * g0.z * silu_f(rf[2]), o[8 * j + 3] * rstd * g0.w * silu_f(rf[3]));
                w.z = pk2(o[8 * j + 4] * rstd * g1.x * silu_f(rf[4]), o[8 * j + 5] * rstd * g1.y * silu_f(rf[5]));
                w.w = pk2(o[8 * j + 6] * rstd * g1.z * silu_f(rf[6]), o[8 * j + 7] * rstd * g1.w * silu_f(rf[7]));
                *(u32x4*)(mo + 8 * j) = w;
            }
        }
        __syncthreads();
    }
}

DEV void ph_router(const KArgs& a, int layer, int nrows, unsigned char* lds) {
    const int tid = get_tid();
    const bf16_t* hn = (const bf16_t*)(a.ws + WS_HN);
    const bf16_t* WT = (const bf16_t*)(a.ws + WS_WRT) + (size_t)layer * 128 * D;
    unsigned* cnt = (unsigned*)(a.ws + WS_CTL) + layer * NE;
    unsigned* list = (unsigned*)(a.ws + WS_LIST);
    float* gate = (float*)(a.ws + WS_GATE);
    float* lgs = (float*)lds;
    for (int t = vblock(); t < nrows / 128; t += gridDim.x) {
        const int row0 = t * 128;
        f32x16 acc[2][2];
        gemm_core(lds, D / 64, [&](int r) { return hn + (size_t)(row0 + r) * D; }, [&](int r) { return WT + (size_t)r * D; }, acc);
        ACC_FOREACH(mi, ni, r, row, col) { if (col < 72) lgs[row * 73 + col] = acc[mi][ni][r]; }
        __syncthreads();
        if (tid < 128) {
            const float* lr = lgs + tid * 73; const int r = row0 + tid;
            float lg[8];
#pragma unroll
            for (int j = 0; j < 8; ++j) lg[j] = lr[j] + a.in[I_BRG][layer * 8 + j];
            float m = lg[0]; int gi = 0;
#pragma unroll
            for (int j = 1; j < 8; ++j) if (lg[j] > m) { m = lg[j]; gi = j; }
            float sum = 0.f;
#pragma unroll
            for (int j = 0; j < 8; ++j) sum += __expf(lg[j] - m);
            const float ptop = 1.f / sum;
            float le[8];
#pragma unroll
            for (int j = 0; j < 8; ++j) le[j] = lr[8 + gi * 8 + j] + a.in[I_BRE][layer * 64 + gi * 8 + j];
            float l1 = le[0]; int i1 = 0;
#pragma unroll
            for (int j = 1; j < 8; ++j) if (le[j] > l1) { l1 = le[j]; i1 = j; }
            float l2 = -3.0e38f; int i2 = 0;
#pragma unroll
            for (int j = 0; j < 8; ++j) if (j != i1 && le[j] > l2) { l2 = le[j]; i2 = j; }
            const float e2 = __expf(l2 - l1), w1 = 1.f / (1.f + e2), w2 = e2 / (1.f + e2);
            const int ex1 = gi * 8 + i1, ex2 = gi * 8 + i2;
            const unsigned p1 = atomicAdd(cnt + ex1, 1u), p2 = atomicAdd(cnt + ex2, 1u);
            list[(size_t)ex1 * LCAP + p1] = (unsigned)(2 * r); list[(size_t)ex2 * LCAP + p2] = (unsigned)(2 * r + 1);
            gate[2 * r] = ptop * w1; gate[2 * r + 1] = ptop * w2;
        }
        __syncthreads();
    }
}

DEV void ph_moe(const KArgs& a, int layer, int sub, unsigned char* lds) {
    const int tid = get_tid();
    const unsigned* cnt = (const unsigned*)(a.ws + WS_CTL) + layer * NE;
    const unsigned* list = (const unsigned*)(a.ws + WS_LIST);
    const float* gate = (const float*)(a.ws + WS_GATE);
    bf16_t* ys = (bf16_t*)(a.ws + WS_KV);
    int (*s_off)[80] = (int (*)[80])(lds + 65536);
    constexpr int ntn = 8;
    if (tid < NE) s_off[0][tid] = (int)cnt[tid];
    __syncthreads();
    if (tid == 0) { int o = 0, t = 0; for (int e = 0; e < NE; ++e) { const int c = s_off[0][e]; s_off[0][e] = o; s_off[1][e] = t; o += c; t += ((c + 127) / 128) * ntn; } s_off[0][NE] = o; s_off[1][NE] = t; }
    __syncthreads();
    const int ntiles = s_off[1][NE];
    struct Cx { int e, p0, nt, c, ro; };
    auto prep = [&](int t) { Cx x; int e = 0;
#pragma unroll
        for (int st = 32; st >= 1; st >>= 1) if (s_off[1][e + st] <= t) e += st;
        const int local = t - s_off[1][e]; x.e = e; x.p0 = (local / ntn) * 128; x.nt = local % ntn; x.c = (int)cnt[e]; x.ro = s_off[0][e];
        return x; };
    const int wr = tid >> 7, wc = (tid >> 6) & 1, lane = tid & 63;
    const unsigned char* hn8 = a.ws + WS_HN8;
    unsigned char* H8 = a.ws + WS_Z;
    if (sub == 0) {
        gemm_stream<true>(lds, D / 128, vblock(), gridDim.x, ntiles, prep,
            [&](const Cx& x, int r) { const int n = x.nt * 64 + (r >> 6) * 32 + (r & 31);
                                return (const bf16_t*)(a.ws + ((r >> 5) & 1 ? WS_W3T : WS_W1T) + ((size_t)x.e * DE + n) * D); },
            [&](const Cx& x, int r) { const int p = x.p0 + r; const unsigned slot = list[(size_t)x.e * LCAP + (p < x.c ? p : 0)]; return (const bf16_t*)(hn8 + (size_t)(slot >> 1) * D); },
            [&](const Cx& x, const f32x16 (&acc)[2][2]) {
                const int p0 = x.p0, nt = x.nt, c = x.c, ro = x.ro;
#pragma unroll
                for (int ni = 0; ni < 2; ++ni) {
                    const int p = p0 + wc * 64 + ni * 32 + (lane & 31);
                    unsigned char* hr = H8 + (size_t)(ro + (p < c ? p : 0)) * DE + nt * 64 + wr * 32 + 8 * (lane >> 5);
#pragma unroll
                    for (int kp = 0; kp < 2; ++kp) {
                        float hv[8];
#pragma unroll
                        for (int q = 0; q < 8; ++q) hv[q] = silu_f(acc[0][ni][8 * kp + q] * W8_INV) * (acc[1][ni][8 * kp + q] * W8_INV);
                        const unsigned wa = pk4_fp8(hv[0], hv[1], hv[2], hv[3]), wb = pk4_fp8(hv[4], hv[5], hv[6], hv[7]);
                        auto rsw = __builtin_amdgcn_permlane32_swap(wa, wb, false, false);
                        u32x2 w; w.x = rsw[0]; w.y = rsw[1];
                        if (p < c) *(u32x2*)(hr + 16 * kp) = w;
                    }
                }
            });
    } else {
        gemm_stream<true>(lds, DE / 128, vblock(), gridDim.x, ntiles, prep,
            [&](const Cx& x, int r) { return (const bf16_t*)(a.ws + WS_W2T + ((size_t)x.e * D + x.nt * 128 + r) * DE); },
            [&](const Cx& x, int r) { const int p = x.p0 + r; return (const bf16_t*)(H8 + (size_t)(x.ro + (p < x.c ? p : 0)) * DE); },
            [&](const Cx& x, const f32x16 (&acc)[2][2]) {
                const int e = x.e, p0 = x.p0, nt = x.nt, c = x.c;
                unsigned slotv[2]; float gtv[2];
#pragma unroll
                for (int ni = 0; ni < 2; ++ni) { const int p = p0 + wc * 64 + ni * 32 + (lane & 31); slotv[ni] = list[(size_t)e * LCAP + (p < c ? p : 0)]; }
#pragma unroll
                for (int ni = 0; ni < 2; ++ni) gtv[ni] = gate[slotv[ni]] * W8_INV;
#pragma unroll
                for (int ni = 0; ni < 2; ++ni) {
                    const int p = p0 + wc * 64 + ni * 32 + (lane & 31);
                    const unsigned slot = slotv[ni]; const float gt = gtv[ni] * YS_SCALE;
                    unsigned char* yo = (unsigned char*)ys + (size_t)slot * D + nt * 128 + wr * 64 + 8 * (lane >> 5);
#pragma unroll
                    for (int mi = 0; mi < 2; ++mi)
#pragma unroll
                        for (int kp = 0; kp < 2; ++kp) {
                            const unsigned wa = pk4_fp8(gt * acc[mi][ni][8 * kp], gt * acc[mi][ni][8 * kp + 1], gt * acc[mi][ni][8 * kp + 2], gt * acc[mi][ni][8 * kp + 3]);
                            const unsigned wb = pk4_fp8(gt * acc[mi][ni][8 * kp + 4], gt * acc[mi][ni][8 * kp + 5], gt * acc[mi][ni][8 * kp + 6], gt * acc[mi][ni][8 * kp + 7]);
                            auto rsw = __builtin_amdgcn_permlane32_swap(wa, wb, false, false);
                            u32x2 w; w.x = rsw[0]; w.y = rsw[1];
                            if (p < c) *(u32x2*)(yo + mi * 32 + 16 * kp) = w;
                        }
                }
            });
    }
}

#define XB_TMO      128
#define XB_XCNT(j)  (256  + 64 * (j))
#define XB_XSUB(j)  (1280 + 64 * (j))
#define XB_XGEN(j)  (2304 + 64 * (j))
#define XB_TOP      3328
#define XB_TOPGEN   3392
#define XCD_BAR_WORDS 3456
#define XB_SPIN_CAP (1u << 18)
#define LAS __attribute__((address_space(3)))
DEV unsigned xb_ld(unsigned* p)              { return __hip_atomic_load(p, __ATOMIC_RELAXED, __HIP_MEMORY_SCOPE_AGENT); }
DEV unsigned xb_add(unsigned* p, unsigned v) { return __hip_atomic_fetch_add(p, v, __ATOMIC_RELAXED, __HIP_MEMORY_SCOPE_AGENT); }
DEV unsigned xb_xcc_id() { return (unsigned)__builtin_amdgcn_s_getreg((3 << 11) | 20) & 0xFu; }
#define XB_SPIN(cond, bar) do { unsigned _sp = 0; while (cond) { __builtin_amdgcn_s_sleep(1); \
    if ((++_sp & 255u) == 0u) { if (xb_ld(&(bar)[XB_TMO])) break; if (_sp > XB_SPIN_CAP) { atomicAdd(&(bar)[XB_TMO], 1u); break; } } } } while (0)
struct XcdBarrier { unsigned* bar; unsigned x; volatile LAS unsigned* st; };
DEV XcdBarrier xcd_barrier_post(unsigned* bar, volatile LAS unsigned* st) {
    XcdBarrier b; b.bar = bar; b.x = xb_xcc_id(); b.st = st;
    if (threadIdx.x == 0) (void)xb_add(&bar[XB_XCNT(b.x)], 1u);
    return b;
}
DEV void xcd_barrier_complete(unsigned* bar, unsigned x, unsigned& nloc, unsigned& nx) {
    const unsigned G = gridDim.x * gridDim.y * gridDim.z;
    unsigned sum, cnt, mine, sp = 0u;
    for (;;) {
        sum = 0u; cnt = 0u; mine = 0u;
#pragma unroll
        for (unsigned j = 0; j < 16; ++j) { const unsigned c = xb_ld(&bar[XB_XCNT(j)]); sum += c; cnt += (c > 0u) ? 1u : 0u; mine = (j == x) ? c : mine; }
        if (sum == G) break;
        __builtin_amdgcn_s_sleep(1);
        if ((++sp & 255u) == 0u) { if (xb_ld(&bar[XB_TMO])) break; if (sp > XB_SPIN_CAP) { atomicAdd(&bar[XB_TMO], 1u); break; } }
    }
    nloc = mine > 0u ? mine : 1u; nx = cnt > 0u ? cnt : 1u;
}
DEV void xcd_barrier(const XcdBarrier& b) {
    asm volatile("s_waitcnt vmcnt(0)" ::: "memory");
    __syncthreads();
    if (threadIdx.x == 0) {
        unsigned* bar = b.bar;
        __builtin_amdgcn_s_waitcnt(0);
        unsigned nloc = b.st[0], nx = b.st[1];
        if (nloc == 0u) { xcd_barrier_complete(bar, b.x, nloc, nx); b.st[0] = nloc; b.st[1] = nx; }
        const unsigned old = xb_add(&bar[XB_XSUB(b.x)], 1u);
        const unsigned gen = old / nloc;
        if (old + 1u == (gen + 1u) * nloc) {
            __builtin_amdgcn_fence(__ATOMIC_RELEASE, "agent");
            asm volatile("s_waitcnt vmcnt(0)" ::: "memory");
            const unsigned og = xb_add(&bar[XB_TOP], 1u);
            const unsigned tg = og / nx;
            if (og + 1u == (tg + 1u) * nx) xb_add(&bar[XB_TOPGEN], 1u);
            else XB_SPIN(xb_ld(&bar[XB_TOPGEN]) == tg, bar);
            __builtin_amdgcn_fence(__ATOMIC_ACQUIRE, "agent");
            xb_add(&bar[XB_XGEN(b.x)], 1u);
            asm volatile("s_waitcnt vmcnt(0)" ::: "memory");
        } else {
            XB_SPIN(xb_ld(&bar[XB_XGEN(b.x)]) == gen, bar);
            __builtin_amdgcn_fence(__ATOMIC_ACQUIRE, "agent");
            asm volatile("s_waitcnt vmcnt(0)" ::: "memory");
        }
    }
    __syncthreads();
}

constexpr int NPH_LAYER = 10, NPH = 1 + 2 * NPH_LAYER + 1;
__global__ void __launch_bounds__(256, 2) mega(KArgs a) {
    __shared__ __attribute__((aligned(16))) unsigned char lds[65536 + 1024];
    uint4& xb_words = *(uint4*)(lds + 65536 + 768);
    cg::grid_group grid = cg::this_grid();
    const int lo = a.ph_lo, hi = a.ph_hi;
    if (threadIdx.x == 0) xb_words = make_uint4(0u, 0u, 0u, 0u);
    __syncthreads();
    const XcdBarrier xb = xcd_barrier_post((unsigned*)(a.ws + WS_CTL + 65536), (volatile LAS unsigned*)&xb_words);
    if (threadIdx.x == 0) {
        const unsigned hwid = (unsigned)__builtin_amdgcn_s_getreg((31 << 11) | 4), key = xb.x * 256u + ((hwid >> 8) & 0xffu);
        ((volatile unsigned*)&xb_words)[2] = atomicAdd((unsigned*)(a.ws + WS_CTL + 16384) + key, 1u);
    }
    __syncthreads();
    const int cu_role = __builtin_amdgcn_readfirstlane((int)(((volatile unsigned*)&xb_words)[2] & 1u));
#define GEMM_PRIO_ON()  (cu_role ? __builtin_amdgcn_s_setprio(2) : (void)0)
#define GEMM_PRIO_OFF() __builtin_amdgcn_s_setprio(0)
    if (hi < 0) grid.sync();
#define PHASE(k, call) do { const int k_ = (k); if (lo <= k_ && k_ < hi) { call; if (k_ + 1 < hi) xcd_barrier(xb); } } while (0)
    PHASE(0, (ph_prep(a, lds), convert_shared(a, lds)));
#pragma unroll 1
    for (int l = 0; l < 2; ++l) {
        const int base = 1 + l * NPH_LAYER;
        const int nrows = l == 0 ? TA : TL;
        PHASE(base + 0, ph_norm(a, l, 0, l > 0, l - 1, l == 0, TA));
        PHASE(base + 1, (GEMM_PRIO_ON(), ph_inproj(a, l, lds), GEMM_PRIO_OFF()));
        PHASE(base + 2, (blockIdx.x < (gridDim.x >> 1) ? (convert_experts(a, l, lds), __syncthreads(), ph_spatial(a, l, nrows, lds), ph_gla_kv(a, l, lds))
                                                        : (ph_spatial(a, l, nrows, lds), ph_gla_kv(a, l, lds), __syncthreads(), convert_experts(a, l, lds))));
        PHASE(base + 3, ph_gla_scan(a));
        PHASE(base + 4, ph_gla_out(a, l, lds));
        PHASE(base + 5, (GEMM_PRIO_ON(), ph_outproj(a, l, nrows, lds), GEMM_PRIO_OFF()));
        PHASE(base + 6, ph_norm(a, l, 1, false, 0, false, nrows));
        PHASE(base + 7, ph_router(a, l, nrows, lds));
        PHASE(base + 8, (GEMM_PRIO_ON(), ph_moe(a, l, 0, lds), GEMM_PRIO_OFF()));
        PHASE(base + 9, (GEMM_PRIO_ON(), ph_moe(a, l, 1, lds), GEMM_PRIO_OFF()));
    }
    PHASE(NPH - 1, ph_norm(a, 0, 2, true, 1, false, TL));
#undef PHASE
}

extern "C" void kernel_launch(void* const* d_in, const int* in_sizes, int n_in, void* d_out, int out_size, void* d_ws, size_t ws_size, hipStream_t stream) {
    static int grid = 0;
    if (grid == 0) {
        int dev = 0, cus = 0, per_cu = 0;
        hipGetDevice(&dev);
        hipDeviceGetAttribute(&cus, hipDeviceAttributeMultiprocessorCount, dev);
        hipOccupancyMaxActiveBlocksPerMultiprocessor(&per_cu, (const void*)mega, 256, 0);
        if (per_cu < 1) per_cu = 1;
        if (per_cu > 2) per_cu = 2;
        grid = cus * per_cu;
        if (n_in != 25 || ws_size < WS_END) { fprintf(stderr, "kernel_launch: unexpected n_in %d or ws_size %zu (need %zu)\n", n_in, ws_size, (size_t)WS_END); }
    }
    KArgs a{};
    for (int i = 0; i < 25; ++i) a.in[i] = (const float*)d_in[i];
    a.out = (float*)d_out; a.ws = (unsigned char*)d_ws;
    hipMemsetAsync(d_ws, 0, WS_MOD + 2 * 17 * 6144 * 4, stream);
#if ONE_LAUNCH
    a.ph_lo = 0; a.ph_hi = NPH;
    void* args[] = {&a};
    hipError_t e = hipLaunchCooperativeKernel((const void*)mega, dim3(grid), dim3(256), args, 0, stream);
    if (e != hipSuccess) fprintf(stderr, "cooperative launch failed: %s (grid %d)\n", hipGetErrorString(e), grid);
#else
    for (int ph = 0; ph < NPH; ++ph) {
        a.ph_lo = ph; a.ph_hi = ph + 1;
        hipLaunchKernelGGL(mega, dim3(grid), dim3(256), 0, stream, a);
    }
#endif
}
```

```cpp
#include <hip/hip_runtime.h>
#include <hip/hip_cooperative_groups.h>
#include <cstdio>
#include <cstdint>
namespace cg = cooperative_groups;

#ifndef ONE_LAUNCH
#define ONE_LAUNCH 1
#endif

#define DEV __device__ __forceinline__
typedef unsigned short bf16_t;
typedef float f32x4 __attribute__((ext_vector_type(4)));
typedef unsigned u32x2 __attribute__((ext_vector_type(2)));
typedef unsigned u32x4 __attribute__((ext_vector_type(4)));
typedef short bf16x8 __attribute__((ext_vector_type(8)));
typedef float f32x16 __attribute__((ext_vector_type(16)));
typedef long i64x2 __attribute__((ext_vector_type(2)));
typedef int i32x4 __attribute__((ext_vector_type(4)));
typedef int i32x8 __attribute__((ext_vector_type(8)));

constexpr int D = 1024, NB = 16, SEQ = 2048, CTXL = 256;
constexpr int TL = NB * SEQ, TC = NB * CTXL, TA = TL + TC;
constexpr int DIN = 2592, OFF_AU = 0, OFF_AV = 512, OFF_BQ = 1024, OFF_BR = 1280, OFF_BK = 1792, OFF_BV = 2048, OFF_BG = 2560;
constexpr int NE = 64, DE = 512, LCAP = 2 * TA;
constexpr float EPS = 1e-6f;

constexpr size_t MiB = 1u << 20;
constexpr size_t WS_CTL = 0, WS_MOD = 1 * MiB, WS_WRT = 2 * MiB, WS_WSP = 2 * MiB + 512 * 1024, WS_WINT = 3 * MiB, WS_WOUTT = 14 * MiB,
                 WS_W1T = 18 * MiB, WS_W3T = 82 * MiB, WS_W2T = 146 * MiB, WS_H = 210 * MiB, WS_HN = 354 * MiB, WS_Z = 426 * MiB, WS_MIX = 609 * MiB,
                 WS_KV = 681 * MiB, WS_LIST = 825 * MiB, WS_GATE = 843 * MiB, WS_DECAY = 844 * MiB, WS_HN8 = 846 * MiB, WS_END = 884 * MiB;
static_assert(WS_WINT + (size_t)2 * DIN * D * 2 <= WS_WOUTT && WS_WOUTT + (size_t)2 * D * D * 2 <= WS_W1T && WS_W1T + (size_t)NE * DE * D * 2 <= WS_W3T && WS_W2T + (size_t)NE * DE * D * 2 <= WS_H, "ws map (weights)");
static_assert(WS_H + (size_t)TA * D * 4 <= WS_HN && WS_HN + (size_t)TA * D * 2 <= WS_Z && WS_Z + (size_t)TA * DIN * 2 <= WS_MIX &&
              WS_MIX + (size_t)TA * D * 2 <= WS_KV && WS_KV + (size_t)2 * TA * 512 * 4 <= WS_LIST && WS_LIST + (size_t)NE * LCAP * 4 <= WS_GATE, "ws map");

struct KArgs { const float* in[25]; float* out; unsigned char* ws; int ph_lo, ph_hi; };
enum { I_X = 0, I_C, I_CTX, I_CCTX, I_WMOD, I_BMOD, I_GN1, I_WIN, I_LNG, I_LNB, I_WSP, I_BSP, I_WGU, I_BG, I_GGLA, I_WOUT, I_GN2, I_WRG, I_BRG, I_WRE, I_BRE, I_W1, I_W3, I_W2, I_GF };

DEV float bf2f(bf16_t v) { return __uint_as_float((unsigned)v << 16); }
typedef __bf16 bf16x2_t __attribute__((ext_vector_type(2)));
DEV bf16_t f2bf(float f) { return __builtin_bit_cast(bf16_t, (__bf16)f); }
DEV unsigned pk2(float lo, float hi) { bf16x2_t v; v.x = (__bf16)lo; v.y = (__bf16)hi; return __builtin_bit_cast(unsigned, v); }
DEV u32x4 widen_pair(u32x2 a, u32x2 b) {
    auto r0 = __builtin_amdgcn_permlane32_swap(a.x, b.x, false, false); auto r1 = __builtin_amdgcn_permlane32_swap(a.y, b.y, false, false);
    u32x4 o; o.x = r0[0]; o.y = r1[0]; o.z = r0[1]; o.w = r1[1]; return o;
}
constexpr float W8_SCALE = 32.f, W8_INV = 1.f / 32.f, YS_SCALE = 16.f, YS_INV = 1.f / 16.f;
DEV unsigned pk4_fp8(float a, float b, float c, float d) { int w = 0; w = __builtin_amdgcn_cvt_pk_fp8_f32(a, b, w, false); w = __builtin_amdgcn_cvt_pk_fp8_f32(c, d, w, true); return (unsigned)w; }
DEV float silu_f(float x) { return x * __builtin_amdgcn_rcpf(1.f + __expf(-x)); }
DEV float gelu_f(float x) { const float x2 = x * x; const float u2 = x * (1.5957691216057308f + 0.07135481627f * x2); return x * __builtin_amdgcn_rcpf(1.f + __expf(-u2)); }
DEV float logsigmoid_f(float x) { return fminf(x, 0.f) - __logf(1.f + __expf(-fabsf(x))); }
DEV float wave_sum(float v) {
#pragma unroll
    for (int o = 1; o < 64; o <<= 1) v += __shfl_xor(v, o);
    return v;
}
DEV int get_tid() { int t = threadIdx.x; asm volatile("" : "+v"(t)); return t; }
DEV int mod_index(int row) { return row < TL ? (row >> 11) : 16; }

DEV void ph_prep(const KArgs& a, unsigned char* lds) {
    const int tid = get_tid(), lane = tid & 63, wid = tid >> 6;
    float* slab = (float*)lds + wid * 17 * 64;
    float* red = (float*)lds + 4 * 17 * 64;
    float* mod = (float*)(a.ws + WS_MOD);
    const float* c = a.in[I_C]; const float* cctx = a.in[I_CCTX];
    for (int item = blockIdx.x; item < 2 * 96 * 2; item += gridDim.x) {
        const int kh = item & 1, it2 = item >> 1, l = it2 / 96, j0 = (it2 % 96) * 64, j = j0 + lane;
        const float* W = a.in[I_WMOD] + (size_t)l * D * 6144;
        float acc[17];
#pragma unroll
        for (int i = 0; i < 17; ++i) acc[i] = 0.f;
#pragma unroll 1
        for (int ks = 0; ks < 2; ++ks) {
            const int kb = kh * 512 + wid * 128 + ks * 64;
#pragma unroll
            for (int bi = 0; bi < 17; ++bi) { const float x = (bi < 16) ? c[bi * D + kb + lane] : cctx[kb + lane]; slab[bi * 64 + lane] = silu_f(x); }
            __syncthreads();
#pragma unroll 1
            for (int k8 = 0; k8 < 64; k8 += 16) {
                float w[16];
#pragma unroll
                for (int u = 0; u < 16; ++u) w[u] = __builtin_nontemporal_load(W + (size_t)(kb + k8 + u) * 6144 + j);
#pragma unroll
                for (int u = 0; u < 16; ++u)
#pragma unroll
                    for (int bi = 0; bi < 17; ++bi) acc[bi] += slab[bi * 64 + k8 + u] * w[u];
            }
            __syncthreads();
        }
#pragma unroll
        for (int bi = 0; bi < 17; ++bi) red[(wid * 17 + bi) * 64 + lane] = acc[bi];
        __syncthreads();
        for (int idx = tid; idx < 17 * 64; idx += 256) {
            const int bi = idx >> 6, ln = idx & 63;
            const float sv = red[(0 * 17 + bi) * 64 + ln] + red[(1 * 17 + bi) * 64 + ln] + red[(2 * 17 + bi) * 64 + ln] + red[(3 * 17 + bi) * 64 + ln] + (kh == 0 ? a.in[I_BMOD][l * 6144 + j0 + ln] : 0.f);
            atomicAdd(mod + (size_t)(l * 17 + bi) * 6144 + j0 + ln, sv);
        }
        __syncthreads();
    }
}

DEV void ph_norm(const KArgs& a, int layer, int which  , bool combine, int comb_layer, bool from_input, int nrows) {
    const int tid = get_tid(), lane = tid & 63, wid = tid >> 6;
    float* hws = (float*)(a.ws + WS_H);
    bf16_t* hn = (bf16_t*)(a.ws + WS_HN);
    const bf16_t* ys = (const bf16_t*)(a.ws + WS_KV);
    const float* mod = (const float*)(a.ws + WS_MOD);
    const float* g = which == 0 ? a.in[I_GN1] + layer * D : (which == 1 ? a.in[I_GN2] + layer * D : a.in[I_GF]);
    const int nw = gridDim.x * 4;
    for (int r = blockIdx.x * 4 + wid; r < nrows; r += nw) {
        const int bi = mod_index(r);
        const float* src = from_input ? (r < TL ? a.in[I_X] + (size_t)r * D : a.in[I_CTX] + (size_t)(r - TL) * D) : hws + (size_t)r * D;
        f32x4 v[4];
#pragma unroll
        for (int j = 0; j < 4; ++j) v[j] = __builtin_nontemporal_load((const f32x4*)(src + (lane + 64 * j) * 4));
        if (combine) {
            const float* g2 = mod + (size_t)(comb_layer * 17 + bi) * 6144 + 5 * D;
            unsigned y0v[4], y1v[4]; f32x4 ggv[4];
#pragma unroll
            for (int j = 0; j < 4; ++j) { const int k = (lane + 64 * j) * 4; y0v[j] = __builtin_nontemporal_load((const unsigned*)((const unsigned char*)ys + (size_t)(2 * r) * D + k)); y1v[j] = __builtin_nontemporal_load((const unsigned*)((const unsigned char*)ys + (size_t)(2 * r + 1) * D + k)); ggv[j] = *(const f32x4*)(g2 + k); }
#pragma unroll
            for (int j = 0; j < 4; ++j) {
                const int k = (lane + 64 * j) * 4;
                const int y0 = (int)y0v[j], y1 = (int)y1v[j];
                const f32x4 gg = ggv[j] * YS_INV;
                v[j].x += gg.x * (__builtin_amdgcn_cvt_f32_fp8(y0, 0) + __builtin_amdgcn_cvt_f32_fp8(y1, 0));
                v[j].y += gg.y * (__builtin_amdgcn_cvt_f32_fp8(y0, 1) + __builtin_amdgcn_cvt_f32_fp8(y1, 1));
                v[j].z += gg.z * (__builtin_amdgcn_cvt_f32_fp8(y0, 2) + __builtin_amdgcn_cvt_f32_fp8(y1, 2));
                v[j].w += gg.w * (__builtin_amdgcn_cvt_f32_fp8(y0, 3) + __builtin_amdgcn_cvt_f32_fp8(y1, 3));
                if (which != 2) __builtin_nontemporal_store(v[j], (f32x4*)(hws + (size_t)r * D + k));
            }
        }
        float ss = 0.f;
#pragma unroll
        for (int j = 0; j < 4; ++j) ss += v[j].x * v[j].x + v[j].y * v[j].y + v[j].z * v[j].z + v[j].w * v[j].w;
        const float rstd = rsqrtf(wave_sum(ss) * (1.f / D) + EPS);
        if (which == 2) {
            f32x4 gv[4];
#pragma unroll
            for (int j = 0; j < 4; ++j) gv[j] = *(const f32x4*)(g + (lane + 64 * j) * 4);
#pragma unroll
            for (int j = 0; j < 4; ++j) { const int k = (lane + 64 * j) * 4; f32x4 o = v[j] * rstd * gv[j]; __builtin_nontemporal_store(o, (f32x4*)(a.out + (size_t)r * D + k)); }
        } else {
            const float* sh = mod + (size_t)(layer * 17 + bi) * 6144 + (which == 0 ? 0 : 3 * D);
            const float* sc = sh + D;
            f32x4 gv[4], s1v[4], s0v[4];
#pragma unroll
            for (int j = 0; j < 4; ++j) { const int k = (lane + 64 * j) * 4; gv[j] = *(const f32x4*)(g + k); s1v[j] = *(const f32x4*)(sc + k); s0v[j] = *(const f32x4*)(sh + k); }
#pragma unroll
            for (int j = 0; j < 4; ++j) {
                const int k = (lane + 64 * j) * 4;
                const f32x4 gg = gv[j], s1 = s1v[j], s0 = s0v[j];
                const f32x4 o = v[j] * rstd * gg * (1.f + s1) + s0;
                u32x2 w; w.x = pk2(o.x, o.y); w.y = pk2(o.z, o.w);
                *(u32x2*)(hn + (size_t)r * D + k) = w;
                if (which == 1) *(unsigned*)(a.ws + WS_HN8 + (size_t)r * D + k) = pk4_fp8(o.x, o.y, o.z, o.w);
            }
        }
    }
}


DEV void transpose_item(const float* W, int K, int N, bf16_t* WT, float* scr, int kb, int nb, int lane) {
    const int k0 = kb * 64, n0 = nb * 32;
    float wv[32];
#pragma unroll
    for (int i = 0; i < 32; ++i) wv[i] = __builtin_nontemporal_load(W + (size_t)(k0 + 2 * i + (lane >> 5)) * N + n0 + (lane & 31));
#pragma unroll
    for (int i = 0; i < 32; ++i) scr[(2 * i + (lane >> 5)) * 33 + (lane & 31)] = wv[i];
    asm volatile("s_waitcnt lgkmcnt(0)" ::: "memory");
    const int c = lane & 7;
#pragma unroll
    for (int j = 0; j < 4; ++j) {
        const int n = (lane >> 3) + 8 * j; const float* sp = scr + (8 * c) * 33 + n;
        u32x4 o; o.x = pk2(sp[0 * 33], sp[1 * 33]); o.y = pk2(sp[2 * 33], sp[3 * 33]); o.z = pk2(sp[4 * 33], sp[5 * 33]); o.w = pk2(sp[6 * 33], sp[7 * 33]);
        *(u32x4*)(WT + (size_t)(n0 + n) * K + k0 + 8 * c) = o;
    }
    asm volatile("s_waitcnt lgkmcnt(0)" ::: "memory");
}
DEV void transpose_item8(const float* W, int K, int N, unsigned char* WT, float* scr, int kb, int nb, int lane) {
    const int k0 = kb * 64, n0 = nb * 32;
    float wv[32];
#pragma unroll
    for (int i = 0; i < 32; ++i) wv[i] = __builtin_nontemporal_load(W + (size_t)(k0 + 2 * i + (lane >> 5)) * N + n0 + (lane & 31));
#pragma unroll
    for (int i = 0; i < 32; ++i) scr[(2 * i + (lane >> 5)) * 33 + (lane & 31)] = wv[i] * W8_SCALE;
    asm volatile("s_waitcnt lgkmcnt(0)" ::: "memory");
    const int n = lane & 31, kh = (lane >> 5) * 32;
    const float* sp = scr + kh * 33 + n;
    u32x4 o0, o1;
    o0.x = pk4_fp8(sp[0 * 33], sp[1 * 33], sp[2 * 33], sp[3 * 33]); o0.y = pk4_fp8(sp[4 * 33], sp[5 * 33], sp[6 * 33], sp[7 * 33]);
    o0.z = pk4_fp8(sp[8 * 33], sp[9 * 33], sp[10 * 33], sp[11 * 33]); o0.w = pk4_fp8(sp[12 * 33], sp[13 * 33], sp[14 * 33], sp[15 * 33]);
    o1.x = pk4_fp8(sp[16 * 33], sp[17 * 33], sp[18 * 33], sp[19 * 33]); o1.y = pk4_fp8(sp[20 * 33], sp[21 * 33], sp[22 * 33], sp[23 * 33]);
    o1.z = pk4_fp8(sp[24 * 33], sp[25 * 33], sp[26 * 33], sp[27 * 33]); o1.w = pk4_fp8(sp[28 * 33], sp[29 * 33], sp[30 * 33], sp[31 * 33]);
    unsigned char* dp = WT + (size_t)(n0 + n) * K + k0 + kh;
    __builtin_nontemporal_store(o0, (u32x4*)dp); __builtin_nontemporal_store(o1, (u32x4*)(dp + 16));
    asm volatile("s_waitcnt lgkmcnt(0)" ::: "memory");
}
DEV void convert_experts(const KArgs& a, int layer, unsigned char* lds) {
    const int tid = get_tid(), lane = tid & 63, wid = tid >> 6;
    float* scr = (float*)lds + wid * (64 * 33);
    const int gw = blockIdx.x * 4 + wid, ngw = gridDim.x * 4;
    for (int it = gw; it < NE * 3 * 256; it += ngw) {
        const int mat = it >> 8, sub = it & 255, e = mat / 3, which = mat % 3;
        if (which < 2) {
            const float* W = a.in[which == 0 ? I_W1 : I_W3] + ((size_t)layer * NE + e) * D * DE;
            unsigned char* WT = a.ws + (which == 0 ? WS_W1T : WS_W3T) + (size_t)e * DE * D;
            transpose_item8(W, D, DE, WT, scr, sub >> 4, sub & 15, lane);
        } else {
            const float* W = a.in[I_W2] + ((size_t)layer * NE + e) * DE * D;
            unsigned char* WT = a.ws + WS_W2T + (size_t)e * D * DE;
            transpose_item8(W, DE, D, WT, scr, sub >> 5, sub & 31, lane);
        }
    }
}
DEV void convert_shared(const KArgs& a, unsigned char* lds) {
    const int tid = get_tid(), lane = tid & 63, wid = tid >> 6;
    float* scr = (float*)lds + wid * (64 * 33);
    const int gw = blockIdx.x * 4 + wid, ngw = gridDim.x * 4;
    constexpr int I_IN = 16 * 81, I_OUT = 16 * 32;
    for (int it = gw; it < 2 * I_IN + 2 * I_OUT; it += ngw) {
        if (it < 2 * I_IN) { const int l = it / I_IN, sub = it % I_IN; transpose_item(a.in[I_WIN] + (size_t)l * D * DIN, D, DIN, (bf16_t*)(a.ws + WS_WINT) + (size_t)l * DIN * D, scr, sub / 81, sub % 81, lane); }
        else { const int r = it - 2 * I_IN, l = r / I_OUT, sub = r % I_OUT; transpose_item(a.in[I_WOUT] + (size_t)l * D * D, D, D, (bf16_t*)(a.ws + WS_WOUTT) + (size_t)l * D * D, scr, sub >> 5, sub & 31, lane); }
    }
    bf16_t* wrt = (bf16_t*)(a.ws + WS_WRT); bf16_t* wsp = (bf16_t*)(a.ws + WS_WSP);
    const int gt = blockIdx.x * 256 + tid, ngt = gridDim.x * 256;
    for (int i = gt; i < 2 * 128 * D; i += ngt) {
        const int l = i >> 17, n = (i >> 10) & 127, k = i & 1023;
        float v = 0.f;
        if (n < 8) v = a.in[I_WRG][((size_t)l * D + k) * 8 + n]; else if (n < 72) v = a.in[I_WRE][((size_t)l * D + k) * 64 + (n - 8)];
        wrt[i] = f2bf(v);
    }
    for (int i = gt; i < 2 * 4 * 128 * 128; i += ngt) wsp[i] = f2bf(a.in[I_WSP][i]);
}

DEV void glds16(const bf16_t* src, unsigned char* dst) { __builtin_amdgcn_global_load_lds((const unsigned*)src, (__attribute__((address_space(3))) unsigned*)dst, 16, 0, 0); }
template <class ARow, class BRow>
DEV void gemm_core(unsigned char* lds, int nk, ARow arow, BRow brow, f32x16 (&acc)[2][2]) {
    const int tid = get_tid(), lane = tid & 63, wid = tid >> 6, wr = wid >> 1, wc = wid & 1;
    const int srow = tid >> 3, sch = (tid & 7) ^ ((tid >> 4) & 7);
    const bf16_t* ap[4]; const bf16_t* bp[4];
#pragma unroll
    for (int i = 0; i < 4; ++i) { ap[i] = arow(i * 32 + srow) + sch * 8; bp[i] = brow(i * 32 + srow) + sch * 8; }
#pragma unroll
    for (int mi = 0; mi < 2; ++mi)
#pragma unroll
        for (int ni = 0; ni < 2; ++ni)
#pragma unroll
            for (int r = 0; r < 16; ++r) acc[mi][ni][r] = 0.f;
    unsigned char* dst = lds + __builtin_amdgcn_readfirstlane(tid & ~63) * 16;
    const int fr = lane & 31, fh = lane >> 5, g = (fr >> 1) & 7;
    const unsigned char* ra = lds + (wr * 64 + fr) * 128;
    const unsigned char* rb = lds + 16384 + (wc * 64 + fr) * 128;
#pragma unroll
    for (int i = 0; i < 4; ++i) { glds16(ap[i], dst + i * 4096); glds16(bp[i], dst + 16384 + i * 4096); }
    if (nk > 1) {
#pragma unroll
        for (int i = 0; i < 4; ++i) { glds16(ap[i] + 64, dst + 32768 + i * 4096); glds16(bp[i] + 64, dst + 32768 + 16384 + i * 4096); }
    }
    for (int kt = 0; kt < nk; ++kt) {
        const int cur = (kt & 1) * 32768;
        if (kt + 1 < nk) asm volatile("s_waitcnt vmcnt(8)" ::: "memory"); else asm volatile("s_waitcnt vmcnt(0)" ::: "memory");
        __builtin_amdgcn_s_barrier();
        asm volatile("" ::: "memory");
        bf16x8 af[4][2], bfr[4][2];
#pragma unroll
        for (int ks = 0; ks < 4; ++ks) {
            const int co = ((ks * 2 + fh) ^ g) << 4;
#pragma unroll
            for (int mi = 0; mi < 2; ++mi) af[ks][mi] = *(const bf16x8*)(ra + cur + mi * 4096 + co);
#pragma unroll
            for (int ni = 0; ni < 2; ++ni) bfr[ks][ni] = *(const bf16x8*)(rb + cur + ni * 4096 + co);
        }
        asm volatile("s_waitcnt lgkmcnt(0)" ::: "memory");
        __builtin_amdgcn_s_barrier();
        asm volatile("" ::: "memory");
        if (kt + 2 < nk) {
            const int ko = (kt + 2) * 64;
#pragma unroll
            for (int i = 0; i < 4; ++i) { glds16(ap[i] + ko, dst + cur + i * 4096); glds16(bp[i] + ko, dst + cur + 16384 + i * 4096); }
        }
#pragma unroll
        for (int ks = 0; ks < 4; ++ks)
#pragma unroll
            for (int mi = 0; mi < 2; ++mi)
#pragma unroll
                for (int ni = 0; ni < 2; ++ni) acc[mi][ni] = __builtin_amdgcn_mfma_f32_32x32x16_bf16(af[ks][mi], bfr[ks][ni], acc[mi][ni], 0, 0, 0);
    }
    __builtin_amdgcn_s_barrier();
    asm volatile("" ::: "memory");
}
template <bool FP8 = false, class Prep, class ARow, class BRow, class Epi>
DEV void gemm_stream(unsigned char* lds, int nk, int t0, int tstep, int tend, Prep prep, ARow arow, BRow brow, Epi epi) {
    const int tid = get_tid(), lane = tid & 63, wid = tid >> 6, wr = wid >> 1, wc = wid & 1;
    const int srow = tid >> 3, sch = (tid & 7) ^ ((tid >> 4) & 7);
    if (t0 >= tend) return;
    auto cx = prep(t0);
    auto nx = cx;
    const bf16_t* ap[4]; const bf16_t* bp[4];
#pragma unroll
    for (int i = 0; i < 4; ++i) { ap[i] = arow(cx, i * 32 + srow) + sch * 8; bp[i] = brow(cx, i * 32 + srow) + sch * 8; }
    unsigned char* dst = lds + __builtin_amdgcn_readfirstlane(tid & ~63) * 16;
    const int fr = lane & 31, fh = lane >> 5, g = (fr >> 1) & 7;
    const unsigned char* ra = lds + (wr * 64 + fr) * 128;
    const unsigned char* rb = lds + 16384 + (wc * 64 + fr) * 128;
#pragma unroll
    for (int i = 0; i < 4; ++i) { glds16(ap[i], dst + i * 4096); glds16(bp[i], dst + 16384 + i * 4096); }
#pragma unroll
    for (int i = 0; i < 4; ++i) { glds16(ap[i] + 64, dst + 32768 + i * 4096); glds16(bp[i] + 64, dst + 32768 + 16384 + i * 4096); }
    for (int t = t0; t < tend; t += tstep) {
        const bool has_next = t + tstep < tend;
        f32x16 acc[2][2];
#pragma unroll
        for (int mi = 0; mi < 2; ++mi)
#pragma unroll
            for (int ni = 0; ni < 2; ++ni)
#pragma unroll
                for (int r = 0; r < 16; ++r) acc[mi][ni][r] = 0.f;
        for (int kt = 0; kt < nk; ++kt) {
            const int cur = (kt & 1) * 32768;
            if (kt + 1 < nk || has_next) asm volatile("s_waitcnt vmcnt(8)" ::: "memory"); else asm volatile("s_waitcnt vmcnt(0)" ::: "memory");
            __builtin_amdgcn_s_barrier();
            asm volatile("" ::: "memory");
            bf16x8 af[4][2], bfr[4][2];
            i32x8 a8[2][2], b8[2][2];
            if (!FP8) {
#pragma unroll
            for (int ks = 0; ks < 4; ++ks) {
                const int co = ((ks * 2 + fh) ^ g) << 4;
#pragma unroll
                for (int mi = 0; mi < 2; ++mi) af[ks][mi] = *(const bf16x8*)(ra + cur + mi * 4096 + co);
#pragma unroll
                for (int ni = 0; ni < 2; ++ni) bfr[ks][ni] = *(const bf16x8*)(rb + cur + ni * 4096 + co);
            }
            } else {
#pragma unroll
            for (int m = 0; m < 2; ++m) {
                const int c0 = ((m * 4 + fh) ^ g) << 4, c1 = ((m * 4 + 2 + fh) ^ g) << 4;
#pragma unroll
                for (int mi = 0; mi < 2; ++mi) { a8[m][mi].lo = *(const i32x4*)(ra + cur + mi * 4096 + c0); a8[m][mi].hi = *(const i32x4*)(ra + cur + mi * 4096 + c1); }
#pragma unroll
                for (int ni = 0; ni < 2; ++ni) { b8[m][ni].lo = *(const i32x4*)(rb + cur + ni * 4096 + c0); b8[m][ni].hi = *(const i32x4*)(rb + cur + ni * 4096 + c1); }
            }
            }
            asm volatile("s_waitcnt lgkmcnt(0)" ::: "memory");
            __builtin_amdgcn_sched_barrier(0);
            __builtin_amdgcn_s_barrier();
            asm volatile("" ::: "memory");
            __builtin_amdgcn_sched_barrier(0);
            int ko = -1;
            if (kt + 2 < nk) ko = (kt + 2) * 64;
            else if (has_next) {
                if (kt + 2 == nk) {
                    nx = prep(t + tstep);
#pragma unroll
                    for (int i = 0; i < 4; ++i) { ap[i] = arow(nx, i * 32 + srow) + sch * 8; bp[i] = brow(nx, i * 32 + srow) + sch * 8; }
                }
                ko = (kt + 2 - nk) * 64;
            }
            if (FP8) {
#pragma unroll
                for (int ks = 0; ks < 8; ++ks) {
                    if (ko >= 0) { if (ks & 1) glds16(bp[ks >> 1] + ko, dst + cur + 16384 + (ks >> 1) * 4096); else glds16(ap[ks >> 1] + ko, dst + cur + (ks >> 1) * 4096); }
                    const int m = ks >> 2, mi = (ks >> 1) & 1, ni = ks & 1;
                    acc[mi][ni] = __builtin_amdgcn_mfma_scale_f32_32x32x64_f8f6f4(a8[m][mi], b8[m][ni], acc[mi][ni], 0, 0, 0, 0x7f7f7f7f, 0, 0x7f7f7f7f);
                    __builtin_amdgcn_sched_barrier(0);
                }
                asm volatile("" : "+v"(acc[0][0]), "+v"(acc[0][1]), "+v"(acc[1][0]), "+v"(acc[1][1]));
            } else
#pragma unroll
            for (int ks = 0; ks < 4; ++ks) {
                if (ko >= 0) { glds16(ap[ks] + ko, dst + cur + ks * 4096); }
                acc[0][0] = __builtin_amdgcn_mfma_f32_32x32x16_bf16(af[ks][0], bfr[ks][0], acc[0][0], 0, 0, 0);
                acc[0][1] = __builtin_amdgcn_mfma_f32_32x32x16_bf16(af[ks][0], bfr[ks][1], acc[0][1], 0, 0, 0);
                __builtin_amdgcn_sched_barrier(0);
                if (ko >= 0) { glds16(bp[ks] + ko, dst + cur + 16384 + ks * 4096); }
                acc[1][0] = __builtin_amdgcn_mfma_f32_32x32x16_bf16(af[ks][1], bfr[ks][0], acc[1][0], 0, 0, 0);
                acc[1][1] = __builtin_amdgcn_mfma_f32_32x32x16_bf16(af[ks][1], bfr[ks][1], acc[1][1], 0, 0, 0);
                __builtin_amdgcn_sched_barrier(0);
            }
        }
        epi(cx, acc);
        cx = nx;
    }
    __builtin_amdgcn_s_barrier();
    asm volatile("" ::: "memory");
}
DEV int vblock() { const int G = gridDim.x, bx = blockIdx.x; return (G % 8 == 0) ? (bx % 8) * (G / 8) + bx / 8 : bx; }
#define ACC_FOREACH(mi, ni, r, row, col) \
    _Pragma("unroll") for (int mi = 0; mi < 2; ++mi) _Pragma("unroll") for (int ni = 0; ni < 2; ++ni) _Pragma("unroll") for (int r = 0; r < 16; ++r) \
        for (int row = (tid >> 7) * 64 + mi * 32 + (r & 3) + 8 * (r >> 2) + 4 * ((tid & 63) >> 5), col = ((tid >> 6) & 1) * 64 + ni * 32 + (tid & 31), once_ = 1; once_; once_ = 0)

template <class ARow, class Epi>
DEV void gemm_naive_tile(float* lds, int K, ARow arow, const float* W, int ldw, int col0, int ncols, Epi epi) {
    const int tid = get_tid(), ty = tid >> 4, tx = tid & 15;
    float* sA = lds;
    float* sB = lds + 16 * 68;
    const int ar = tid >> 2, kq = (tid & 3) * 4;
    const bf16_t* ap = arow(ar);
    const int kr = tid >> 4, c4 = (tid & 15) * 4;
    const bool cok = (col0 + c4) < ncols;
    float acc[4][4];
#pragma unroll
    for (int i = 0; i < 4; ++i)
#pragma unroll
        for (int j = 0; j < 4; ++j) acc[i][j] = 0.f;
    for (int k0 = 0; k0 < K; k0 += 16) {
        const u32x2 av = *(const u32x2*)(ap + k0 + kq);
        f32x4 wv = {0.f, 0.f, 0.f, 0.f};
        if (cok) wv = *(const f32x4*)(W + (size_t)(k0 + kr) * ldw + col0 + c4);
        sA[(kq + 0) * 68 + ar] = __uint_as_float(av.x << 16);
        sA[(kq + 1) * 68 + ar] = __uint_as_float(av.x & 0xffff0000u);
        sA[(kq + 2) * 68 + ar] = __uint_as_float(av.y << 16);
        sA[(kq + 3) * 68 + ar] = __uint_as_float(av.y & 0xffff0000u);
        *(f32x4*)(sB + kr * 64 + c4) = wv;
        __syncthreads();
#pragma unroll 4
        for (int k = 0; k < 16; ++k) {
            const f32x4 a4 = *(const f32x4*)(sA + k * 68 + ty * 4), b4 = *(const f32x4*)(sB + k * 64 + tx * 4);
            const float aa[4] = {a4.x, a4.y, a4.z, a4.w}, bb[4] = {b4.x, b4.y, b4.z, b4.w};
#pragma unroll
            for (int i = 0; i < 4; ++i)
#pragma unroll
                for (int j = 0; j < 4; ++j) acc[i][j] += aa[i] * bb[j];
        }
        __syncthreads();
    }
#pragma unroll
    for (int i = 0; i < 4; ++i)
#pragma unroll
        for (int j = 0; j < 4; ++j) { const int col = col0 + tx * 4 + j; if (col < ncols) epi(ty * 4 + i, col, acc[i][j]); }
}

DEV void ph_inproj(const KArgs& a, int layer, unsigned char* lds) {
    const int tid = get_tid();
    const bf16_t* hn = (const bf16_t*)(a.ws + WS_HN);
    bf16_t* z = (bf16_t*)(a.ws + WS_Z);
    const bf16_t* WT = (const bf16_t*)(a.ws + WS_WINT) + (size_t)layer * DIN * D;
    constexpr int ntn = (DIN + 127) / 128, nlat = (TL / 128) * ntn, ncn = ntn - OFF_BK / 128;
    const int ntiles = layer == 0 ? (TA / 128) * ntn : nlat + (TC / 128) * ncn;
    struct Cx { int row0, col0; };
    auto prep = [&](int t) { Cx c;
        if (layer == 0 || t < nlat) { c.row0 = (t / ntn) * 128; c.col0 = (t % ntn) * 128; }
        else { const int u = t - nlat; c.row0 = TL + (u / ncn) * 128; c.col0 = OFF_BK + (u % ncn) * 128; }
        return c; };
    gemm_stream(lds, D / 64, vblock(), gridDim.x, ntiles, prep,
        [&](const Cx& c, int r) { int n = c.col0 + r; n = n < DIN ? n : DIN - 1; return WT + (size_t)n * D; },
        [&](const Cx& c, int r) { return hn + (size_t)(c.row0 + r) * D; },
        [&](const Cx& c, const f32x16 (&acc)[2][2]) {
            const int row0 = c.row0, col0 = c.col0;
            const int wr = tid >> 7, wc = (tid >> 6) & 1, lane = tid & 63;
#pragma unroll
            for (int ni = 0; ni < 2; ++ni) {
                bf16_t* zr = z + (size_t)(row0 + wc * 64 + ni * 32 + (lane & 31)) * DIN + col0;
#pragma unroll
                for (int mi = 0; mi < 2; ++mi)
#pragma unroll
                    for (int kp = 0; kp < 2; ++kp) {
                        u32x2 wa, wb;
                        wa.x = pk2(acc[mi][ni][8 * kp], acc[mi][ni][8 * kp + 1]); wa.y = pk2(acc[mi][ni][8 * kp + 2], acc[mi][ni][8 * kp + 3]);
                        wb.x = pk2(acc[mi][ni][8 * kp + 4], acc[mi][ni][8 * kp + 5]); wb.y = pk2(acc[mi][ni][8 * kp + 6], acc[mi][ni][8 * kp + 7]);
                        const u32x4 w = widen_pair(wa, wb);
                        const int n = wr * 64 + mi * 32 + 16 * kp + 8 * (lane >> 5);
                        if (col0 + n < DIN) *(u32x4*)(zr + n) = w;
                    }
            }
        });
}

DEV void ph_outproj(const KArgs& a, int layer, int nrows, unsigned char* lds) {
    const int tid = get_tid();
    const bf16_t* mix = (const bf16_t*)(a.ws + WS_MIX);
    float* hws = (float*)(a.ws + WS_H);
    const float* mod = (const float*)(a.ws + WS_MOD);
    const bf16_t* WT = (const bf16_t*)(a.ws + WS_WOUTT) + (size_t)layer * D * D;
    constexpr int ntn = D / 128;
    gemm_stream(lds, D / 64, vblock(), gridDim.x, (nrows / 128) * ntn, [](int t) { return t; },
        [&](int t, int r) { return mix + (size_t)((t / ntn) * 128 + r) * D; },
        [&](int t, int r) { return WT + (size_t)((t % ntn) * 128 + r) * D; },
        [&](int t, const f32x16 (&acc)[2][2]) {
            const int row0 = (t / ntn) * 128, col0 = (t % ntn) * 128;
            const int bi = mod_index(row0);
            const float* g1 = mod + (size_t)(layer * 17 + bi) * 6144 + 2 * D + col0;
            const int wr = tid >> 7, wc = (tid >> 6) & 1, lane = tid & 63;
            const float g1a = g1[wc * 64 + (lane & 31)], g1b = g1[wc * 64 + 32 + (lane & 31)];
            const float* resb = (layer == 0 ? (row0 < TL ? a.in[I_X] + (size_t)row0 * D : a.in[I_CTX] + (size_t)(row0 - TL) * D) : hws + (size_t)row0 * D) + col0 + wc * 64 + (lane & 31);
            float* outb = hws + (size_t)row0 * D + col0 + wc * 64 + (lane & 31);
            float resc[8], resn[8];
#define OP_RO(b) ((size_t)(wr * 64 + ((b) >> 2) * 32 + 16 * ((b) & 1) + 4 * (lane >> 5)) * D + (((b) >> 1) & 1) * 32)
#pragma unroll
            for (int r = 0; r < 8; ++r) resc[r] = __builtin_nontemporal_load(resb + OP_RO(0) + (size_t)((r & 3) + 8 * (r >> 2)) * D);
#pragma unroll
            for (int b = 0; b < 8; ++b) {
                const int mi = b >> 2, ni = (b >> 1) & 1, hq = b & 1;
                if (b + 1 < 8) {
#pragma unroll
                    for (int r = 0; r < 8; ++r) resn[r] = __builtin_nontemporal_load(resb + OP_RO(b + 1) + (size_t)((r & 3) + 8 * (r >> 2)) * D);
                }
                asm volatile("" ::: "memory");
#pragma unroll
                for (int r = 0; r < 8; ++r) outb[OP_RO(b) + (size_t)((r & 3) + 8 * (r >> 2)) * D] = resc[r] + (ni ? g1b : g1a) * acc[mi][ni][8 * hq + r];
                asm volatile("" ::: "memory");
#pragma unroll
                for (int r = 0; r < 8; ++r) resc[r] = resn[r];
            }
#undef OP_RO
        });
}

DEV bf16x8 tr_frag_at(unsigned base, int RS, int c, int ks, int lane);
DEV void unpack8(const u32x4 v, float* f);
DEV void ph_spatial(const KArgs& a, int layer, int nrows, unsigned char* lds) {
    const int tid = get_tid(), lane = tid & 63, wid = tid >> 6, wr = wid >> 1, wc = wid & 1, fr = lane & 31, fh = lane >> 5;
    const bf16_t* z = (const bf16_t*)(a.ws + WS_Z);
    bf16_t* mix = (bf16_t*)(a.ws + WS_MIX);
    unsigned char* vs = lds;
    const unsigned vs_a = (unsigned)(size_t)vs;
    const int nitems = (nrows / 128) * 4;
    for (int item = vblock(); item < nitems; item += gridDim.x) {
        const int ci = item >> 2, g = item & 3, row0 = ci * 128;
        const int l8 = tid & 7, tk = tid >> 3;
        float lgv[16], lbv[16];
#pragma unroll
        for (int j = 0; j < 4; ++j) {
            const f32x4 g4 = *(const f32x4*)(a.in[I_LNG] + layer * 512 + g * 128 + l8 * 16 + 4 * j), b4 = *(const f32x4*)(a.in[I_LNB] + layer * 512 + g * 128 + l8 * 16 + 4 * j);
            lgv[4 * j] = g4.x; lgv[4 * j + 1] = g4.y; lgv[4 * j + 2] = g4.z; lgv[4 * j + 3] = g4.w; lbv[4 * j] = b4.x; lbv[4 * j + 1] = b4.y; lbv[4 * j + 2] = b4.z; lbv[4 * j + 3] = b4.w;
        }
#pragma unroll 2
        for (int pass = 0; pass < 4; ++pass) {
            const int tok = pass * 32 + tk;
            const bf16_t* zp = z + (size_t)(row0 + tok) * DIN + OFF_AV + g * 128 + l8 * 16;
            float x[16];
            unpack8(*(const u32x4*)zp, x); unpack8(*(const u32x4*)(zp + 8), x + 8);
            float sm = 0.f;
#pragma unroll
            for (int j = 0; j < 16; ++j) { x[j] = gelu_f(x[j]); sm += x[j]; }
            sm += __shfl_xor(sm, 1); sm += __shfl_xor(sm, 2); sm += __shfl_xor(sm, 4);
            const float mu = sm * (1.f / 128.f);
            float q = 0.f;
#pragma unroll
            for (int j = 0; j < 16; ++j) { x[j] -= mu; q += x[j] * x[j]; }
            q += __shfl_xor(q, 1); q += __shfl_xor(q, 2); q += __shfl_xor(q, 4);
            const float rs = rsqrtf(q * (1.f / 128.f) + EPS);
            u32x4 w0, w1;
            w0.x = pk2(x[0] * rs * lgv[0] + lbv[0], x[1] * rs * lgv[1] + lbv[1]); w0.y = pk2(x[2] * rs * lgv[2] + lbv[2], x[3] * rs * lgv[3] + lbv[3]);
            w0.z = pk2(x[4] * rs * lgv[4] + lbv[4], x[5] * rs * lgv[5] + lbv[5]); w0.w = pk2(x[6] * rs * lgv[6] + lbv[6], x[7] * rs * lgv[7] + lbv[7]);
            w1.x = pk2(x[8] * rs * lgv[8] + lbv[8], x[9] * rs * lgv[9] + lbv[9]); w1.y = pk2(x[10] * rs * lgv[10] + lbv[10], x[11] * rs * lgv[11] + lbv[11]);
            w1.z = pk2(x[12] * rs * lgv[12] + lbv[12], x[13] * rs * lgv[13] + lbv[13]); w1.w = pk2(x[14] * rs * lgv[14] + lbv[14], x[15] * rs * lgv[15] + lbv[15]);
            *(u32x4*)(vs + tok * 320 + l8 * 32) = w0; *(u32x4*)(vs + tok * 320 + l8 * 32 + 16) = w1;
        }
        __syncthreads();
        const bf16_t* wsp = (const bf16_t*)(a.ws + WS_WSP) + (size_t)(layer * 4 + g) * 128 * 128;
        f32x16 acc[2][2];
#pragma unroll
        for (int mi = 0; mi < 2; ++mi)
#pragma unroll
            for (int ni = 0; ni < 2; ++ni)
#pragma unroll
                for (int r = 0; r < 16; ++r) acc[mi][ni][r] = 0.f;
#pragma unroll 2
        for (int ks = 0; ks < 8; ++ks) {
            bf16x8 af[2], bfr[2];
#pragma unroll
            for (int mi = 0; mi < 2; ++mi) af[mi] = *(const bf16x8*)(wsp + (wr * 64 + mi * 32 + fr) * 128 + ks * 16 + fh * 8);
#pragma unroll
            for (int ni = 0; ni < 2; ++ni) bfr[ni] = tr_frag_at(vs_a, 320, wc * 2 + ni, ks, lane);
#pragma unroll
            for (int mi = 0; mi < 2; ++mi)
#pragma unroll
                for (int ni = 0; ni < 2; ++ni) acc[mi][ni] = __builtin_amdgcn_mfma_f32_32x32x16_bf16(af[mi], bfr[ni], acc[mi][ni], 0, 0, 0);
        }
        __syncthreads();
        ACC_FOREACH(mi, ni, r, row, col) { *(bf16_t*)(vs + row * 272 + col * 2) = f2bf(acc[mi][ni][r]); }
        __syncthreads();
        {
            const int p = tid >> 1, c0 = (tid & 1) * 64;
            const float bs = a.in[I_BSP][(layer * 4 + g) * 128 + p];
            const bf16_t* zu = z + (size_t)(row0 + p) * DIN + OFF_AU + g * 128 + c0;
            bf16_t* mo = mix + (size_t)(row0 + p) * D + g * 128 + c0;
            u32x4 zuv[8];
#pragma unroll
            for (int j = 0; j < 8; ++j) zuv[j] = *(const u32x4*)(zu + 8 * j);
#pragma unroll 2
            for (int j = 0; j < 8; ++j) {
                float uf[8], sf[8];
                unpack8(zuv[j], uf); unpack8(*(const u32x4*)(vs + p * 272 + (c0 + 8 * j) * 2), sf);
                u32x4 w;
                w.x = pk2(gelu_f(uf[0]) * (sf[0] + bs), gelu_f(uf[1]) * (sf[1] + bs)); w.y = pk2(gelu_f(uf[2]) * (sf[2] + bs), gelu_f(uf[3]) * (sf[3] + bs));
                w.z = pk2(gelu_f(uf[4]) * (sf[4] + bs), gelu_f(uf[5]) * (sf[5] + bs)); w.w = pk2(gelu_f(uf[6]) * (sf[6] + bs), gelu_f(uf[7]) * (sf[7] + bs));
                *(u32x4*)(mo + 8 * j) = w;
            }
        }
        __syncthreads();
    }
}

constexpr int GLA_LA_STRIDE = 65, GLA_VT_RS = 320, GLA_KD_RS = 192, GLA_QK_RS = 144;
constexpr int GLA_OFF_LA = 0, GLA_OFF_QE = 16896, GLA_OFF_KE = 16896 + 9216, GLA_OFF_VT = 16896 + 2 * 9216, GLA_OFF_WU = GLA_OFF_VT + 64 * GLA_VT_RS, GLA_OFF_TOT = GLA_OFF_WU + 2 * 4352, GLA_OFF_END = GLA_OFF_TOT + 1280;
static_assert(64 * GLA_LA_STRIDE * 4 <= GLA_OFF_QE && GLA_OFF_END <= 65536 + 768 && 64 * 132 * 4 <= GLA_OFF_VT && 64 * GLA_KD_RS <= 2 * 9216, "GLA LDS map");
DEV void gla_chunk_coords(int ci, int& row0, int& b, int& slot) {
    if (ci < 512) { row0 = ci * 64; b = ci >> 5; slot = 4 + (ci & 31); } else { const int c = ci - 512; row0 = TL + c * 64; b = c >> 2; slot = c & 3; }
}
DEV bf16x8 tr_frag(unsigned a0, unsigned a1) {
    u32x2 lo, hi;
    asm volatile("ds_read_b64_tr_b16 %0, %2\n\tds_read_b64_tr_b16 %1, %3\n\ts_waitcnt lgkmcnt(0)" : "=&v"(lo), "=&v"(hi) : "v"(a0), "v"(a1) : "memory");
    u32x4 w; w.x = lo.x; w.y = lo.y; w.z = hi.x; w.w = hi.y;
    return __builtin_bit_cast(bf16x8, w);
}
DEV bf16x8 tr_frag_at(unsigned base, int RS, int c, int ks, int lane) {
    const int h = lane >> 5, blk = (lane >> 4) & 1, q = (lane & 15) >> 2, p = lane & 3;
    const unsigned a0 = base + (unsigned)((16 * ks + 8 * h + q) * RS + (32 * c + 16 * blk + 4 * p) * 2);
    return tr_frag(a0, a0 + 4u * (unsigned)RS);
}
DEV void unpack8(const u32x4 v, float* f) {
    f[0] = __uint_as_float(v.x << 16); f[1] = __uint_as_float(v.x & 0xffff0000u); f[2] = __uint_as_float(v.y << 16); f[3] = __uint_as_float(v.y & 0xffff0000u);
    f[4] = __uint_as_float(v.z << 16); f[5] = __uint_as_float(v.z & 0xffff0000u); f[6] = __uint_as_float(v.w << 16); f[7] = __uint_as_float(v.w & 0xffff0000u);
}
DEV void gla_stage_gate(const KArgs& a, int layer, int dir, int h, float* swu, int tid) {
    bf16_t* hi = (bf16_t*)swu; bf16_t* lo = hi + 1024; float* bias = swu + 1024;
    for (int i = tid; i < 16 * 64; i += 256) {
        const int k = i >> 6, d = i & 63;
        const float w = a.in[I_WGU][((size_t)(layer * 2 + dir) * 16 + k) * 256 + h * 64 + d];
        const bf16_t wh = f2bf(w);
        hi[d * 16 + k] = wh; lo[d * 16 + k] = f2bf(w - bf2f(wh));
    }
    if (tid < 64) bias[tid] = a.in[I_BG][(layer * 2 + dir) * 256 + h * 64 + tid];
}
DEV void gla_logdecay(const bf16x8 zfrag, const float* swu, float* la, int tid) {
    const int lane = tid & 63, wid = tid >> 6, fr = lane & 31, fh = lane >> 5, dt = (wid & 1) * 32, tt = (wid >> 1) * 32;
    const bf16_t* hi = (const bf16_t*)swu; const bf16_t* lo = hi + 1024; const float* bias = swu + 1024;
    const bf16x8 bh = *(const bf16x8*)(hi + (dt + fr) * 16 + fh * 8), bl = *(const bf16x8*)(lo + (dt + fr) * 16 + fh * 8);
    f32x16 acc;
#pragma unroll
    for (int r = 0; r < 16; ++r) acc[r] = 0.f;
    acc = __builtin_amdgcn_mfma_f32_32x32x16_bf16(zfrag, bl, acc, 0, 0, 0);
    acc = __builtin_amdgcn_mfma_f32_32x32x16_bf16(zfrag, bh, acc, 0, 0, 0);
    const float bb = bias[dt + fr];
#pragma unroll
    for (int r = 0; r < 16; ++r) la[(tt + (r & 3) + 8 * (r >> 2) + 4 * fh) * GLA_LA_STRIDE + dt + fr] = logsigmoid_f(acc[r] + bb) * (1.f / 16.f);
}
DEV void gla_cumsum(float* la, float* tot, int dir, int tid) {
    const int d = tid & 63, sg = tid >> 6;
    float v[16];
#pragma unroll
    for (int t = 0; t < 16; ++t) v[t] = la[(sg * 16 + t) * GLA_LA_STRIDE + d];
    if (dir == 0) {
#pragma unroll
        for (int t = 1; t < 16; ++t) v[t] += v[t - 1];
        tot[sg * 64 + d] = v[15];
    } else {
#pragma unroll
        for (int t = 14; t >= 0; --t) v[t] += v[t + 1];
        tot[sg * 64 + d] = v[0];
    }
    __syncthreads();
    const float t0 = tot[d], t1 = tot[64 + d], t2 = tot[128 + d], t3 = tot[192 + d];
    float off;
    if (dir == 0) off = (sg > 0 ? t0 : 0.f) + (sg > 1 ? t1 : 0.f) + (sg > 2 ? t2 : 0.f);
    else off = (sg < 3 ? t3 : 0.f) + (sg < 2 ? t2 : 0.f) + (sg < 1 ? t1 : 0.f);
    if (sg == 0) tot[256 + d] = (t0 + t1) + (t2 + t3);
#pragma unroll
    for (int t = 0; t < 16; ++t) la[(sg * 16 + t) * GLA_LA_STRIDE + d] = v[t] + off;
    __syncthreads();
}
DEV void gla_store_v(const u32x4 (&vr)[4], unsigned char* vt, int tid) {
    const int i = tid >> 2, e0 = (tid & 3) * 32;
#pragma unroll
    for (int j = 0; j < 4; ++j) *(u32x4*)(vt + i * GLA_VT_RS + (e0 + 8 * j) * 2) = vr[j];
}

DEV void ph_gla_kv(const KArgs& a, int layer, unsigned char* lds) {
    const int tid = get_tid(), lane = tid & 63, wid = tid >> 6;
    const bf16_t* z = (const bf16_t*)(a.ws + WS_Z);
    bf16_t* kvo = (bf16_t*)(a.ws + WS_KV);
    float* dco = (float*)(a.ws + WS_DECAY);
    float* la = (float*)(lds + GLA_OFF_LA); unsigned char* kdt = lds + GLA_OFF_QE; unsigned char* vt = lds + GLA_OFF_VT;
    float* swu = (float*)(lds + GLA_OFF_WU); float* tot = (float*)(lds + GLA_OFF_TOT);
    const unsigned vt_a = (unsigned)(size_t)vt, kd_a = (unsigned)(size_t)kdt;
    const int vb = vblock(), h = vb & 3;
    gla_stage_gate(a, layer, 0, h, swu, tid); gla_stage_gate(a, layer, 1, h, swu + 1088, tid);
    __syncthreads();
    const int i = tid >> 2, d0 = (tid & 3) * 16, e0 = (tid & 3) * 32;
    for (int item = vb; item < 576 * 4; item += gridDim.x) {
        const int ci = item >> 2;
        int row0, b, slot; gla_chunk_coords(ci, row0, b, slot);
        const bf16_t* zr = z + (size_t)(row0 + i) * DIN;
        const bf16_t* zgp = z + (size_t)(row0 + (wid >> 1) * 32 + (lane & 31)) * DIN + OFF_BG + (lane >> 5) * 8;
        const bf16x8 zf0 = *(const bf16x8*)zgp, zf1 = *(const bf16x8*)(zgp + 16);
        const u32x4 kr0 = *(const u32x4*)(zr + OFF_BK + h * 64 + d0), kr1 = *(const u32x4*)(zr + OFF_BK + h * 64 + d0 + 8);
        u32x4 vr[4];
#pragma unroll
        for (int j = 0; j < 4; ++j) vr[j] = *(const u32x4*)(zr + OFF_BV + h * 128 + e0 + 8 * j);
        gla_store_v(vr, vt, tid);
#pragma unroll 1
        for (int dir = 0; dir < 2; ++dir) {
            gla_logdecay(dir ? zf1 : zf0, swu + dir * 1088, la, tid);
            __syncthreads();
            gla_cumsum(la, tot, dir, tid);
            const size_t tile = (size_t)(((dir * NB + b) * 4 + h) * 36 + slot);
            {
                float kf[16];
                unpack8(kr0, kf); unpack8(kr1, kf + 8);
#pragma unroll
                for (int dd = 0; dd < 16; ++dd) kf[dd] *= __expf(tot[256 + d0 + dd] - la[i * GLA_LA_STRIDE + d0 + dd]);
                u32x4 w0, w1;
                w0.x = pk2(kf[0], kf[1]); w0.y = pk2(kf[2], kf[3]); w0.z = pk2(kf[4], kf[5]); w0.w = pk2(kf[6], kf[7]);
                w1.x = pk2(kf[8], kf[9]); w1.y = pk2(kf[10], kf[11]); w1.z = pk2(kf[12], kf[13]); w1.w = pk2(kf[14], kf[15]);
                *(u32x4*)(kdt + i * GLA_KD_RS + d0 * 2) = w0; *(u32x4*)(kdt + i * GLA_KD_RS + d0 * 2 + 16) = w1;
                if (tid < 64) dco[tile * 64 + tid] = __expf(tot[256 + tid]);
            }
            __syncthreads();
            f32x16 acc[2];
#pragma unroll
            for (int nt = 0; nt < 2; ++nt)
#pragma unroll
                for (int r = 0; r < 16; ++r) acc[nt][r] = 0.f;
#pragma unroll
            for (int ks = 0; ks < 4; ++ks) {
                const bf16x8 af = tr_frag_at(vt_a, GLA_VT_RS, wid, ks, lane);
#pragma unroll
                for (int nt = 0; nt < 2; ++nt) { const bf16x8 bfr = tr_frag_at(kd_a, GLA_KD_RS, nt, ks, lane); acc[nt] = __builtin_amdgcn_mfma_f32_32x32x16_bf16(af, bfr, acc[nt], 0, 0, 0); }
            }
            bf16_t* out = kvo + tile * 8192;
#pragma unroll
            for (int nt = 0; nt < 2; ++nt)
#pragma unroll
                for (int r = 0; r < 16; ++r) { const int e = wid * 32 + (r & 3) + 8 * (r >> 2) + 4 * (lane >> 5); out[e * 64 + nt * 32 + (lane & 31)] = f2bf(acc[nt][r]); }
            __syncthreads();
        }
    }
}

DEV void ph_gla_scan(const KArgs& a) {
    const int tid = get_tid();
    const bf16_t* kv = (const bf16_t*)(a.ws + WS_KV);
    const float* dc = (const float*)(a.ws + WS_DECAY);
    bf16_t* sp = (bf16_t*)(a.ws + WS_HN);
    for (int item = blockIdx.x; item < 2 * NB * 4 * 8; item += gridDim.x) {
        const int dbh = item >> 3, sub = item & 7, dir = dbh >> 6;
        const int e = sub * 16 + (tid >> 4), dq = (tid & 15) * 4;
        f32x4 S = {0.f, 0.f, 0.f, 0.f};
#pragma unroll 1
        for (int s0 = 0; s0 < 36; s0 += 12) {
            u32x2 kvr[12]; f32x4 dcv[12];
#pragma unroll
            for (int q = 0; q < 12; ++q) {
                const int step = s0 + q, slot = dir == 0 ? step : (step < 4 ? 3 - step : 39 - step);
                const size_t tile = (size_t)dbh * 36 + slot;
                kvr[q] = __builtin_nontemporal_load((const u32x2*)(kv + tile * 8192 + e * 64 + dq)); dcv[q] = *(const f32x4*)(dc + tile * 64 + dq);
            }
#pragma unroll
            for (int q = 0; q < 12; ++q) {
                const int step = s0 + q, slot = dir == 0 ? step : (step < 4 ? 3 - step : 39 - step);
                const size_t tile = (size_t)dbh * 36 + slot;
                const f32x4 kvv = {__uint_as_float(kvr[q].x << 16), __uint_as_float(kvr[q].x & 0xffff0000u), __uint_as_float(kvr[q].y << 16), __uint_as_float(kvr[q].y & 0xffff0000u)};
                u32x2 w; w.x = pk2(S.x, S.y); w.y = pk2(S.z, S.w);
                *(u32x2*)(sp + tile * 8192 + e * 64 + dq) = w;
                S = dcv[q] * S + kvv;
            }
        }
    }
}

DEV void ph_gla_out(const KArgs& a, int layer, unsigned char* lds) {
    const int tid = get_tid(), lane = tid & 63, wid = tid >> 6, ih = wid >> 1, eh = wid & 1, fr = lane & 31, fh = lane >> 5;
    const bf16_t* z = (const bf16_t*)(a.ws + WS_Z);
    const bf16_t* sp = (const bf16_t*)(a.ws + WS_HN);
    bf16_t* mix = (bf16_t*)(a.ws + WS_MIX);
    float* la = (float*)(lds + GLA_OFF_LA); unsigned char* att = lds + GLA_OFF_LA; unsigned char* qet = lds + GLA_OFF_QE; unsigned char* ket = lds + GLA_OFF_KE; unsigned char* vt = lds + GLA_OFF_VT;
    float* swu = (float*)(lds + GLA_OFF_WU); float* tot = (float*)(lds + GLA_OFF_TOT); float* ob = (float*)lds;
    const unsigned vt_a = (unsigned)(size_t)vt;
    const int nchunks = layer == 0 ? 576 : 512;
    const int vb = vblock(), h = vb & 3;
    gla_stage_gate(a, layer, 0, h, swu, tid); gla_stage_gate(a, layer, 1, h, swu + 1088, tid);
    __syncthreads();
    const int i = tid >> 2, d0 = (tid & 3) * 16, e0 = (tid & 3) * 32;
    for (int item = vb; item < nchunks * 4; item += gridDim.x) {
        const int ci = item >> 2;
        int row0, b, slot; gla_chunk_coords(ci, row0, b, slot);
        const bf16_t* zr = z + (size_t)(row0 + i) * DIN;
        const bf16_t* zgp = z + (size_t)(row0 + (wid >> 1) * 32 + (lane & 31)) * DIN + OFF_BG + (lane >> 5) * 8;
        const bf16x8 zf0 = *(const bf16x8*)zgp, zf1 = *(const bf16x8*)(zgp + 16);
        const u32x4 qr0 = *(const u32x4*)(zr + OFF_BQ + h * 64 + d0), qr1 = *(const u32x4*)(zr + OFF_BQ + h * 64 + d0 + 8);
        const u32x4 kr0 = *(const u32x4*)(zr + OFF_BK + h * 64 + d0), kr1 = *(const u32x4*)(zr + OFF_BK + h * 64 + d0 + 8);
        u32x4 vr[4], rr4[4];
#pragma unroll
        for (int j = 0; j < 4; ++j) vr[j] = *(const u32x4*)(zr + OFF_BV + h * 128 + e0 + 8 * j);
#pragma unroll
        for (int j = 0; j < 4; ++j) rr4[j] = *(const u32x4*)(zr + OFF_BR + h * 128 + e0 + 8 * j);
        gla_store_v(vr, vt, tid);
        f32x16 acc[2];
#pragma unroll
        for (int nt = 0; nt < 2; ++nt)
#pragma unroll
            for (int r = 0; r < 16; ++r) acc[nt][r] = 0.f;
#pragma unroll 1
        for (int dir = 0; dir < 2; ++dir) {
            gla_logdecay(dir ? zf1 : zf0, swu + dir * 1088, la, tid);
            __syncthreads();
            gla_cumsum(la, tot, dir, tid);
            {
                float qf[16], kf[16];
                unpack8(qr0, qf); unpack8(qr1, qf + 8); unpack8(kr0, kf); unpack8(kr1, kf + 8);
#pragma unroll
                for (int dd = 0; dd < 16; ++dd) { const float bb = la[i * GLA_LA_STRIDE + d0 + dd]; qf[dd] *= 0.125f * __expf(bb); kf[dd] *= __expf(-bb); }
                u32x4 w0, w1;
                w0.x = pk2(qf[0], qf[1]); w0.y = pk2(qf[2], qf[3]); w0.z = pk2(qf[4], qf[5]); w0.w = pk2(qf[6], qf[7]);
                w1.x = pk2(qf[8], qf[9]); w1.y = pk2(qf[10], qf[11]); w1.z = pk2(qf[12], qf[13]); w1.w = pk2(qf[14], qf[15]);
                *(u32x4*)(qet + i * GLA_QK_RS + d0 * 2) = w0; *(u32x4*)(qet + i * GLA_QK_RS + d0 * 2 + 16) = w1;
                w0.x = pk2(kf[0], kf[1]); w0.y = pk2(kf[2], kf[3]); w0.z = pk2(kf[4], kf[5]); w0.w = pk2(kf[6], kf[7]);
                w1.x = pk2(kf[8], kf[9]); w1.y = pk2(kf[10], kf[11]); w1.z = pk2(kf[12], kf[13]); w1.w = pk2(kf[14], kf[15]);
                *(u32x4*)(ket + i * GLA_QK_RS + d0 * 2) = w0; *(u32x4*)(ket + i * GLA_QK_RS + d0 * 2 + 16) = w1;
            }
            const bf16_t* st = sp + (size_t)(((dir * NB + b) * 4 + h) * 36 + slot) * 8192;
            bf16x8 bs[4][2];
#pragma unroll
            for (int ks = 0; ks < 4; ++ks)
#pragma unroll
                for (int nt = 0; nt < 2; ++nt) bs[ks][nt] = *(const bf16x8*)(st + (eh * 64 + nt * 32 + fr) * 64 + ks * 16 + fh * 8);
            __syncthreads();
            bf16x8 aq[4];
#pragma unroll
            for (int ks = 0; ks < 4; ++ks) aq[ks] = *(const bf16x8*)(qet + (ih * 32 + fr) * GLA_QK_RS + (ks * 16 + fh * 8) * 2);
            {
                f32x16 sa;
#pragma unroll
                for (int r = 0; r < 16; ++r) sa[r] = 0.f;
#pragma unroll
                for (int ks = 0; ks < 4; ++ks) { const bf16x8 bk = *(const bf16x8*)(ket + (eh * 32 + fr) * GLA_QK_RS + (ks * 16 + fh * 8) * 2); sa = __builtin_amdgcn_mfma_f32_32x32x16_bf16(aq[ks], bk, sa, 0, 0, 0); }
                const int j = eh * 32 + fr;
#pragma unroll
                for (int r = 0; r < 16; ++r) {
                    const int ii = ih * 32 + (r & 3) + 8 * (r >> 2) + 4 * fh;
                    const bool keep = dir == 0 ? (j <= ii) : (j >= ii);
                    *(bf16_t*)(att + ii * GLA_QK_RS + j * 2) = f2bf(keep ? sa[r] : 0.f);
                }
            }
            __syncthreads();
#pragma unroll
            for (int ks = 0; ks < 4; ++ks) {
                const bf16x8 aa = *(const bf16x8*)(att + (ih * 32 + fr) * GLA_QK_RS + (ks * 16 + fh * 8) * 2);
#pragma unroll
                for (int nt = 0; nt < 2; ++nt) {
                    const bf16x8 bv = tr_frag_at(vt_a, GLA_VT_RS, eh * 2 + nt, ks, lane);
                    acc[nt] = __builtin_amdgcn_mfma_f32_32x32x16_bf16(aa, bv, acc[nt], 0, 0, 0);
                    acc[nt] = __builtin_amdgcn_mfma_f32_32x32x16_bf16(aq[ks], bs[ks][nt], acc[nt], 0, 0, 0);
                }
            }
            __syncthreads();
        }
#pragma unroll
        for (int nt = 0; nt < 2; ++nt)
#pragma unroll
            for (int r = 0; r < 16; ++r) ob[(ih * 32 + (r & 3) + 8 * (r >> 2) + 4 * fh) * 132 + eh * 64 + nt * 32 + fr] = acc[nt][r];
        __syncthreads();
        {
            float o[32]; float ss = 0.f;
#pragma unroll
            for (int j = 0; j < 8; ++j) { const f32x4 v = *(const f32x4*)(ob + i * 132 + e0 + 4 * j); o[4 * j] = v.x; o[4 * j + 1] = v.y; o[4 * j + 2] = v.z; o[4 * j + 3] = v.w; ss += v.x * v.x + v.y * v.y + v.z * v.z + v.w * v.w; }
            ss += __shfl_xor(ss, 1); ss += __shfl_xor(ss, 2);
            const float rstd = rsqrtf(ss * (1.f / 128.f) + EPS);
            const float* gg = a.in[I_GGLA] + layer * 512 + h * 128 + e0;
            bf16_t* mo = mix + (size_t)(row0 + i) * D + 512 + h * 128 + e0;
#pragma unroll
            for (int j = 0; j < 4; ++j) {
                float rf[8]; unpack8(rr4[j], rf);
                const f32x4 g0 = *(const f32x4*)(gg + 8 * j), g1 = *(const f32x4*)(gg + 8 * j + 4);
                u32x4 w;
                w.x = pk2(o[8 * j + 0] * rstd * g0.x * silu_f(rf[0]), o[8 * j + 1] * rstd * g0.y * silu_f(rf[1]));
                w.y = pk2(o[8 * j + 2] * rstd * g0.z * silu_f(rf[2]), o[8 * j + 3] * rstd * g0.w * silu_f(rf[3]));
                w.z = pk2(o[8 * j + 4] * rstd * g1.x * silu_f(rf[4]), o[8 * j + 5] * rstd * g1.y * silu_f(rf[5]));
                w.w = pk2(o[8 * j + 6] * rstd * g1.z * silu_f(rf[6]), o[8 * j + 7] * rstd * g1.w * silu_f(rf[7]));
                *(u32x4*)(mo + 8 * j) = w;
            }
        }
        __syncthreads();
    }
}

DEV void ph_router(const KArgs& a, int layer, int nrows, unsigned char* lds) {
    const int tid = get_tid();
    const bf16_t* hn = (const bf16_t*)(a.ws + WS_HN);
    const bf16_t* WT = (const bf16_t*)(a.ws + WS_WRT) + (size_t)layer * 128 * D;
    unsigned* cnt = (unsigned*)(a.ws + WS_CTL) + layer * NE;
    unsigned* list = (unsigned*)(a.ws + WS_LIST);
    float* gate = (float*)(a.ws + WS_GATE);
    float* lgs = (float*)lds;
    for (int t = vblock(); t < nrows / 128; t += gridDim.x) {
        const int row0 = t * 128;
        f32x16 acc[2][2];
        gemm_core(lds, D / 64, [&](int r) { return hn + (size_t)(row0 + r) * D; }, [&](int r) { return WT + (size_t)r * D; }, acc);
        ACC_FOREACH(mi, ni, r, row, col) { if (col < 72) lgs[row * 73 + col] = acc[mi][ni][r]; }
        __syncthreads();
        if (tid < 128) {
            const float* lr = lgs + tid * 73; const int r = row0 + tid;
            float lg[8];
#pragma unroll
            for (int j = 0; j < 8; ++j) lg[j] = lr[j] + a.in[I_BRG][layer * 8 + j];
            float m = lg[0]; int gi = 0;
#pragma unroll
            for (int j = 1; j < 8; ++j) if (lg[j] > m) { m = lg[j]; gi = j; }
            float sum = 0.f;
#pragma unroll
            for (int j = 0; j < 8; ++j) sum += __expf(lg[j] - m);
            const float ptop = 1.f / sum;
            float le[8];
#pragma unroll
            for (int j = 0; j < 8; ++j) le[j] = lr[8 + gi * 8 + j] + a.in[I_BRE][layer * 64 + gi * 8 + j];
            float l1 = le[0]; int i1 = 0;
#pragma unroll
            for (int j = 1; j < 8; ++j) if (le[j] > l1) { l1 = le[j]; i1 = j; }
            float l2 = -3.0e38f; int i2 = 0;
#pragma unroll
            for (int j = 0; j < 8; ++j) if (j != i1 && le[j] > l2) { l2 = le[j]; i2 = j; }
            const float e2 = __expf(l2 - l1), w1 = 1.f / (1.f + e2), w2 = e2 / (1.f + e2);
            const int ex1 = gi * 8 + i1, ex2 = gi * 8 + i2;
            const unsigned p1 = atomicAdd(cnt + ex1, 1u), p2 = atomicAdd(cnt + ex2, 1u);
            list[(size_t)ex1 * LCAP + p1] = (unsigned)(2 * r); list[(size_t)ex2 * LCAP + p2] = (unsigned)(2 * r + 1);
            gate[2 * r] = ptop * w1; gate[2 * r + 1] = ptop * w2;
        }
        __syncthreads();
    }
}

DEV void ph_moe(const KArgs& a, int layer, int sub, unsigned char* lds) {
    const int tid = get_tid();
    const unsigned* cnt = (const unsigned*)(a.ws + WS_CTL) + layer * NE;
    const unsigned* list = (const unsigned*)(a.ws + WS_LIST);
    const float* gate = (const float*)(a.ws + WS_GATE);
    bf16_t* ys = (bf16_t*)(a.ws + WS_KV);
    int (*s_off)[80] = (int (*)[80])(lds + 65536);
    constexpr int ntn = 8;
    if (tid < NE) s_off[0][tid] = (int)cnt[tid];
    __syncthreads();
    if (tid == 0) { int o = 0, t = 0; for (int e = 0; e < NE; ++e) { const int c = s_off[0][e]; s_off[0][e] = o; s_off[1][e] = t; o += c; t += ((c + 127) / 128) * ntn; } s_off[0][NE] = o; s_off[1][NE] = t; }
    __syncthreads();
    const int ntiles = s_off[1][NE];
    struct Cx { int e, p0, nt, c, ro; };
    auto prep = [&](int t) { Cx x; int e = 0;
#pragma unroll
        for (int st = 32; st >= 1; st >>= 1) if (s_off[1][e + st] <= t) e += st;
        const int local = t - s_off[1][e]; x.e = e; x.p0 = (local / ntn) * 128; x.nt = local % ntn; x.c = (int)cnt[e]; x.ro = s_off[0][e];
        return x; };
    const int wr = tid >> 7, wc = (tid >> 6) & 1, lane = tid & 63;
    const unsigned char* hn8 = a.ws + WS_HN8;
    unsigned char* H8 = a.ws + WS_Z;
    if (sub == 0) {
        gemm_stream<true>(lds, D / 128, vblock(), gridDim.x, ntiles, prep,
            [&](const Cx& x, int r) { const int n = x.nt * 64 + (r >> 6) * 32 + (r & 31);
                                return (const bf16_t*)(a.ws + ((r >> 5) & 1 ? WS_W3T : WS_W1T) + ((size_t)x.e * DE + n) * D); },
            [&](const Cx& x, int r) { const int p = x.p0 + r; const unsigned slot = list[(size_t)x.e * LCAP + (p < x.c ? p : 0)]; return (const bf16_t*)(hn8 + (size_t)(slot >> 1) * D); },
            [&](const Cx& x, const f32x16 (&acc)[2][2]) {
                const int p0 = x.p0, nt = x.nt, c = x.c, ro = x.ro;
#pragma unroll
                for (int ni = 0; ni < 2; ++ni) {
                    const int p = p0 + wc * 64 + ni * 32 + (lane & 31);
                    unsigned char* hr = H8 + (size_t)(ro + (p < c ? p : 0)) * DE + nt * 64 + wr * 32 + 8 * (lane >> 5);
#pragma unroll
                    for (int kp = 0; kp < 2; ++kp) {
                        float hv[8];
#pragma unroll
                        for (int q = 0; q < 8; ++q) hv[q] = silu_f(acc[0][ni][8 * kp + q] * W8_INV) * (acc[1][ni][8 * kp + q] * W8_INV);
                        const unsigned wa = pk4_fp8(hv[0], hv[1], hv[2], hv[3]), wb = pk4_fp8(hv[4], hv[5], hv[6], hv[7]);
                        auto rsw = __builtin_amdgcn_permlane32_swap(wa, wb, false, false);
                        u32x2 w; w.x = rsw[0]; w.y = rsw[1];
                        if (p < c) *(u32x2*)(hr + 16 * kp) = w;
                    }
                }
            });
    } else {
        gemm_stream<true>(lds, DE / 128, vblock(), gridDim.x, ntiles, prep,
            [&](const Cx& x, int r) { return (const bf16_t*)(a.ws + WS_W2T + ((size_t)x.e * D + x.nt * 128 + r) * DE); },
            [&](const Cx& x, int r) { const int p = x.p0 + r; return (const bf16_t*)(H8 + (size_t)(x.ro + (p < x.c ? p : 0)) * DE); },
            [&](const Cx& x, const f32x16 (&acc)[2][2]) {
                const int e = x.e, p0 = x.p0, nt = x.nt, c = x.c;
                unsigned slotv[2]; float gtv[2];
#pragma unroll
                for (int ni = 0; ni < 2; ++ni) { const int p = p0 + wc * 64 + ni * 32 + (lane & 31); slotv[ni] = list[(size_t)e * LCAP + (p < c ? p : 0)]; }
#pragma unroll
                for (int ni = 0; ni < 2; ++ni) gtv[ni] = gate[slotv[ni]] * W8_INV;
#pragma unroll
                for (int ni = 0; ni < 2; ++ni) {
                    const int p = p0 + wc * 64 + ni * 32 + (lane & 31);
                    const unsigned slot = slotv[ni]; const float gt = gtv[ni] * YS_SCALE;
                    unsigned char* yo = (unsigned char*)ys + (size_t)slot * D + nt * 128 + wr * 64 + 8 * (lane >> 5);
#pragma unroll
                    for (int mi = 0; mi < 2; ++mi)
#pragma unroll
                        for (int kp = 0; kp < 2; ++kp) {
                            const unsigned wa = pk4_fp8(gt * acc[mi][ni][8 * kp], gt * acc[mi][ni][8 * kp + 1], gt * acc[mi][ni][8 * kp + 2], gt * acc[mi][ni][8 * kp + 3]);
                            const unsigned wb = pk4_fp8(gt * acc[mi][ni][8 * kp + 4], gt * acc[mi][ni][8 * kp + 5], gt * acc[mi][ni][8 * kp + 6], gt * acc[mi][ni][8 * kp + 7]);
                            auto rsw = __builtin_amdgcn_permlane32_swap(wa, wb, false, false);
                            u32x2 w; w.x = rsw[0]; w.y = rsw[1];
                            if (p < c) *(u32x2*)(yo + mi * 32 + 16 * kp) = w;
                        }
                }
            });
    }
}

#define XB_TMO      128
#define XB_XCNT(j)  (256  + 64 * (j))
#define XB_XSUB(j)  (1280 + 64 * (j))
#define XB_XGEN(j)  (2304 + 64 * (j))
#define XB_TOP      3328
#define XB_TOPGEN   3392
#define XCD_BAR_WORDS 3456
#define XB_SPIN_CAP (1u << 18)
#define LAS __attribute__((address_space(3)))
DEV unsigned xb_ld(unsigned* p)              { return __hip_atomic_load(p, __ATOMIC_RELAXED, __HIP_MEMORY_SCOPE_AGENT); }
DEV unsigned xb_add(unsigned* p, unsigned v) { return __hip_atomic_fetch_add(p, v, __ATOMIC_RELAXED, __HIP_MEMORY_SCOPE_AGENT); }
DEV unsigned xb_xcc_id() { return (unsigned)__builtin_amdgcn_s_getreg((3 << 11) | 20) & 0xFu; }
#define XB_SPIN(cond, bar) do { unsigned _sp = 0; while (cond) { __builtin_amdgcn_s_sleep(1); \
    if ((++_sp & 255u) == 0u) { if (xb_ld(&(bar)[XB_TMO])) break; if (_sp > XB_SPIN_CAP) { atomicAdd(&(bar)[XB_TMO], 1u); break; } } } } while (0)
struct XcdBarrier { unsigned* bar; unsigned x; volatile LAS unsigned* st; };
DEV XcdBarrier xcd_barrier_post(unsigned* bar, volatile LAS unsigned* st) {
    XcdBarrier b; b.bar = bar; b.x = xb_xcc_id(); b.st = st;
    if (threadIdx.x == 0) (void)xb_add(&bar[XB_XCNT(b.x)], 1u);
    return b;
}
DEV void xcd_barrier_complete(unsigned* bar, unsigned x, unsigned& nloc, unsigned& nx) {
    const unsigned G = gridDim.x * gridDim.y * gridDim.z;
    unsigned sum, cnt, mine, sp = 0u;
    for (;;) {
        sum = 0u; cnt = 0u; mine = 0u;
#pragma unroll
        for (unsigned j = 0; j < 16; ++j) { const unsigned c = xb_ld(&bar[XB_XCNT(j)]); sum += c; cnt += (c > 0u) ? 1u : 0u; mine = (j == x) ? c : mine; }
        if (sum == G) break;
        __builtin_amdgcn_s_sleep(1);
        if ((++sp & 255u) == 0u) { if (xb_ld(&bar[XB_TMO])) break; if (sp > XB_SPIN_CAP) { atomicAdd(&bar[XB_TMO], 1u); break; } }
    }
    nloc = mine > 0u ? mine : 1u; nx = cnt > 0u ? cnt : 1u;
}
DEV void xcd_barrier(const XcdBarrier& b) {
    asm volatile("s_waitcnt vmcnt(0)" ::: "memory");
    __syncthreads();
    if (threadIdx.x == 0) {
        unsigned* bar = b.bar;
        __builtin_amdgcn_s_waitcnt(0);
        unsigned nloc = b.st[0], nx = b.st[1];
        if (nloc == 0u) { xcd_barrier_complete(bar, b.x, nloc, nx); b.st[0] = nloc; b.st[1] = nx; }
        const unsigned old = xb_add(&bar[XB_XSUB(b.x)], 1u);
        const unsigned gen = old / nloc;
        if (old + 1u == (gen + 1u) * nloc) {
            __builtin_amdgcn_fence(__ATOMIC_RELEASE, "agent");
            asm volatile("s_waitcnt vmcnt(0)" ::: "memory");
            const unsigned og = xb_add(&bar[XB_TOP], 1u);
            const unsigned tg = og / nx;
            if (og + 1u == (tg + 1u) * nx) xb_add(&bar[XB_TOPGEN], 1u);
            else XB_SPIN(xb_ld(&bar[XB_TOPGEN]) == tg, bar);
            __builtin_amdgcn_fence(__ATOMIC_ACQUIRE, "agent");
            xb_add(&bar[XB_XGEN(b.x)], 1u);
            asm volatile("s_waitcnt vmcnt(0)" ::: "memory");
        } else {
            XB_SPIN(xb_ld(&bar[XB_XGEN(b.x)]) == gen, bar);
            __builtin_amdgcn_fence(__ATOMIC_ACQUIRE, "agent");
            asm volatile("s_waitcnt vmcnt(0)" ::: "memory");
        }
    }
    __syncthreads();
}

constexpr int NPH_LAYER = 10, NPH = 1 + 2 * NPH_LAYER + 1;
__global__ void __launch_bounds__(256, 2) mega(KArgs a) {
    __shared__ __attribute__((aligned(16))) unsigned char lds[65536 + 1024];
    uint4& xb_words = *(uint4*)(lds + 65536 + 768);
    cg::grid_group grid = cg::this_grid();
    const int lo = a.ph_lo, hi = a.ph_hi;
    if (threadIdx.x == 0) xb_words = make_uint4(0u, 0u, 0u, 0u);
    __syncthreads();
    const XcdBarrier xb = xcd_barrier_post((unsigned*)(a.ws + WS_CTL + 65536), (volatile LAS unsigned*)&xb_words);
    if (threadIdx.x == 0) {
        const unsigned hwid = (unsigned)__builtin_amdgcn_s_getreg((31 << 11) | 4), key = xb.x * 256u + ((hwid >> 8) & 0xffu);
        ((volatile unsigned*)&xb_words)[2] = atomicAdd((unsigned*)(a.ws + WS_CTL + 16384) + key, 1u);
    }
    __syncthreads();
    const int cu_role = __builtin_amdgcn_readfirstlane((int)(((volatile unsigned*)&xb_words)[2] & 1u));
#define GEMM_PRIO_ON()  (cu_role ? __builtin_amdgcn_s_setprio(2) : (void)0)
#define GEMM_PRIO_OFF() __builtin_amdgcn_s_setprio(0)
    if (hi < 0) grid.sync();
#define PHASE(k, call) do { const int k_ = (k); if (lo <= k_ && k_ < hi) { call; if (k_ + 1 < hi) xcd_barrier(xb); } } while (0)
    PHASE(0, (ph_prep(a, lds), convert_shared(a, lds)));
#pragma unroll 1
    for (int l = 0; l < 2; ++l) {
        const int base = 1 + l * NPH_LAYER;
        const int nrows = l == 0 ? TA : TL;
        PHASE(base + 0, ph_norm(a, l, 0, l > 0, l - 1, l == 0, TA));
        PHASE(base + 1, (GEMM_PRIO_ON(), ph_inproj(a, l, lds), GEMM_PRIO_OFF()));
        PHASE(base + 2, (blockIdx.x < (gridDim.x >> 1) ? (convert_experts(a, l, lds), __syncthreads(), ph_spatial(a, l, nrows, lds), ph_gla_kv(a, l, lds))
                                                        : (ph_spatial(a, l, nrows, lds), ph_gla_kv(a, l, lds), __syncthreads(), convert_experts(a, l, lds))));
        PHASE(base + 3, ph_gla_scan(a));
        PHASE(base + 4, ph_gla_out(a, l, lds));
        PHASE(base + 5, (GEMM_PRIO_ON(), ph_outproj(a, l, nrows, lds), GEMM_PRIO_OFF()));
        PHASE(base + 6, ph_norm(a, l, 1, false, 0, false, nrows));
        PHASE(base + 7, ph_router(a, l, nrows, lds));
        PHASE(base + 8, (GEMM_PRIO_ON(), ph_moe(a, l, 0, lds), GEMM_PRIO_OFF()));
        PHASE(base + 9, (GEMM_PRIO_ON(), ph_moe(a, l, 1, lds), GEMM_PRIO_OFF()));
    }
    PHASE(NPH - 1, ph_norm(a, 0, 2, true, 1, false, TL));
#undef PHASE
}

extern "C" void kernel_launch(void* const* d_in, const int* in_sizes, int n_in, void* d_out, int out_size, void* d_ws, size_t ws_size, hipStream_t stream) {
    static int grid = 0;
    if (grid == 0) {
        int dev = 0, cus = 0, per_cu = 0;
        hipGetDevice(&dev);
        hipDeviceGetAttribute(&cus, hipDeviceAttributeMultiprocessorCount, dev);
        hipOccupancyMaxActiveBlocksPerMultiprocessor(&per_cu, (const void*)mega, 256, 0);
        if (per_cu < 1) per_cu = 1;
        if (per_cu > 2) per_cu = 2;
        grid = cus * per_cu;
        if (n_in != 25 || ws_size < WS_END) { fprintf(stderr, "kernel_launch: unexpected n_in %d or ws_size %zu (need %zu)\n", n_in, ws_size, (size_t)WS_END); }
    }
    KArgs a{};
    for (int i = 0; i < 25; ++i) a.in[i] = (const float*)d_in[i];
    a.out = (float*)d_out; a.ws = (unsigned char*)d_ws;
    hipMemsetAsync(d_ws, 0, WS_MOD + 2 * 17 * 6144 * 4, stream);
#if ONE_LAUNCH
    a.ph_lo = 0; a.ph_hi = NPH;
    void* args[] = {&a};
    hipError_t e = hipLaunchCooperativeKernel((const void*)mega, dim3(grid), dim3(256), args, 0, stream);
    if (e != hipSuccess) fprintf(stderr, "cooperative launch failed: %s (grid %d)\n", hipGetErrorString(e), grid);
#else
    for (int ph = 0; ph < NPH; ++ph) {
        a.ph_lo = ph; a.ph_hi = ph + 1;
        hipLaunchKernelGGL(mega, dim3(grid), dim3(256), 0, stream, a);
    }
#endif
}
```

```cpp
#include <hip/hip_runtime.h>
#include <hip/hip_cooperative_groups.h>
#include <cstdio>
#include <cstdint>
namespace cg = cooperative_groups;

#ifndef ONE_LAUNCH
#define ONE_LAUNCH 1
#endif

#define DEV __device__ __forceinline__
typedef unsigned short bf16_t;
typedef float f32x4 __attribute__((ext_vector_type(4)));
typedef unsigned u32x2 __attribute__((ext_vector_type(2)));
typedef unsigned u32x4 __attribute__((ext_vector_type(4)));
typedef short bf16x8 __attribute__((ext_vector_type(8)));
typedef float f32x16 __attribute__((ext_vector_type(16)));
typedef long i64x2 __attribute__((ext_vector_type(2)));
typedef int i32x4 __attribute__((ext_vector_type(4)));
typedef int i32x8 __attribute__((ext_vector_type(8)));

constexpr int D = 1024, NB = 16, SEQ = 2048, CTXL = 256;
constexpr int TL = NB * SEQ, TC = NB * CTXL, TA = TL + TC;
constexpr int DIN = 2592, OFF_AU = 0, OFF_AV = 512, OFF_BQ = 1024, OFF_BR = 1280, OFF_BK = 1792, OFF_BV = 2048, OFF_BG = 2560;
constexpr int NE = 64, DE = 512, LCAP = 2 * TA;
constexpr float EPS = 1e-6f;

constexpr size_t MiB = 1u << 20;
constexpr size_t WS_CTL = 0, WS_MOD = 1 * MiB, WS_WRT = 2 * MiB, WS_WSP = 2 * MiB + 512 * 1024, WS_WINT = 3 * MiB, WS_WOUTT = 14 * MiB,
                 WS_W1T = 18 * MiB, WS_W3T = 82 * MiB, WS_W2T = 146 * MiB, WS_H = 210 * MiB, WS_HN = 354 * MiB, WS_Z = 426 * MiB, WS_MIX = 609 * MiB,
                 WS_KV = 681 * MiB, WS_DECAY = 844 * MiB, WS_HN8 = 846 * MiB, WS_LIST = 884 * MiB, WS_END = 921 * MiB;
static_assert(WS_WINT + (size_t)2 * DIN * D * 2 <= WS_WOUTT && WS_WOUTT + (size_t)2 * D * D * 2 <= WS_W1T && WS_W1T + (size_t)NE * DE * D * 2 <= WS_W3T && WS_W2T + (size_t)NE * DE * D * 2 <= WS_H, "ws map (weights)");
static_assert(WS_H + (size_t)TA * D * 4 <= WS_HN && WS_HN + (size_t)TA * D * 2 <= WS_Z && WS_Z + (size_t)TA * DIN * 2 <= WS_MIX &&
              WS_MIX + (size_t)TA * D * 2 <= WS_KV && WS_KV + (size_t)2 * TA * 512 * 4 <= WS_DECAY && WS_LIST + (size_t)NE * LCAP * 8 <= WS_END, "ws map");

struct KArgs { const float* in[25]; float* out; unsigned char* ws; int ph_lo, ph_hi; };
enum { I_X = 0, I_C, I_CTX, I_CCTX, I_WMOD, I_BMOD, I_GN1, I_WIN, I_LNG, I_LNB, I_WSP, I_BSP, I_WGU, I_BG, I_GGLA, I_WOUT, I_GN2, I_WRG, I_BRG, I_WRE, I_BRE, I_W1, I_W3, I_W2, I_GF };

DEV float bf2f(bf16_t v) { return __uint_as_float((unsigned)v << 16); }
typedef __bf16 bf16x2_t __attribute__((ext_vector_type(2)));
DEV bf16_t f2bf(float f) { return __builtin_bit_cast(bf16_t, (__bf16)f); }
DEV unsigned pk2(float lo, float hi) { bf16x2_t v; v.x = (__bf16)lo; v.y = (__bf16)hi; return __builtin_bit_cast(unsigned, v); }
DEV u32x4 widen_pair(u32x2 a, u32x2 b) {
    auto r0 = __builtin_amdgcn_permlane32_swap(a.x, b.x, false, false); auto r1 = __builtin_amdgcn_permlane32_swap(a.y, b.y, false, false);
    u32x4 o; o.x = r0[0]; o.y = r1[0]; o.z = r0[1]; o.w = r1[1]; return o;
}
constexpr float W8_SCALE = 32.f, W8_INV = 1.f / 32.f, YS_SCALE = 16.f, YS_INV = 1.f / 16.f;
DEV unsigned pk4_fp8(float a, float b, float c, float d) { int w = 0; w = __builtin_amdgcn_cvt_pk_fp8_f32(a, b, w, false); w = __builtin_amdgcn_cvt_pk_fp8_f32(c, d, w, true); return (unsigned)w; }
DEV float silu_f(float x) { return x * __builtin_amdgcn_rcpf(1.f + __expf(-x)); }
DEV float gelu_f(float x) { const float x2 = x * x; const float u2 = x * (1.5957691216057308f + 0.07135481627f * x2); return x * __builtin_amdgcn_rcpf(1.f + __expf(-u2)); }
DEV float logsigmoid_f(float x) { return fminf(x, 0.f) - __logf(1.f + __expf(-fabsf(x))); }
DEV float wave_sum(float v) {
#pragma unroll
    for (int o = 1; o < 64; o <<= 1) v += __shfl_xor(v, o);
    return v;
}
DEV int get_tid() { int t = threadIdx.x; asm volatile("" : "+v"(t)); return t; }
DEV int mod_index(int row) { return row < TL ? (row >> 11) : 16; }

DEV void ph_prep(const KArgs& a, unsigned char* lds) {
    const int tid = get_tid(), lane = tid & 63, wid = tid >> 6;
    float* slab = (float*)lds + wid * 17 * 64;
    float* red = (float*)lds + 4 * 17 * 64;
    float* mod = (float*)(a.ws + WS_MOD);
    const float* c = a.in[I_C]; const float* cctx = a.in[I_CCTX];
    for (int item = blockIdx.x; item < 2 * 96 * 2; item += gridDim.x) {
        const int kh = item & 1, it2 = item >> 1, l = it2 / 96, j0 = (it2 % 96) * 64, j = j0 + lane;
        const float* W = a.in[I_WMOD] + (size_t)l * D * 6144;
        float acc[17];
#pragma unroll
        for (int i = 0; i < 17; ++i) acc[i] = 0.f;
#pragma unroll 1
        for (int ks = 0; ks < 2; ++ks) {
            const int kb = kh * 512 + wid * 128 + ks * 64;
#pragma unroll
            for (int bi = 0; bi < 17; ++bi) { const float x = (bi < 16) ? c[bi * D + kb + lane] : cctx[kb + lane]; slab[bi * 64 + lane] = silu_f(x); }
            __syncthreads();
#pragma unroll 1
            for (int k8 = 0; k8 < 64; k8 += 16) {
                float w[16];
#pragma unroll
                for (int u = 0; u < 16; ++u) w[u] = __builtin_nontemporal_load(W + (size_t)(kb + k8 + u) * 6144 + j);
#pragma unroll
                for (int u = 0; u < 16; ++u)
#pragma unroll
                    for (int bi = 0; bi < 17; ++bi) acc[bi] += slab[bi * 64 + k8 + u] * w[u];
            }
            __syncthreads();
        }
#pragma unroll
        for (int bi = 0; bi < 17; ++bi) red[(wid * 17 + bi) * 64 + lane] = acc[bi];
        __syncthreads();
        for (int idx = tid; idx < 17 * 64; idx += 256) {
            const int bi = idx >> 6, ln = idx & 63;
            const float sv = red[(0 * 17 + bi) * 64 + ln] + red[(1 * 17 + bi) * 64 + ln] + red[(2 * 17 + bi) * 64 + ln] + red[(3 * 17 + bi) * 64 + ln] + (kh == 0 ? a.in[I_BMOD][l * 6144 + j0 + ln] : 0.f);
            atomicAdd(mod + (size_t)(l * 17 + bi) * 6144 + j0 + ln, sv);
        }
        __syncthreads();
    }
}

DEV void ph_norm(const KArgs& a, int layer, int which  , bool combine, int comb_layer, bool from_input, int nrows) {
    const int tid = get_tid(), lane = tid & 63, wid = tid >> 6;
    float* hws = (float*)(a.ws + WS_H);
    bf16_t* hn = (bf16_t*)(a.ws + WS_HN);
    const bf16_t* ys = (const bf16_t*)(a.ws + WS_KV);
    const float* mod = (const float*)(a.ws + WS_MOD);
    const float* g = which == 0 ? a.in[I_GN1] + layer * D : (which == 1 ? a.in[I_GN2] + layer * D : a.in[I_GF]);
    const int nw = gridDim.x * 4;
    for (int r = blockIdx.x * 4 + wid; r < nrows; r += nw) {
        const int bi = mod_index(r);
        const float* src = from_input ? (r < TL ? a.in[I_X] + (size_t)r * D : a.in[I_CTX] + (size_t)(r - TL) * D) : hws + (size_t)r * D;
        f32x4 v[4];
#pragma unroll
        for (int j = 0; j < 4; ++j) v[j] = __builtin_nontemporal_load((const f32x4*)(src + (lane + 64 * j) * 4));
        if (combine) {
            const float* g2 = mod + (size_t)(comb_layer * 17 + bi) * 6144 + 5 * D;
            unsigned y0v[4], y1v[4]; f32x4 ggv[4];
#pragma unroll
            for (int j = 0; j < 4; ++j) { const int k = (lane + 64 * j) * 4; y0v[j] = __builtin_nontemporal_load((const unsigned*)((const unsigned char*)ys + (size_t)(2 * r) * D + k)); y1v[j] = __builtin_nontemporal_load((const unsigned*)((const unsigned char*)ys + (size_t)(2 * r + 1) * D + k)); ggv[j] = *(const f32x4*)(g2 + k); }
#pragma unroll
            for (int j = 0; j < 4; ++j) {
                const int k = (lane + 64 * j) * 4;
                const int y0 = (int)y0v[j], y1 = (int)y1v[j];
                const f32x4 gg = ggv[j] * YS_INV;
                v[j].x += gg.x * (__builtin_amdgcn_cvt_f32_fp8(y0, 0) + __builtin_amdgcn_cvt_f32_fp8(y1, 0));
                v[j].y += gg.y * (__builtin_amdgcn_cvt_f32_fp8(y0, 1) + __builtin_amdgcn_cvt_f32_fp8(y1, 1));
                v[j].z += gg.z * (__builtin_amdgcn_cvt_f32_fp8(y0, 2) + __builtin_amdgcn_cvt_f32_fp8(y1, 2));
                v[j].w += gg.w * (__builtin_amdgcn_cvt_f32_fp8(y0, 3) + __builtin_amdgcn_cvt_f32_fp8(y1, 3));
                if (which != 2) __builtin_nontemporal_store(v[j], (f32x4*)(hws + (size_t)r * D + k));
            }
        }
        float ss = 0.f;
#pragma unroll
        for (int j = 0; j < 4; ++j) ss += v[j].x * v[j].x + v[j].y * v[j].y + v[j].z * v[j].z + v[j].w * v[j].w;
        const float rstd = rsqrtf(wave_sum(ss) * (1.f / D) + EPS);
        if (which == 2) {
            f32x4 gv[4];
#pragma unroll
            for (int j = 0; j < 4; ++j) gv[j] = *(const f32x4*)(g + (lane + 64 * j) * 4);
#pragma unroll
            for (int j = 0; j < 4; ++j) { const int k = (lane + 64 * j) * 4; f32x4 o = v[j] * rstd * gv[j]; __builtin_nontemporal_store(o, (f32x4*)(a.out + (size_t)r * D + k)); }
        } else {
            const float* sh = mod + (size_t)(layer * 17 + bi) * 6144 + (which == 0 ? 0 : 3 * D);
            const float* sc = sh + D;
            f32x4 gv[4], s1v[4], s0v[4];
#pragma unroll
            for (int j = 0; j < 4; ++j) { const int k = (lane + 64 * j) * 4; gv[j] = *(const f32x4*)(g + k); s1v[j] = *(const f32x4*)(sc + k); s0v[j] = *(const f32x4*)(sh + k); }
#pragma unroll
            for (int j = 0; j < 4; ++j) {
                const int k = (lane + 64 * j) * 4;
                const f32x4 gg = gv[j], s1 = s1v[j], s0 = s0v[j];
                const f32x4 o = v[j] * rstd * gg * (1.f + s1) + s0;
                u32x2 w; w.x = pk2(o.x, o.y); w.y = pk2(o.z, o.w);
                *(u32x2*)(hn + (size_t)r * D + k) = w;
                if (which == 1) *(unsigned*)(a.ws + WS_HN8 + (size_t)r * D + k) = pk4_fp8(o.x, o.y, o.z, o.w);
            }
        }
    }
}


DEV void transpose_item(const float* W, int K, int N, bf16_t* WT, float* scr, int kb, int nb, int lane) {
    const int k0 = kb * 64, n0 = nb * 32;
    float wv[32];
#pragma unroll
    for (int i = 0; i < 32; ++i) wv[i] = __builtin_nontemporal_load(W + (size_t)(k0 + 2 * i + (lane >> 5)) * N + n0 + (lane & 31));
#pragma unroll
    for (int i = 0; i < 32; ++i) scr[(2 * i + (lane >> 5)) * 33 + (lane & 31)] = wv[i];
    asm volatile("s_waitcnt lgkmcnt(0)" ::: "memory");
    const int c = lane & 7;
#pragma unroll
    for (int j = 0; j < 4; ++j) {
        const int n = (lane >> 3) + 8 * j; const float* sp = scr + (8 * c) * 33 + n;
        u32x4 o; o.x = pk2(sp[0 * 33], sp[1 * 33]); o.y = pk2(sp[2 * 33], sp[3 * 33]); o.z = pk2(sp[4 * 33], sp[5 * 33]); o.w = pk2(sp[6 * 33], sp[7 * 33]);
        *(u32x4*)(WT + (size_t)(n0 + n) * K + k0 + 8 * c) = o;
    }
    asm volatile("s_waitcnt lgkmcnt(0)" ::: "memory");
}
DEV void transpose_item8(const float* W, int K, int N, unsigned char* WT, float* scr, int kb, int nb, int lane) {
    const int k0 = kb * 64, n0 = nb * 32;
    float wv[32];
#pragma unroll
    for (int i = 0; i < 32; ++i) wv[i] = __builtin_nontemporal_load(W + (size_t)(k0 + 2 * i + (lane >> 5)) * N + n0 + (lane & 31));
#pragma unroll
    for (int i = 0; i < 32; ++i) scr[(2 * i + (lane >> 5)) * 33 + (lane & 31)] = wv[i] * W8_SCALE;
    asm volatile("s_waitcnt lgkmcnt(0)" ::: "memory");
    const int n = lane & 31, kh = (lane >> 5) * 32;
    const float* sp = scr + kh * 33 + n;
    u32x4 o0, o1;
    o0.x = pk4_fp8(sp[0 * 33], sp[1 * 33], sp[2 * 33], sp[3 * 33]); o0.y = pk4_fp8(sp[4 * 33], sp[5 * 33], sp[6 * 33], sp[7 * 33]);
    o0.z = pk4_fp8(sp[8 * 33], sp[9 * 33], sp[10 * 33], sp[11 * 33]); o0.w = pk4_fp8(sp[12 * 33], sp[13 * 33], sp[14 * 33], sp[15 * 33]);
    o1.x = pk4_fp8(sp[16 * 33], sp[17 * 33], sp[18 * 33], sp[19 * 33]); o1.y = pk4_fp8(sp[20 * 33], sp[21 * 33], sp[22 * 33], sp[23 * 33]);
    o1.z = pk4_fp8(sp[24 * 33], sp[25 * 33], sp[26 * 33], sp[27 * 33]); o1.w = pk4_fp8(sp[28 * 33], sp[29 * 33], sp[30 * 33], sp[31 * 33]);
    unsigned char* dp = WT + (size_t)(n0 + n) * K + k0 + kh;
    __builtin_nontemporal_store(o0, (u32x4*)dp); __builtin_nontemporal_store(o1, (u32x4*)(dp + 16));
    asm volatile("s_waitcnt lgkmcnt(0)" ::: "memory");
}
DEV void convert_experts(const KArgs& a, int layer, unsigned char* lds) {
    const int tid = get_tid(), lane = tid & 63, wid = tid >> 6;
    float* scr = (float*)lds + wid * (64 * 33);
    const int gw = blockIdx.x * 4 + wid, ngw = gridDim.x * 4;
    for (int it = gw; it < NE * 3 * 256; it += ngw) {
        const int mat = it >> 8, sub = it & 255, e = mat / 3, which = mat % 3;
        if (which < 2) {
            const float* W = a.in[which == 0 ? I_W1 : I_W3] + ((size_t)layer * NE + e) * D * DE;
            unsigned char* WT = a.ws + (which == 0 ? WS_W1T : WS_W3T) + (size_t)e * DE * D;
            transpose_item8(W, D, DE, WT, scr, sub >> 4, sub & 15, lane);
        } else {
            const float* W = a.in[I_W2] + ((size_t)layer * NE + e) * DE * D;
            unsigned char* WT = a.ws + WS_W2T + (size_t)e * D * DE;
            transpose_item8(W, DE, D, WT, scr, sub >> 5, sub & 31, lane);
        }
    }
}
DEV void convert_shared(const KArgs& a, unsigned char* lds) {
    const int tid = get_tid(), lane = tid & 63, wid = tid >> 6;
    float* scr = (float*)lds + wid * (64 * 33);
    const int gw = blockIdx.x * 4 + wid, ngw = gridDim.x * 4;
    constexpr int I_IN = 16 * 81, I_OUT = 16 * 32;
    for (int it = gw; it < 2 * I_IN + 2 * I_OUT; it += ngw) {
        if (it < 2 * I_IN) { const int l = it / I_IN, sub = it % I_IN; transpose_item(a.in[I_WIN] + (size_t)l * D * DIN, D, DIN, (bf16_t*)(a.ws + WS_WINT) + (size_t)l * DIN * D, scr, sub / 81, sub % 81, lane); }
        else { const int r = it - 2 * I_IN, l = r / I_OUT, sub = r % I_OUT; transpose_item(a.in[I_WOUT] + (size_t)l * D * D, D, D, (bf16_t*)(a.ws + WS_WOUTT) + (size_t)l * D * D, scr, sub >> 5, sub & 31, lane); }
    }
    bf16_t* wrt = (bf16_t*)(a.ws + WS_WRT); bf16_t* wsp = (bf16_t*)(a.ws + WS_WSP);
    const int gt = blockIdx.x * 256 + tid, ngt = gridDim.x * 256;
    for (int i = gt; i < 2 * 128 * D; i += ngt) {
        const int l = i >> 17, n = (i >> 10) & 127, k = i & 1023;
        float v = 0.f;
        if (n < 8) v = a.in[I_WRG][((size_t)l * D + k) * 8 + n]; else if (n < 72) v = a.in[I_WRE][((size_t)l * D + k) * 64 + (n - 8)];
        wrt[i] = f2bf(v);
    }
    for (int i = gt; i < 2 * 4 * 128 * 128; i += ngt) wsp[i] = f2bf(a.in[I_WSP][i]);
}

DEV void glds16(const bf16_t* src, unsigned char* dst) { __builtin_amdgcn_global_load_lds((const unsigned*)src, (__attribute__((address_space(3))) unsigned*)dst, 16, 0, 0); }
template <class ARow, class BRow>
DEV void gemm_core(unsigned char* lds, int nk, ARow arow, BRow brow, f32x16 (&acc)[2][2]) {
    const int tid = get_tid(), lane = tid & 63, wid = tid >> 6, wr = wid >> 1, wc = wid & 1;
    const int srow = tid >> 3, sch = (tid & 7) ^ ((tid >> 4) & 7);
    const bf16_t* ap[4]; const bf16_t* bp[4];
#pragma unroll
    for (int i = 0; i < 4; ++i) { ap[i] = arow(i * 32 + srow) + sch * 8; bp[i] = brow(i * 32 + srow) + sch * 8; }
#pragma unroll
    for (int mi = 0; mi < 2; ++mi)
#pragma unroll
        for (int ni = 0; ni < 2; ++ni)
#pragma unroll
            for (int r = 0; r < 16; ++r) acc[mi][ni][r] = 0.f;
    unsigned char* dst = lds + __builtin_amdgcn_readfirstlane(tid & ~63) * 16;
    const int fr = lane & 31, fh = lane >> 5, g = (fr >> 1) & 7;
    const unsigned char* ra = lds + (wr * 64 + fr) * 128;
    const unsigned char* rb = lds + 16384 + (wc * 64 + fr) * 128;
#pragma unroll
    for (int i = 0; i < 4; ++i) { glds16(ap[i], dst + i * 4096); glds16(bp[i], dst + 16384 + i * 4096); }
    if (nk > 1) {
#pragma unroll
        for (int i = 0; i < 4; ++i) { glds16(ap[i] + 64, dst + 32768 + i * 4096); glds16(bp[i] + 64, dst + 32768 + 16384 + i * 4096); }
    }
    for (int kt = 0; kt < nk; ++kt) {
        const int cur = (kt & 1) * 32768;
        if (kt + 1 < nk) asm volatile("s_waitcnt vmcnt(8)" ::: "memory"); else asm volatile("s_waitcnt vmcnt(0)" ::: "memory");
        __builtin_amdgcn_s_barrier();
        asm volatile("" ::: "memory");
        bf16x8 af[4][2], bfr[4][2];
#pragma unroll
        for (int ks = 0; ks < 4; ++ks) {
            const int co = ((ks * 2 + fh) ^ g) << 4;
#pragma unroll
            for (int mi = 0; mi < 2; ++mi) af[ks][mi] = *(const bf16x8*)(ra + cur + mi * 4096 + co);
#pragma unroll
            for (int ni = 0; ni < 2; ++ni) bfr[ks][ni] = *(const bf16x8*)(rb + cur + ni * 4096 + co);
        }
        asm volatile("s_waitcnt lgkmcnt(0)" ::: "memory");
        __builtin_amdgcn_s_barrier();
        asm volatile("" ::: "memory");
        if (kt + 2 < nk) {
            const int ko = (kt + 2) * 64;
#pragma unroll
            for (int i = 0; i < 4; ++i) { glds16(ap[i] + ko, dst + cur + i * 4096); glds16(bp[i] + ko, dst + cur + 16384 + i * 4096); }
        }
#pragma unroll
        for (int ks = 0; ks < 4; ++ks)
#pragma unroll
            for (int mi = 0; mi < 2; ++mi)
#pragma unroll
                for (int ni = 0; ni < 2; ++ni) acc[mi][ni] = __builtin_amdgcn_mfma_f32_32x32x16_bf16(af[ks][mi], bfr[ks][ni], acc[mi][ni], 0, 0, 0);
    }
    __builtin_amdgcn_s_barrier();
    asm volatile("" ::: "memory");
}
template <bool FP8 = false, class Prep, class ARow, class Fetch, class BRow, class Pre, class Epi>
DEV void gemm_stream_x(unsigned char* lds, int nk, int t0, int tstep, int tend, Prep prep, ARow arow, Fetch fetch, BRow brow, Pre pre, Epi epi) {
    const int tid = get_tid(), lane = tid & 63, wid = tid >> 6, wr = wid >> 1, wc = wid & 1;
    const int srow = tid >> 3, sch = (tid & 7) ^ ((tid >> 4) & 7);
    if (t0 >= tend) return;
    auto cx = prep(t0);
    auto nx = cx;
    const bf16_t* ap[4]; const bf16_t* bp[4];
    unsigned raw[4];
#pragma unroll
    for (int i = 0; i < 4; ++i) raw[i] = fetch(cx, i * 32 + srow);
#pragma unroll
    for (int i = 0; i < 4; ++i) { ap[i] = arow(cx, i * 32 + srow) + sch * 8; bp[i] = brow(cx, i * 32 + srow, raw[i]) + sch * 8; }
    unsigned char* dst = lds + __builtin_amdgcn_readfirstlane(tid & ~63) * 16;
    const int fr = lane & 31, fh = lane >> 5, g = (fr >> 1) & 7;
    const unsigned char* ra = lds + (wr * 64 + fr) * 128;
    const unsigned char* rb = lds + 16384 + (wc * 64 + fr) * 128;
#pragma unroll
    for (int i = 0; i < 4; ++i) { glds16(ap[i], dst + i * 4096); glds16(bp[i], dst + 16384 + i * 4096); }
#pragma unroll
    for (int i = 0; i < 4; ++i) { glds16(ap[i] + 64, dst + 32768 + i * 4096); glds16(bp[i] + 64, dst + 32768 + 16384 + i * 4096); }
    for (int t = t0; t < tend; t += tstep) {
        const bool has_next = t + tstep < tend;
        const auto pv = pre(cx);
        if (has_next) {
            nx = prep(t + tstep);
#pragma unroll
            for (int i = 0; i < 4; ++i) raw[i] = fetch(nx, i * 32 + srow);
        }
        f32x16 acc[2][2];
#pragma unroll
        for (int mi = 0; mi < 2; ++mi)
#pragma unroll
            for (int ni = 0; ni < 2; ++ni)
#pragma unroll
                for (int r = 0; r < 16; ++r) acc[mi][ni][r] = 0.f;
        for (int kt = 0; kt < nk; ++kt) {
            const int cur = (kt & 1) * 32768;
            if (kt + 1 < nk || has_next) asm volatile("s_waitcnt vmcnt(8)" ::: "memory"); else asm volatile("s_waitcnt vmcnt(0)" ::: "memory");
            __builtin_amdgcn_s_barrier();
            asm volatile("" ::: "memory");
            bf16x8 af[4][2], bfr[4][2];
            i32x8 a8[2][2], b8[2][2];
            if (!FP8) {
#pragma unroll
            for (int ks = 0; ks < 4; ++ks) {
                const int co = ((ks * 2 + fh) ^ g) << 4;
#pragma unroll
                for (int mi = 0; mi < 2; ++mi) af[ks][mi] = *(const bf16x8*)(ra + cur + mi * 4096 + co);
#pragma unroll
                for (int ni = 0; ni < 2; ++ni) bfr[ks][ni] = *(const bf16x8*)(rb + cur + ni * 4096 + co);
            }
            } else {
#pragma unroll
            for (int m = 0; m < 2; ++m) {
                const int c0 = ((m * 4 + fh) ^ g) << 4, c1 = ((m * 4 + 2 + fh) ^ g) << 4;
#pragma unroll
                for (int mi = 0; mi < 2; ++mi) { a8[m][mi].lo = *(const i32x4*)(ra + cur + mi * 4096 + c0); a8[m][mi].hi = *(const i32x4*)(ra + cur + mi * 4096 + c1); }
#pragma unroll
                for (int ni = 0; ni < 2; ++ni) { b8[m][ni].lo = *(const i32x4*)(rb + cur + ni * 4096 + c0); b8[m][ni].hi = *(const i32x4*)(rb + cur + ni * 4096 + c1); }
            }
            }
            asm volatile("s_waitcnt lgkmcnt(0)" ::: "memory");
            __builtin_amdgcn_sched_barrier(0);
            __builtin_amdgcn_s_barrier();
            asm volatile("" ::: "memory");
            __builtin_amdgcn_sched_barrier(0);
            int ko = -1;
            if (kt + 2 < nk) ko = (kt + 2) * 64;
            else if (has_next) {
                if (kt + 2 == nk) {
#pragma unroll
                    for (int i = 0; i < 4; ++i) { ap[i] = arow(nx, i * 32 + srow) + sch * 8; bp[i] = brow(nx, i * 32 + srow, raw[i]) + sch * 8; }
                }
                ko = (kt + 2 - nk) * 64;
            }
            if (FP8) {
#pragma unroll
                for (int ks = 0; ks < 8; ++ks) {
                    if (ko >= 0) { if (ks & 1) glds16(bp[ks >> 1] + ko, dst + cur + 16384 + (ks >> 1) * 4096); else glds16(ap[ks >> 1] + ko, dst + cur + (ks >> 1) * 4096); }
                    const int m = ks >> 2, mi = (ks >> 1) & 1, ni = ks & 1;
                    acc[mi][ni] = __builtin_amdgcn_mfma_scale_f32_32x32x64_f8f6f4(a8[m][mi], b8[m][ni], acc[mi][ni], 0, 0, 0, 0x7f7f7f7f, 0, 0x7f7f7f7f);
                    __builtin_amdgcn_sched_barrier(0);
                }
                asm volatile("" : "+v"(acc[0][0]), "+v"(acc[0][1]), "+v"(acc[1][0]), "+v"(acc[1][1]));
            } else
#pragma unroll
            for (int ks = 0; ks < 4; ++ks) {
                if (ko >= 0) { glds16(ap[ks] + ko, dst + cur + ks * 4096); }
                acc[0][0] = __builtin_amdgcn_mfma_f32_32x32x16_bf16(af[ks][0], bfr[ks][0], acc[0][0], 0, 0, 0);
                acc[0][1] = __builtin_amdgcn_mfma_f32_32x32x16_bf16(af[ks][0], bfr[ks][1], acc[0][1], 0, 0, 0);
                __builtin_amdgcn_sched_barrier(0);
                if (ko >= 0) { glds16(bp[ks] + ko, dst + cur + 16384 + ks * 4096); }
                acc[1][0] = __builtin_amdgcn_mfma_f32_32x32x16_bf16(af[ks][1], bfr[ks][0], acc[1][0], 0, 0, 0);
                acc[1][1] = __builtin_amdgcn_mfma_f32_32x32x16_bf16(af[ks][1], bfr[ks][1], acc[1][1], 0, 0, 0);
                __builtin_amdgcn_sched_barrier(0);
            }
        }
        epi(cx, acc, pv);
        cx = nx;
    }
    __builtin_amdgcn_s_barrier();
    asm volatile("" ::: "memory");
}
template <bool FP8 = false, class Prep, class ARow, class BRow, class Epi>
DEV void gemm_stream(unsigned char* lds, int nk, int t0, int tstep, int tend, Prep prep, ARow arow, BRow brow, Epi epi) {
    gemm_stream_x<FP8>(lds, nk, t0, tstep, tend, prep, arow, [](const auto&, int) { return 0u; }, [&](const auto& cx, int r, unsigned) { return brow(cx, r); },
                       [](const auto&) { return 0; }, [&](const auto& cx, const f32x16 (&acc)[2][2], int) { epi(cx, acc); });
}
DEV int vblock() { const int G = gridDim.x, bx = blockIdx.x; return (G % 8 == 0) ? (bx % 8) * (G / 8) + bx / 8 : bx; }
#define ACC_FOREACH(mi, ni, r, row, col) \
    _Pragma("unroll") for (int mi = 0; mi < 2; ++mi) _Pragma("unroll") for (int ni = 0; ni < 2; ++ni) _Pragma("unroll") for (int r = 0; r < 16; ++r) \
        for (int row = (tid >> 7) * 64 + mi * 32 + (r & 3) + 8 * (r >> 2) + 4 * ((tid & 63) >> 5), col = ((tid >> 6) & 1) * 64 + ni * 32 + (tid & 31), once_ = 1; once_; once_ = 0)

template <class ARow, class Epi>
DEV void gemm_naive_tile(float* lds, int K, ARow arow, const float* W, int ldw, int col0, int ncols, Epi epi) {
    const int tid = get_tid(), ty = tid >> 4, tx = tid & 15;
    float* sA = lds;
    float* sB = lds + 16 * 68;
    const int ar = tid >> 2, kq = (tid & 3) * 4;
    const bf16_t* ap = arow(ar);
    const int kr = tid >> 4, c4 = (tid & 15) * 4;
    const bool cok = (col0 + c4) < ncols;
    float acc[4][4];
#pragma unroll
    for (int i = 0; i < 4; ++i)
#pragma unroll
        for (int j = 0; j < 4; ++j) acc[i][j] = 0.f;
    for (int k0 = 0; k0 < K; k0 += 16) {
        const u32x2 av = *(const u32x2*)(ap + k0 + kq);
        f32x4 wv = {0.f, 0.f, 0.f, 0.f};
        if (cok) wv = *(const f32x4*)(W + (size_t)(k0 + kr) * ldw + col0 + c4);
        sA[(kq + 0) * 68 + ar] = __uint_as_float(av.x << 16);
        sA[(kq + 1) * 68 + ar] = __uint_as_float(av.x & 0xffff0000u);
        sA[(kq + 2) * 68 + ar] = __uint_as_float(av.y << 16);
        sA[(kq + 3) * 68 + ar] = __uint_as_float(av.y & 0xffff0000u);
        *(f32x4*)(sB + kr * 64 + c4) = wv;
        __syncthreads();
#pragma unroll 4
        for (int k = 0; k < 16; ++k) {
            const f32x4 a4 = *(const f32x4*)(sA + k * 68 + ty * 4), b4 = *(const f32x4*)(sB + k * 64 + tx * 4);
            const float aa[4] = {a4.x, a4.y, a4.z, a4.w}, bb[4] = {b4.x, b4.y, b4.z, b4.w};
#pragma unroll
            for (int i = 0; i < 4; ++i)
#pragma unroll
                for (int j = 0; j < 4; ++j) acc[i][j] += aa[i] * bb[j];
        }
        __syncthreads();
    }
#pragma unroll
    for (int i = 0; i < 4; ++i)
#pragma unroll
        for (int j = 0; j < 4; ++j) { const int col = col0 + tx * 4 + j; if (col < ncols) epi(ty * 4 + i, col, acc[i][j]); }
}

DEV void ph_inproj(const KArgs& a, int layer, unsigned char* lds) {
    const int tid = get_tid();
    const bf16_t* hn = (const bf16_t*)(a.ws + WS_HN);
    bf16_t* z = (bf16_t*)(a.ws + WS_Z);
    const bf16_t* WT = (const bf16_t*)(a.ws + WS_WINT) + (size_t)layer * DIN * D;
    constexpr int ntn = (DIN + 127) / 128, nlat = (TL / 128) * ntn, ncn = ntn - OFF_BK / 128;
    const int ntiles = layer == 0 ? (TA / 128) * ntn : nlat + (TC / 128) * ncn;
    struct Cx { int row0, col0; };
    auto prep = [&](int t) { Cx c;
        if (layer == 0 || t < nlat) { c.row0 = (t / ntn) * 128; c.col0 = (t % ntn) * 128; }
        else { const int u = t - nlat; c.row0 = TL + (u / ncn) * 128; c.col0 = OFF_BK + (u % ncn) * 128; }
        return c; };
    gemm_stream(lds, D / 64, vblock(), gridDim.x, ntiles, prep,
        [&](const Cx& c, int r) { int n = c.col0 + r; n = n < DIN ? n : DIN - 1; return WT + (size_t)n * D; },
        [&](const Cx& c, int r) { return hn + (size_t)(c.row0 + r) * D; },
        [&](const Cx& c, const f32x16 (&acc)[2][2]) {
            const int row0 = c.row0, col0 = c.col0;
            const int wr = tid >> 7, wc = (tid >> 6) & 1, lane = tid & 63;
#pragma unroll
            for (int ni = 0; ni < 2; ++ni) {
                bf16_t* zr = z + (size_t)(row0 + wc * 64 + ni * 32 + (lane & 31)) * DIN + col0;
#pragma unroll
                for (int mi = 0; mi < 2; ++mi)
#pragma unroll
                    for (int kp = 0; kp < 2; ++kp) {
                        u32x2 wa, wb;
                        wa.x = pk2(acc[mi][ni][8 * kp], acc[mi][ni][8 * kp + 1]); wa.y = pk2(acc[mi][ni][8 * kp + 2], acc[mi][ni][8 * kp + 3]);
                        wb.x = pk2(acc[mi][ni][8 * kp + 4], acc[mi][ni][8 * kp + 5]); wb.y = pk2(acc[mi][ni][8 * kp + 6], acc[mi][ni][8 * kp + 7]);
                        const u32x4 w = widen_pair(wa, wb);
                        const int n = wr * 64 + mi * 32 + 16 * kp + 8 * (lane >> 5);
                        if (col0 + n < DIN) *(u32x4*)(zr + n) = w;
                    }
            }
        });
}

DEV void ph_outproj(const KArgs& a, int layer, int nrows, unsigned char* lds) {
    const int tid = get_tid();
    const bf16_t* mix = (const bf16_t*)(a.ws + WS_MIX);
    float* hws = (float*)(a.ws + WS_H);
    const float* mod = (const float*)(a.ws + WS_MOD);
    const bf16_t* WT = (const bf16_t*)(a.ws + WS_WOUTT) + (size_t)layer * D * D;
    constexpr int ntn = D / 128;
    gemm_stream(lds, D / 64, vblock(), gridDim.x, (nrows / 128) * ntn, [](int t) { return t; },
        [&](int t, int r) { return mix + (size_t)((t / ntn) * 128 + r) * D; },
        [&](int t, int r) { return WT + (size_t)((t % ntn) * 128 + r) * D; },
        [&](int t, const f32x16 (&acc)[2][2]) {
            const int row0 = (t / ntn) * 128, col0 = (t % ntn) * 128;
            const int bi = mod_index(row0);
            const float* g1 = mod + (size_t)(layer * 17 + bi) * 6144 + 2 * D + col0;
            const int wr = tid >> 7, wc = (tid >> 6) & 1, lane = tid & 63;
            const float g1a = g1[wc * 64 + (lane & 31)], g1b = g1[wc * 64 + 32 + (lane & 31)];
            const float* resb = (layer == 0 ? (row0 < TL ? a.in[I_X] + (size_t)row0 * D : a.in[I_CTX] + (size_t)(row0 - TL) * D) : hws + (size_t)row0 * D) + col0 + wc * 64 + (lane & 31);
            float* outb = hws + (size_t)row0 * D + col0 + wc * 64 + (lane & 31);
            float resc[8], resn[8];
#define OP_RO(b) ((size_t)(wr * 64 + ((b) >> 2) * 32 + 16 * ((b) & 1) + 4 * (lane >> 5)) * D + (((b) >> 1) & 1) * 32)
#pragma unroll
            for (int r = 0; r < 8; ++r) resc[r] = __builtin_nontemporal_load(resb + OP_RO(0) + (size_t)((r & 3) + 8 * (r >> 2)) * D);
#pragma unroll
            for (int b = 0; b < 8; ++b) {
                const int mi = b >> 2, ni = (b >> 1) & 1, hq = b & 1;
                if (b + 1 < 8) {
#pragma unroll
                    for (int r = 0; r < 8; ++r) resn[r] = __builtin_nontemporal_load(resb + OP_RO(b + 1) + (size_t)((r & 3) + 8 * (r >> 2)) * D);
                }
                asm volatile("" ::: "memory");
#pragma unroll
                for (int r = 0; r < 8; ++r) outb[OP_RO(b) + (size_t)((r & 3) + 8 * (r >> 2)) * D] = resc[r] + (ni ? g1b : g1a) * acc[mi][ni][8 * hq + r];
                asm volatile("" ::: "memory");
#pragma unroll
                for (int r = 0; r < 8; ++r) resc[r] = resn[r];
            }
#undef OP_RO
        });
}

DEV bf16x8 tr_frag_at(unsigned base, int RS, int c, int ks, int lane);
DEV void unpack8(const u32x4 v, float* f);
DEV void ph_spatial(const KArgs& a, int layer, int nrows, unsigned char* lds) {
    const int tid = get_tid(), lane = tid & 63, wid = tid >> 6, wr = wid >> 1, wc = wid & 1, fr = lane & 31, fh = lane >> 5;
    const bf16_t* z = (const bf16_t*)(a.ws + WS_Z);
    bf16_t* mix = (bf16_t*)(a.ws + WS_MIX);
    unsigned char* vs = lds;
    const unsigned vs_a = (unsigned)(size_t)vs;
    const int nitems = (nrows / 128) * 4;
    for (int item = vblock(); item < nitems; item += gridDim.x) {
        const int ci = item >> 2, g = item & 3, row0 = ci * 128;
        const int l8 = tid & 7, tk = tid >> 3;
        float lgv[16], lbv[16];
#pragma unroll
        for (int j = 0; j < 4; ++j) {
            const f32x4 g4 = *(const f32x4*)(a.in[I_LNG] + layer * 512 + g * 128 + l8 * 16 + 4 * j), b4 = *(const f32x4*)(a.in[I_LNB] + layer * 512 + g * 128 + l8 * 16 + 4 * j);
            lgv[4 * j] = g4.x; lgv[4 * j + 1] = g4.y; lgv[4 * j + 2] = g4.z; lgv[4 * j + 3] = g4.w; lbv[4 * j] = b4.x; lbv[4 * j + 1] = b4.y; lbv[4 * j + 2] = b4.z; lbv[4 * j + 3] = b4.w;
        }
#pragma unroll 2
        for (int pass = 0; pass < 4; ++pass) {
            const int tok = pass * 32 + tk;
            const bf16_t* zp = z + (size_t)(row0 + tok) * DIN + OFF_AV + g * 128 + l8 * 16;
            float x[16];
            unpack8(*(const u32x4*)zp, x); unpack8(*(const u32x4*)(zp + 8), x + 8);
            float sm = 0.f;
#pragma unroll
            for (int j = 0; j < 16; ++j) { x[j] = gelu_f(x[j]); sm += x[j]; }
            sm += __shfl_xor(sm, 1); sm += __shfl_xor(sm, 2); sm += __shfl_xor(sm, 4);
            const float mu = sm * (1.f / 128.f);
            float q = 0.f;
#pragma unroll
            for (int j = 0; j < 16; ++j) { x[j] -= mu; q += x[j] * x[j]; }
            q += __shfl_xor(q, 1); q += __shfl_xor(q, 2); q += __shfl_xor(q, 4);
            const float rs = rsqrtf(q * (1.f / 128.f) + EPS);
            u32x4 w0, w1;
            w0.x = pk2(x[0] * rs * lgv[0] + lbv[0], x[1] * rs * lgv[1] + lbv[1]); w0.y = pk2(x[2] * rs * lgv[2] + lbv[2], x[3] * rs * lgv[3] + lbv[3]);
            w0.z = pk2(x[4] * rs * lgv[4] + lbv[4], x[5] * rs * lgv[5] + lbv[5]); w0.w = pk2(x[6] * rs * lgv[6] + lbv[6], x[7] * rs * lgv[7] + lbv[7]);
            w1.x = pk2(x[8] * rs * lgv[8] + lbv[8], x[9] * rs * lgv[9] + lbv[9]); w1.y = pk2(x[10] * rs * lgv[10] + lbv[10], x[11] * rs * lgv[11] + lbv[11]);
            w1.z = pk2(x[12] * rs * lgv[12] + lbv[12], x[13] * rs * lgv[13] + lbv[13]); w1.w = pk2(x[14] * rs * lgv[14] + lbv[14], x[15] * rs * lgv[15] + lbv[15]);
            *(u32x4*)(vs + tok * 320 + l8 * 32) = w0; *(u32x4*)(vs + tok * 320 + l8 * 32 + 16) = w1;
        }
        __syncthreads();
        const bf16_t* wsp = (const bf16_t*)(a.ws + WS_WSP) + (size_t)(layer * 4 + g) * 128 * 128;
        f32x16 acc[2][2];
#pragma unroll
        for (int mi = 0; mi < 2; ++mi)
#pragma unroll
            for (int ni = 0; ni < 2; ++ni)
#pragma unroll
                for (int r = 0; r < 16; ++r) acc[mi][ni][r] = 0.f;
#pragma unroll 2
        for (int ks = 0; ks < 8; ++ks) {
            bf16x8 af[2], bfr[2];
#pragma unroll
            for (int mi = 0; mi < 2; ++mi) af[mi] = *(const bf16x8*)(wsp + (wr * 64 + mi * 32 + fr) * 128 + ks * 16 + fh * 8);
#pragma unroll
            for (int ni = 0; ni < 2; ++ni) bfr[ni] = tr_frag_at(vs_a, 320, wc * 2 + ni, ks, lane);
#pragma unroll
            for (int mi = 0; mi < 2; ++mi)
#pragma unroll
                for (int ni = 0; ni < 2; ++ni) acc[mi][ni] = __builtin_amdgcn_mfma_f32_32x32x16_bf16(af[mi], bfr[ni], acc[mi][ni], 0, 0, 0);
        }
        __syncthreads();
        ACC_FOREACH(mi, ni, r, row, col) { *(bf16_t*)(vs + row * 272 + col * 2) = f2bf(acc[mi][ni][r]); }
        __syncthreads();
        {
            const int p = tid >> 1, c0 = (tid & 1) * 64;
            const float bs = a.in[I_BSP][(layer * 4 + g) * 128 + p];
            const bf16_t* zu = z + (size_t)(row0 + p) * DIN + OFF_AU + g * 128 + c0;
            bf16_t* mo = mix + (size_t)(row0 + p) * D + g * 128 + c0;
            u32x4 zuv[8];
#pragma unroll
            for (int j = 0; j < 8; ++j) zuv[j] = *(const u32x4*)(zu + 8 * j);
#pragma unroll 2
            for (int j = 0; j < 8; ++j) {
                float uf[8], sf[8];
                unpack8(zuv[j], uf); unpack8(*(const u32x4*)(vs + p * 272 + (c0 + 8 * j) * 2), sf);
                u32x4 w;
                w.x = pk2(gelu_f(uf[0]) * (sf[0] + bs), gelu_f(uf[1]) * (sf[1] + bs)); w.y = pk2(gelu_f(uf[2]) * (sf[2] + bs), gelu_f(uf[3]) * (sf[3] + bs));
                w.z = pk2(gelu_f(uf[4]) * (sf[4] + bs), gelu_f(uf[5]) * (sf[5] + bs)); w.w = pk2(gelu_f(uf[6]) * (sf[6] + bs), gelu_f(uf[7]) * (sf[7] + bs));
                *(u32x4*)(mo + 8 * j) = w;
            }
        }
        __syncthreads();
    }
}

constexpr int GLA_LA_STRIDE = 65, GLA_VT_RS = 320, GLA_KD_RS = 192, GLA_QK_RS = 144;
constexpr int GLA_OFF_LA = 0, GLA_OFF_QE = 16896, GLA_OFF_KE = 16896 + 9216, GLA_OFF_VT = 16896 + 2 * 9216, GLA_OFF_WU = GLA_OFF_VT + 64 * GLA_VT_RS, GLA_OFF_TOT = GLA_OFF_WU + 2 * 4352, GLA_OFF_END = GLA_OFF_TOT + 1280;
static_assert(64 * GLA_LA_STRIDE * 4 <= GLA_OFF_QE && GLA_OFF_END <= 65536 + 768 && 64 * 132 * 4 <= GLA_OFF_VT && 64 * GLA_KD_RS <= 2 * 9216, "GLA LDS map");
DEV void gla_chunk_coords(int ci, int& row0, int& b, int& slot) {
    if (ci < 512) { row0 = ci * 64; b = ci >> 5; slot = 4 + (ci & 31); } else { const int c = ci - 512; row0 = TL + c * 64; b = c >> 2; slot = c & 3; }
}
DEV bf16x8 tr_frag(unsigned a0, unsigned a1) {
    u32x2 lo, hi;
    asm volatile("ds_read_b64_tr_b16 %0, %2\n\tds_read_b64_tr_b16 %1, %3\n\ts_waitcnt lgkmcnt(0)" : "=&v"(lo), "=&v"(hi) : "v"(a0), "v"(a1) : "memory");
    u32x4 w; w.x = lo.x; w.y = lo.y; w.z = hi.x; w.w = hi.y;
    return __builtin_bit_cast(bf16x8, w);
}
DEV bf16x8 tr_frag_at(unsigned base, int RS, int c, int ks, int lane) {
    const int h = lane >> 5, blk = (lane >> 4) & 1, q = (lane & 15) >> 2, p = lane & 3;
    const unsigned a0 = base + (unsigned)((16 * ks + 8 * h + q) * RS + (32 * c + 16 * blk + 4 * p) * 2);
    return tr_frag(a0, a0 + 4u * (unsigned)RS);
}
DEV void unpack8(const u32x4 v, float* f) {
    f[0] = __uint_as_float(v.x << 16); f[1] = __uint_as_float(v.x & 0xffff0000u); f[2] = __uint_as_float(v.y << 16); f[3] = __uint_as_float(v.y & 0xffff0000u);
    f[4] = __uint_as_float(v.z << 16); f[5] = __uint_as_float(v.z & 0xffff0000u); f[6] = __uint_as_float(v.w << 16); f[7] = __uint_as_float(v.w & 0xffff0000u);
}
DEV void gla_stage_gate(const KArgs& a, int layer, int dir, int h, float* swu, int tid) {
    bf16_t* hi = (bf16_t*)swu; bf16_t* lo = hi + 1024; float* bias = swu + 1024;
    for (int i = tid; i < 16 * 64; i += 256) {
        const int k = i >> 6, d = i & 63;
        const float w = a.in[I_WGU][((size_t)(layer * 2 + dir) * 16 + k) * 256 + h * 64 + d];
        const bf16_t wh = f2bf(w);
        hi[d * 16 + k] = wh; lo[d * 16 + k] = f2bf(w - bf2f(wh));
    }
    if (tid < 64) bias[tid] = a.in[I_BG][(layer * 2 + dir) * 256 + h * 64 + tid];
}
DEV void gla_logdecay(const bf16x8 zfrag, const float* swu, float* la, int tid) {
    const int lane = tid & 63, wid = tid >> 6, fr = lane & 31, fh = lane >> 5, dt = (wid & 1) * 32, tt = (wid >> 1) * 32;
    const bf16_t* hi = (const bf16_t*)swu; const bf16_t* lo = hi + 1024; const float* bias = swu + 1024;
    const bf16x8 bh = *(const bf16x8*)(hi + (dt + fr) * 16 + fh * 8), bl = *(const bf16x8*)(lo + (dt + fr) * 16 + fh * 8);
    f32x16 acc;
#pragma unroll
    for (int r = 0; r < 16; ++r) acc[r] = 0.f;
    acc = __builtin_amdgcn_mfma_f32_32x32x16_bf16(zfrag, bl, acc, 0, 0, 0);
    acc = __builtin_amdgcn_mfma_f32_32x32x16_bf16(zfrag, bh, acc, 0, 0, 0);
    const float bb = bias[dt + fr];
#pragma unroll
    for (int r = 0; r < 16; ++r) la[(tt + (r & 3) + 8 * (r >> 2) + 4 * fh) * GLA_LA_STRIDE + dt + fr] = logsigmoid_f(acc[r] + bb) * (1.f / 16.f);
}
DEV void gla_cumsum(float* la, float* tot, int dir, int tid) {
    const int d = tid & 63, sg = tid >> 6;
    float v[16];
#pragma unroll
    for (int t = 0; t < 16; ++t) v[t] = la[(sg * 16 + t) * GLA_LA_STRIDE + d];
    if (dir == 0) {
#pragma unroll
        for (int t = 1; t < 16; ++t) v[t] += v[t - 1];
        tot[sg * 64 + d] = v[15];
    } else {
#pragma unroll
        for (int t = 14; t >= 0; --t) v[t] += v[t + 1];
        tot[sg * 64 + d] = v[0];
    }
    __syncthreads();
    const float t0 = tot[d], t1 = tot[64 + d], t2 = tot[128 + d], t3 = tot[192 + d];
    float off;
    if (dir == 0) off = (sg > 0 ? t0 : 0.f) + (sg > 1 ? t1 : 0.f) + (sg > 2 ? t2 : 0.f);
    else off = (sg < 3 ? t3 : 0.f) + (sg < 2 ? t2 : 0.f) + (sg < 1 ? t1 : 0.f);
    if (sg == 0) tot[256 + d] = (t0 + t1) + (t2 + t3);
#pragma unroll
    for (int t = 0; t < 16; ++t) la[(sg * 16 + t) * GLA_LA_STRIDE + d] = v[t] + off;
    __syncthreads();
}
DEV void gla_store_v(const u32x4 (&vr)[4], unsigned char* vt, int tid) {
    const int i = tid >> 2, e0 = (tid & 3) * 32;
#pragma unroll
    for (int j = 0; j < 4; ++j) *(u32x4*)(vt + i * GLA_VT_RS + (e0 + 8 * j) * 2) = vr[j];
}

DEV void ph_gla_kv(const KArgs& a, int layer, unsigned char* lds) {
    const int tid = get_tid(), lane = tid & 63, wid = tid >> 6;
    const bf16_t* z = (const bf16_t*)(a.ws + WS_Z);
    bf16_t* kvo = (bf16_t*)(a.ws + WS_KV);
    float* dco = (float*)(a.ws + WS_DECAY);
    float* la = (float*)(lds + GLA_OFF_LA); unsigned char* kdt = lds + GLA_OFF_QE; unsigned char* vt = lds + GLA_OFF_VT;
    float* swu = (float*)(lds + GLA_OFF_WU); float* tot = (float*)(lds + GLA_OFF_TOT);
    const unsigned vt_a = (unsigned)(size_t)vt, kd_a = (unsigned)(size_t)kdt;
    const int vb = vblock(), h = vb & 3;
    gla_stage_gate(a, layer, 0, h, swu, tid); gla_stage_gate(a, layer, 1, h, swu + 1088, tid);
    __syncthreads();
    const int i = tid >> 2, d0 = (tid & 3) * 16, e0 = (tid & 3) * 32;
    for (int item = vb; item < 576 * 4; item += gridDim.x) {
        const int ci = item >> 2;
        int row0, b, slot; gla_chunk_coords(ci, row0, b, slot);
        const bf16_t* zr = z + (size_t)(row0 + i) * DIN;
        const bf16_t* zgp = z + (size_t)(row0 + (wid >> 1) * 32 + (lane & 31)) * DIN + OFF_BG + (lane >> 5) * 8;
        const bf16x8 zf0 = *(const bf16x8*)zgp, zf1 = *(const bf16x8*)(zgp + 16);
        const u32x4 kr0 = *(const u32x4*)(zr + OFF_BK + h * 64 + d0), kr1 = *(const u32x4*)(zr + OFF_BK + h * 64 + d0 + 8);
        u32x4 vr[4];
#pragma unroll
        for (int j = 0; j < 4; ++j) vr[j] = *(const u32x4*)(zr + OFF_BV + h * 128 + e0 + 8 * j);
        gla_store_v(vr, vt, tid);
#pragma unroll 1
        for (int dir = 0; dir < 2; ++dir) {
            gla_logdecay(dir ? zf1 : zf0, swu + dir * 1088, la, tid);
            __syncthreads();
            gla_cumsum(la, tot, dir, tid);
            const size_t tile = (size_t)(((dir * NB + b) * 4 + h) * 36 + slot);
            {
                float kf[16];
                unpack8(kr0, kf); unpack8(kr1, kf + 8);
#pragma unroll
                for (int dd = 0; dd < 16; ++dd) kf[dd] *= __expf(tot[256 + d0 + dd] - la[i * GLA_LA_STRIDE + d0 + dd]);
                u32x4 w0, w1;
                w0.x = pk2(kf[0], kf[1]); w0.y = pk2(kf[2], kf[3]); w0.z = pk2(kf[4], kf[5]); w0.w = pk2(kf[6], kf[7]);
                w1.x = pk2(kf[8], kf[9]); w1.y = pk2(kf[10], kf[11]); w1.z = pk2(kf[12], kf[13]); w1.w = pk2(kf[14], kf[15]);
                *(u32x4*)(kdt + i * GLA_KD_RS + d0 * 2) = w0; *(u32x4*)(kdt + i * GLA_KD_RS + d0 * 2 + 16) = w1;
                if (tid < 64) dco[tile * 64 + tid] = __expf(tot[256 + tid]);
            }
            __syncthreads();
            f32x16 acc[2];
#pragma unroll
            for (int nt = 0; nt < 2; ++nt)
#pragma unroll
                for (int r = 0; r < 16; ++r) acc[nt][r] = 0.f;
#pragma unroll
            for (int ks = 0; ks < 4; ++ks) {
                const bf16x8 af = tr_frag_at(vt_a, GLA_VT_RS, wid, ks, lane);
#pragma unroll
                for (int nt = 0; nt < 2; ++nt) { const bf16x8 bfr = tr_frag_at(kd_a, GLA_KD_RS, nt, ks, lane); acc[nt] = __builtin_amdgcn_mfma_f32_32x32x16_bf16(af, bfr, acc[nt], 0, 0, 0); }
            }
            bf16_t* out = kvo + tile * 8192;
#pragma unroll
            for (int nt = 0; nt < 2; ++nt)
#pragma unroll
                for (int r = 0; r < 16; ++r) { const int e = wid * 32 + (r & 3) + 8 * (r >> 2) + 4 * (lane >> 5); out[e * 64 + nt * 32 + (lane & 31)] = f2bf(acc[nt][r]); }
            __syncthreads();
        }
    }
}

DEV void ph_gla_scan(const KArgs& a) {
    const int tid = get_tid();
    const bf16_t* kv = (const bf16_t*)(a.ws + WS_KV);
    const float* dc = (const float*)(a.ws + WS_DECAY);
    bf16_t* sp = (bf16_t*)(a.ws + WS_HN);
    for (int item = blockIdx.x; item < 2 * NB * 4 * 8; item += gridDim.x) {
        const int dbh = item >> 3, sub = item & 7, dir = dbh >> 6;
        const int e = sub * 16 + (tid >> 4), dq = (tid & 15) * 4;
        f32x4 S = {0.f, 0.f, 0.f, 0.f};
#pragma unroll 1
        for (int s0 = 0; s0 < 36; s0 += 12) {
            u32x2 kvr[12]; f32x4 dcv[12];
#pragma unroll
            for (int q = 0; q < 12; ++q) {
                const int step = s0 + q, slot = dir == 0 ? step : (step < 4 ? 3 - step : 39 - step);
                const size_t tile = (size_t)dbh * 36 + slot;
                kvr[q] = __builtin_nontemporal_load((const u32x2*)(kv + tile * 8192 + e * 64 + dq)); dcv[q] = *(const f32x4*)(dc + tile * 64 + dq);
            }
#pragma unroll
            for (int q = 0; q < 12; ++q) {
                const int step = s0 + q, slot = dir == 0 ? step : (step < 4 ? 3 - step : 39 - step);
                const size_t tile = (size_t)dbh * 36 + slot;
                const f32x4 kvv = {__uint_as_float(kvr[q].x << 16), __uint_as_float(kvr[q].x & 0xffff0000u), __uint_as_float(kvr[q].y << 16), __uint_as_float(kvr[q].y & 0xffff0000u)};
                u32x2 w; w.x = pk2(S.x, S.y); w.y = pk2(S.z, S.w);
                *(u32x2*)(sp + tile * 8192 + e * 64 + dq) = w;
                S = dcv[q] * S + kvv;
            }
        }
    }
}

DEV void ph_gla_out(const KArgs& a, int layer, unsigned char* lds) {
    const int tid = get_tid(), lane = tid & 63, wid = tid >> 6, ih = wid >> 1, eh = wid & 1, fr = lane & 31, fh = lane >> 5;
    const bf16_t* z = (const bf16_t*)(a.ws + WS_Z);
    const bf16_t* sp = (const bf16_t*)(a.ws + WS_HN);
    bf16_t* mix = (bf16_t*)(a.ws + WS_MIX);
    float* la = (float*)(lds + GLA_OFF_LA); unsigned char* att = lds + GLA_OFF_LA; unsigned char* qet = lds + GLA_OFF_QE; unsigned char* ket = lds + GLA_OFF_KE; unsigned char* vt = lds + GLA_OFF_VT;
    float* swu = (float*)(lds + GLA_OFF_WU); float* tot = (float*)(lds + GLA_OFF_TOT); float* ob = (float*)lds;
    const unsigned vt_a = (unsigned)(size_t)vt;
    const int nchunks = layer == 0 ? 576 : 512;
    const int vb = vblock(), h = vb & 3;
    gla_stage_gate(a, layer, 0, h, swu, tid); gla_stage_gate(a, layer, 1, h, swu + 1088, tid);
    __syncthreads();
    const int i = tid >> 2, d0 = (tid & 3) * 16, e0 = (tid & 3) * 32;
    for (int item = vb; item < nchunks * 4; item += gridDim.x) {
        const int ci = item >> 2;
        int row0, b, slot; gla_chunk_coords(ci, row0, b, slot);
        const bf16_t* zr = z + (size_t)(row0 + i) * DIN;
        const bf16_t* zgp = z + (size_t)(row0 + (wid >> 1) * 32 + (lane & 31)) * DIN + OFF_BG + (lane >> 5) * 8;
        const bf16x8 zf0 = *(const bf16x8*)zgp, zf1 = *(const bf16x8*)(zgp + 16);
        const u32x4 qr0 = *(const u32x4*)(zr + OFF_BQ + h * 64 + d0), qr1 = *(const u32x4*)(zr + OFF_BQ + h * 64 + d0 + 8);
        const u32x4 kr0 = *(const u32x4*)(zr + OFF_BK + h * 64 + d0), kr1 = *(const u32x4*)(zr + OFF_BK + h * 64 + d0 + 8);
        u32x4 vr[4], rr4[4];
#pragma unroll
        for (int j = 0; j < 4; ++j) vr[j] = *(const u32x4*)(zr + OFF_BV + h * 128 + e0 + 8 * j);
#pragma unroll
        for (int j = 0; j < 4; ++j) rr4[j] = *(const u32x4*)(zr + OFF_BR + h * 128 + e0 + 8 * j);
        gla_store_v(vr, vt, tid);
        f32x16 acc[2];
#pragma unroll
        for (int nt = 0; nt < 2; ++nt)
#pragma unroll
            for (int r = 0; r < 16; ++r) acc[nt][r] = 0.f;
#pragma unroll 1
        for (int dir = 0; dir < 2; ++dir) {
            gla_logdecay(dir ? zf1 : zf0, swu + dir * 1088, la, tid);
            __syncthreads();
            gla_cumsum(la, tot, dir, tid);
            {
                float qf[16], kf[16];
                unpack8(qr0, qf); unpack8(qr1, qf + 8); unpack8(kr0, kf); unpack8(kr1, kf + 8);
#pragma unroll
                for (int dd = 0; dd < 16; ++dd) { const float bb = la[i * GLA_LA_STRIDE + d0 + dd]; qf[dd] *= 0.125f * __expf(bb); kf[dd] *= __expf(-bb); }
                u32x4 w0, w1;
                w0.x = pk2(qf[0], qf[1]); w0.y = pk2(qf[2], qf[3]); w0.z = pk2(qf[4], qf[5]); w0.w = pk2(qf[6], qf[7]);
                w1.x = pk2(qf[8], qf[9]); w1.y = pk2(qf[10], qf[11]); w1.z = pk2(qf[12], qf[13]); w1.w = pk2(qf[14], qf[15]);
                *(u32x4*)(qet + i * GLA_QK_RS + d0 * 2) = w0; *(u32x4*)(qet + i * GLA_QK_RS + d0 * 2 + 16) = w1;
                w0.x = pk2(kf[0], kf[1]); w0.y = pk2(kf[2], kf[3]); w0.z = pk2(kf[4], kf[5]); w0.w = pk2(kf[6], kf[7]);
                w1.x = pk2(kf[8], kf[9]); w1.y = pk2(kf[10], kf[11]); w1.z = pk2(kf[12], kf[13]); w1.w = pk2(kf[14], kf[15]);
                *(u32x4*)(ket + i * GLA_QK_RS + d0 * 2) = w0; *(u32x4*)(ket + i * GLA_QK_RS + d0 * 2 + 16) = w1;
            }
            const bf16_t* st = sp + (size_t)(((dir * NB + b) * 4 + h) * 36 + slot) * 8192;
            bf16x8 bs[4][2];
#pragma unroll
            for (int ks = 0; ks < 4; ++ks)
#pragma unroll
                for (int nt = 0; nt < 2; ++nt) bs[ks][nt] = *(const bf16x8*)(st + (eh * 64 + nt * 32 + fr) * 64 + ks * 16 + fh * 8);
            __syncthreads();
            bf16x8 aq[4];
#pragma unroll
            for (int ks = 0; ks < 4; ++ks) aq[ks] = *(const bf16x8*)(qet + (ih * 32 + fr) * GLA_QK_RS + (ks * 16 + fh * 8) * 2);
            {
                f32x16 sa;
#pragma unroll
                for (int r = 0; r < 16; ++r) sa[r] = 0.f;
#pragma unroll
                for (int ks = 0; ks < 4; ++ks) { const bf16x8 bk = *(const bf16x8*)(ket + (eh * 32 + fr) * GLA_QK_RS + (ks * 16 + fh * 8) * 2); sa = __builtin_amdgcn_mfma_f32_32x32x16_bf16(aq[ks], bk, sa, 0, 0, 0); }
                const int j = eh * 32 + fr;
#pragma unroll
                for (int r = 0; r < 16; ++r) {
                    const int ii = ih * 32 + (r & 3) + 8 * (r >> 2) + 4 * fh;
                    const bool keep = dir == 0 ? (j <= ii) : (j >= ii);
                    *(bf16_t*)(att + ii * GLA_QK_RS + j * 2) = f2bf(keep ? sa[r] : 0.f);
                }
            }
            __syncthreads();
#pragma unroll
            for (int ks = 0; ks < 4; ++ks) {
                const bf16x8 aa = *(const bf16x8*)(att + (ih * 32 + fr) * GLA_QK_RS + (ks * 16 + fh * 8) * 2);
#pragma unroll
                for (int nt = 0; nt < 2; ++nt) {
                    const bf16x8 bv = tr_frag_at(vt_a, GLA_VT_RS, eh * 2 + nt, ks, lane);
                    acc[nt] = __builtin_amdgcn_mfma_f32_32x32x16_bf16(aa, bv, acc[nt], 0, 0, 0);
                    acc[nt] = __builtin_amdgcn_mfma_f32_32x32x16_bf16(aq[ks], bs[ks][nt], acc[nt], 0, 0, 0);
                }
            }
            __syncthreads();
        }
#pragma unroll
        for (int nt = 0; nt < 2; ++nt)
#pragma unroll
            for (int r = 0; r < 16; ++r) ob[(ih * 32 + (r & 3) + 8 * (r >> 2) + 4 * fh) * 132 + eh * 64 + nt * 32 + fr] = acc[nt][r];
        __syncthreads();
        {
            float o[32]; float ss = 0.f;
#pragma unroll
            for (int j = 0; j < 8; ++j) { const f32x4 v = *(const f32x4*)(ob + i * 132 + e0 + 4 * j); o[4 * j] = v.x; o[4 * j + 1] = v.y; o[4 * j + 2] = v.z; o[4 * j + 3] = v.w; ss += v.x * v.x + v.y * v.y + v.z * v.z + v.w * v.w; }
            ss += __shfl_xor(ss, 1); ss += __shfl_xor(ss, 2);
            const float rstd = rsqrtf(ss * (1.f / 128.f) + EPS);
            const float* gg = a.in[I_GGLA] + layer * 512 + h * 128 + e0;
            bf16_t* mo = mix + (size_t)(row0 + i) * D + 512 + h * 128 + e0;
#pragma unroll
            for (int j = 0; j < 4; ++j) {
                float rf[8]; unpack8(rr4[j], rf);
                const f32x4 g0 = *(const f32x4*)(gg + 8 * j), g1 = *(const f32x4*)(gg + 8 * j + 4);
                u32x4 w;
                w.x = pk2(o[8 * j + 0] * rstd * g0.x * silu_f(rf[0]), o[8 * j + 1] * rstd * g0.y * silu_f(rf[1]));
                w.y = pk2(o[8 * j + 2] * rstd * g0.z * silu_f(rf[2]), o[8 * j + 3] * rstd * g0.w * silu_f(rf[3]));
                w.z = pk2(o[8 * j + 4] * rstd * g1.x * silu_f(rf[4]), o[8 * j + 5] * rstd * g1.y * silu_f(rf[5]));
                w.w = pk2(o[8 * j + 6] * rstd * g1.z * silu_f(rf[6]), o[8 * j + 7] * rstd * g1.w * silu_f(rf[7]));
                *(u32x4*)(mo + 8 * j) = w;
            }
        }
        __syncthreads();
    }
}

DEV void ph_router(const KArgs& a, int layer, int nrows, unsigned char* lds) {
    const int tid = get_tid();
    const bf16_t* hn = (const bf16_t*)(a.ws + WS_HN);
    const bf16_t* WT = (const bf16_t*)(a.ws + WS_WRT) + (size_t)layer * 128 * D;
    unsigned* cnt = (unsigned*)(a.ws + WS_CTL) + layer * NE;
    u32x2* list = (u32x2*)(a.ws + WS_LIST);
    float* lgs = (float*)lds;
    int* s_cnt = (int*)(lds + 49152);
    for (int t = vblock(); t < nrows / 128; t += gridDim.x) {
        const int row0 = t * 128;
        f32x16 acc[2][2];
        gemm_core(lds, D / 64, [&](int r) { return hn + (size_t)(row0 + r) * D; }, [&](int r) { return WT + (size_t)r * D; }, acc);
        ACC_FOREACH(mi, ni, r, row, col) { if (col < 72) lgs[row * 73 + col] = acc[mi][ni][r]; }
        if (tid < 64) s_cnt[tid] = 0;
        __syncthreads();
        int ex1 = 0, ex2 = 0, lp1 = 0, lp2 = 0; float gt1 = 0.f, gt2 = 0.f;
        if (tid < 128) {
            const float* lr = lgs + tid * 73;
            float lg[8];
#pragma unroll
            for (int j = 0; j < 8; ++j) lg[j] = lr[j] + a.in[I_BRG][layer * 8 + j];
            float m = lg[0]; int gi = 0;
#pragma unroll
            for (int j = 1; j < 8; ++j) if (lg[j] > m) { m = lg[j]; gi = j; }
            float sum = 0.f;
#pragma unroll
            for (int j = 0; j < 8; ++j) sum += __expf(lg[j] - m);
            const float ptop = 1.f / sum;
            float le[8];
#pragma unroll
            for (int j = 0; j < 8; ++j) le[j] = lr[8 + gi * 8 + j] + a.in[I_BRE][layer * 64 + gi * 8 + j];
            float l1 = le[0]; int i1 = 0;
#pragma unroll
            for (int j = 1; j < 8; ++j) if (le[j] > l1) { l1 = le[j]; i1 = j; }
            float l2 = -3.0e38f; int i2 = 0;
#pragma unroll
            for (int j = 0; j < 8; ++j) if (j != i1 && le[j] > l2) { l2 = le[j]; i2 = j; }
            const float e2 = __expf(l2 - l1), w1 = 1.f / (1.f + e2), w2 = e2 / (1.f + e2);
            ex1 = gi * 8 + i1; ex2 = gi * 8 + i2; gt1 = ptop * w1; gt2 = ptop * w2;
            lp1 = atomicAdd(&s_cnt[ex1], 1); lp2 = atomicAdd(&s_cnt[ex2], 1);
        }
        __syncthreads();
        if (tid < 64) { const int c = s_cnt[tid]; s_cnt[64 + tid] = c ? (int)atomicAdd(cnt + tid, (unsigned)c) : 0; }
        __syncthreads();
        if (tid < 128) {
            const int r = row0 + tid;
            const unsigned p1 = (unsigned)(s_cnt[64 + ex1] + lp1), p2 = (unsigned)(s_cnt[64 + ex2] + lp2);
            u32x2 e1v, e2v; e1v.x = (unsigned)(2 * r); e1v.y = __float_as_uint(gt1); e2v.x = (unsigned)(2 * r + 1); e2v.y = __float_as_uint(gt2);
            list[(size_t)ex1 * LCAP + p1] = e1v; list[(size_t)ex2 * LCAP + p2] = e2v;
        }
        __syncthreads();
    }
}

DEV void ph_moe(const KArgs& a, int layer, int sub, unsigned char* lds) {
    const int tid = get_tid();
    const unsigned* cnt = (const unsigned*)(a.ws + WS_CTL) + layer * NE;
    const u32x2* list = (const u32x2*)(a.ws + WS_LIST);
    bf16_t* ys = (bf16_t*)(a.ws + WS_KV);
    int (*s_off)[80] = (int (*)[80])(lds + 65536);
    constexpr int ntn = 8;
    if (tid < NE) s_off[0][tid] = (int)cnt[tid];
    __syncthreads();
    if (tid == 0) { int o = 0, t = 0; for (int e = 0; e < NE; ++e) { const int c = s_off[0][e]; s_off[0][e] = o; s_off[1][e] = t; o += c; t += ((c + 127) / 128) * ntn; } s_off[0][NE] = o; s_off[1][NE] = t; }
    __syncthreads();
    const int ntiles = s_off[1][NE];
    struct Cx { int e, p0, nt, c, ro; };
    auto prep = [&](int t) { Cx x; int e = 0;
#pragma unroll
        for (int st = 32; st >= 1; st >>= 1) if (s_off[1][e + st] <= t) e += st;
        const int local = t - s_off[1][e]; x.e = e; x.p0 = (local / ntn) * 128; x.nt = local % ntn; x.ro = s_off[0][e]; x.c = s_off[0][e + 1] - x.ro;
        return x; };
    const int wr = tid >> 7, wc = (tid >> 6) & 1, lane = tid & 63;
    const unsigned char* hn8 = a.ws + WS_HN8;
    unsigned char* H8 = a.ws + WS_Z;
    if (sub == 0) {
        gemm_stream_x<true>(lds, D / 128, vblock(), gridDim.x, ntiles, prep,
            [&](const Cx& x, int r) { const int n = x.nt * 64 + (r >> 6) * 32 + (r & 31);
                                return (const bf16_t*)(a.ws + ((r >> 5) & 1 ? WS_W3T : WS_W1T) + ((size_t)x.e * DE + n) * D); },
            [&](const Cx& x, int r) { const int p = x.p0 + r; return list[(size_t)x.e * LCAP + (p < x.c ? p : 0)].x; },
            [&](const Cx& x, int r, unsigned slot) { return (const bf16_t*)(hn8 + (size_t)(slot >> 1) * D); },
            [](const Cx&) { return 0; },
            [&](const Cx& x, const f32x16 (&acc)[2][2], int) {
                const int p0 = x.p0, nt = x.nt, c = x.c, ro = x.ro;
#pragma unroll
                for (int ni = 0; ni < 2; ++ni) {
                    const int p = p0 + wc * 64 + ni * 32 + (lane & 31);
                    unsigned char* hr = H8 + (size_t)(ro + (p < c ? p : 0)) * DE + nt * 64 + wr * 32 + 8 * (lane >> 5);
#pragma unroll
                    for (int kp = 0; kp < 2; ++kp) {
                        float hv[8];
#pragma unroll
                        for (int q = 0; q < 8; ++q) hv[q] = silu_f(acc[0][ni][8 * kp + q] * W8_INV) * (acc[1][ni][8 * kp + q] * W8_INV);
                        const unsigned wa = pk4_fp8(hv[0], hv[1], hv[2], hv[3]), wb = pk4_fp8(hv[4], hv[5], hv[6], hv[7]);
                        auto rsw = __builtin_amdgcn_permlane32_swap(wa, wb, false, false);
                        u32x2 w; w.x = rsw[0]; w.y = rsw[1];
                        if (p < c) *(u32x2*)(hr + 16 * kp) = w;
                    }
                }
            });
    } else {
        struct Pv { u32x2 e[2]; };
        gemm_stream_x<true>(lds, DE / 128, vblock(), gridDim.x, ntiles, prep,
            [&](const Cx& x, int r) { return (const bf16_t*)(a.ws + WS_W2T + ((size_t)x.e * D + x.nt * 128 + r) * DE); },
            [](const Cx&, int) { return 0u; },
            [&](const Cx& x, int r, unsigned) { const int p = x.p0 + r; return (const bf16_t*)(H8 + (size_t)(x.ro + (p < x.c ? p : 0)) * DE); },
            [&](const Cx& x) { Pv v;
#pragma unroll
                for (int ni = 0; ni < 2; ++ni) { const int p = x.p0 + wc * 64 + ni * 32 + (lane & 31); v.e[ni] = list[(size_t)x.e * LCAP + (p < x.c ? p : 0)]; }
                return v; },
            [&](const Cx& x, const f32x16 (&acc)[2][2], const Pv& pv) {
                const int p0 = x.p0, nt = x.nt, c = x.c;
#pragma unroll
                for (int ni = 0; ni < 2; ++ni) {
                    const int p = p0 + wc * 64 + ni * 32 + (lane & 31);
                    const unsigned slot = pv.e[ni].x; const float gt = __uint_as_float(pv.e[ni].y) * (W8_INV * YS_SCALE);
                    unsigned char* yo = (unsigned char*)ys + (size_t)slot * D + nt * 128 + wr * 64 + 8 * (lane >> 5);
#pragma unroll
                    for (int mi = 0; mi < 2; ++mi)
#pragma unroll
                        for (int kp = 0; kp < 2; ++kp) {
                            const unsigned wa = pk4_fp8(gt * acc[mi][ni][8 * kp], gt * acc[mi][ni][8 * kp + 1], gt * acc[mi][ni][8 * kp + 2], gt * acc[mi][ni][8 * kp + 3]);
                            const unsigned wb = pk4_fp8(gt * acc[mi][ni][8 * kp + 4], gt * acc[mi][ni][8 * kp + 5], gt * acc[mi][ni][8 * kp + 6], gt * acc[mi][ni][8 * kp + 7]);
                            auto rsw = __builtin_amdgcn_permlane32_swap(wa, wb, false, false);
                            u32x2 w; w.x = rsw[0]; w.y = rsw[1];
                            if (p < c) *(u32x2*)(yo + mi * 32 + 16 * kp) = w;
                        }
                }
            });
    }
}

#define XB_TMO      128
#define XB_XCNT(j)  (256  + 64 * (j))
#define XB_XSUB(j)  (1280 + 64 * (j))
#define XB_XGEN(j)  (2304 + 64 * (j))
#define XB_TOP      3328
#define XB_TOPGEN   3392
#define XCD_BAR_WORDS 3456
#define XB_SPIN_CAP (1u << 18)
#define LAS __attribute__((address_space(3)))
DEV unsigned xb_ld(unsigned* p)              { return __hip_atomic_load(p, __ATOMIC_RELAXED, __HIP_MEMORY_SCOPE_AGENT); }
DEV unsigned xb_add(unsigned* p, unsigned v) { return __hip_atomic_fetch_add(p, v, __ATOMIC_RELAXED, __HIP_MEMORY_SCOPE_AGENT); }
DEV unsigned xb_xcc_id() { return (unsigned)__builtin_amdgcn_s_getreg((3 << 11) | 20) & 0xFu; }
#define XB_SPIN(cond, bar) do { unsigned _sp = 0; while (cond) { __builtin_amdgcn_s_sleep(1); \
    if ((++_sp & 255u) == 0u) { if (xb_ld(&(bar)[XB_TMO])) break; if (_sp > XB_SPIN_CAP) { atomicAdd(&(bar)[XB_TMO], 1u); break; } } } } while (0)
struct XcdBarrier { unsigned* bar; unsigned x; volatile LAS unsigned* st; };
DEV XcdBarrier xcd_barrier_post(unsigned* bar, volatile LAS unsigned* st) {
    XcdBarrier b; b.bar = bar; b.x = xb_xcc_id(); b.st = st;
    if (threadIdx.x == 0) (void)xb_add(&bar[XB_XCNT(b.x)], 1u);
    return b;
}
DEV void xcd_barrier_complete(unsigned* bar, unsigned x, unsigned& nloc, unsigned& nx) {
    const unsigned G = gridDim.x * gridDim.y * gridDim.z;
    unsigned sum, cnt, mine, sp = 0u;
    for (;;) {
        sum = 0u; cnt = 0u; mine = 0u;
#pragma unroll
        for (unsigned j = 0; j < 16; ++j) { const unsigned c = xb_ld(&bar[XB_XCNT(j)]); sum += c; cnt += (c > 0u) ? 1u : 0u; mine = (j == x) ? c : mine; }
        if (sum == G) break;
        __builtin_amdgcn_s_sleep(1);
        if ((++sp & 255u) == 0u) { if (xb_ld(&bar[XB_TMO])) break; if (sp > XB_SPIN_CAP) { atomicAdd(&bar[XB_TMO], 1u); break; } }
    }
    nloc = mine > 0u ? mine : 1u; nx = cnt > 0u ? cnt : 1u;
}
DEV void xcd_barrier(const XcdBarrier& b) {
    asm volatile("s_waitcnt vmcnt(0)" ::: "memory");
    __syncthreads();
    if (threadIdx.x == 0) {
        unsigned* bar = b.bar;
        __builtin_amdgcn_s_waitcnt(0);
        unsigned nloc = b.st[0], nx = b.st[1];
        if (nloc == 0u) { xcd_barrier_complete(bar, b.x, nloc, nx); b.st[0] = nloc; b.st[1] = nx; }
        const unsigned old = xb_add(&bar[XB_XSUB(b.x)], 1u);
        const unsigned gen = old / nloc;
        if (old + 1u == (gen + 1u) * nloc) {
            __builtin_amdgcn_fence(__ATOMIC_RELEASE, "agent");
            asm volatile("s_waitcnt vmcnt(0)" ::: "memory");
            const unsigned og = xb_add(&bar[XB_TOP], 1u);
            const unsigned tg = og / nx;
            if (og + 1u == (tg + 1u) * nx) xb_add(&bar[XB_TOPGEN], 1u);
            else XB_SPIN(xb_ld(&bar[XB_TOPGEN]) == tg, bar);
            __builtin_amdgcn_fence(__ATOMIC_ACQUIRE, "agent");
            xb_add(&bar[XB_XGEN(b.x)], 1u);
            asm volatile("s_waitcnt vmcnt(0)" ::: "memory");
        } else {
            XB_SPIN(xb_ld(&bar[XB_XGEN(b.x)]) == gen, bar);
            __builtin_amdgcn_fence(__ATOMIC_ACQUIRE, "agent");
            asm volatile("s_waitcnt vmcnt(0)" ::: "memory");
        }
    }
    __syncthreads();
}

constexpr int NPH_LAYER = 10, NPH = 1 + 2 * NPH_LAYER + 1;
__global__ void __launch_bounds__(256, 2) mega(KArgs a) {
    __shared__ __attribute__((aligned(16))) unsigned char lds[65536 + 1024];
    uint4& xb_words = *(uint4*)(lds + 65536 + 768);
    cg::grid_group grid = cg::this_grid();
    const int lo = a.ph_lo, hi = a.ph_hi;
    if (threadIdx.x == 0) xb_words = make_uint4(0u, 0u, 0u, 0u);
    __syncthreads();
    const XcdBarrier xb = xcd_barrier_post((unsigned*)(a.ws + WS_CTL + 65536), (volatile LAS unsigned*)&xb_words);
    if (threadIdx.x == 0) {
        const unsigned hwid = (unsigned)__builtin_amdgcn_s_getreg((31 << 11) | 4), key = xb.x * 256u + ((hwid >> 8) & 0xffu);
        ((volatile unsigned*)&xb_words)[2] = atomicAdd((unsigned*)(a.ws + WS_CTL + 16384) + key, 1u);
    }
    __syncthreads();
    const int cu_role = __builtin_amdgcn_readfirstlane((int)(((volatile unsigned*)&xb_words)[2] & 1u));
#define GEMM_PRIO_ON()  (cu_role ? __builtin_amdgcn_s_setprio(2) : (void)0)
#define GEMM_PRIO_OFF() __builtin_amdgcn_s_setprio(0)
    if (hi < 0) grid.sync();
#define PHASE(k, call) do { const int k_ = (k); if (lo <= k_ && k_ < hi) { call; if (k_ + 1 < hi) xcd_barrier(xb); } } while (0)
    PHASE(0, (ph_prep(a, lds), convert_shared(a, lds)));
#pragma unroll 1
    for (int l = 0; l < 2; ++l) {
        const int base = 1 + l * NPH_LAYER;
        const int nrows = l == 0 ? TA : TL;
        PHASE(base + 0, ph_norm(a, l, 0, l > 0, l - 1, l == 0, TA));
        PHASE(base + 1, (GEMM_PRIO_ON(), ph_inproj(a, l, lds), GEMM_PRIO_OFF()));
        PHASE(base + 2, (blockIdx.x < (gridDim.x >> 1) ? (convert_experts(a, l, lds), __syncthreads(), ph_spatial(a, l, nrows, lds), ph_gla_kv(a, l, lds))
                                                        : (ph_spatial(a, l, nrows, lds), ph_gla_kv(a, l, lds), __syncthreads(), convert_experts(a, l, lds))));
        PHASE(base + 3, ph_gla_scan(a));
        PHASE(base + 4, ph_gla_out(a, l, lds));
        PHASE(base + 5, (GEMM_PRIO_ON(), ph_outproj(a, l, nrows, lds), GEMM_PRIO_OFF()));
        PHASE(base + 6, ph_norm(a, l, 1, false, 0, false, nrows));
        PHASE(base + 7, ph_router(a, l, nrows, lds));
        PHASE(base + 8, (GEMM_PRIO_ON(), ph_moe(a, l, 0, lds), GEMM_PRIO_OFF()));
        PHASE(base + 9, (GEMM_PRIO_ON(), ph_moe(a, l, 1, lds), GEMM_PRIO_OFF()));
    }
    PHASE(NPH - 1, ph_norm(a, 0, 2, true, 1, false, TL));
#undef PHASE
}

extern "C" void kernel_launch(void* const* d_in, const int* in_sizes, int n_in, void* d_out, int out_size, void* d_ws, size_t ws_size, hipStream_t stream) {
    static int grid = 0;
    if (grid == 0) {
        int dev = 0, cus = 0, per_cu = 0;
        hipGetDevice(&dev);
        hipDeviceGetAttribute(&cus, hipDeviceAttributeMultiprocessorCount, dev);
        hipOccupancyMaxActiveBlocksPerMultiprocessor(&per_cu, (const void*)mega, 256, 0);
        if (per_cu < 1) per_cu = 1;
        if (per_cu > 2) per_cu = 2;
        grid = cus * per_cu;
        if (n_in != 25 || ws_size < WS_END) { fprintf(stderr, "kernel_launch: unexpected n_in %d or ws_size %zu (need %zu)\n", n_in, ws_size, (size_t)WS_END); }
    }
    KArgs a{};
    for (int i = 0; i < 25; ++i) a.in[i] = (const float*)d_in[i];
    a.out = (float*)d_out; a.ws = (unsigned char*)d_ws;
    hipMemsetAsync(d_ws, 0, WS_MOD + 2 * 17 * 6144 * 4, stream);
#if ONE_LAUNCH
    a.ph_lo = 0; a.ph_hi = NPH;
    void* args[] = {&a};
    hipError_t e = hipLaunchCooperativeKernel((const void*)mega, dim3(grid), dim3(256), args, 0, stream);
    if (e != hipSuccess) fprintf(stderr, "cooperative launch failed: %s (grid %d)\n", hipGetErrorString(e), grid);
#else
    for (int ph = 0; ph < NPH; ++ph) {
        a.ph_lo = ph; a.ph_hi = ph + 1;
        hipLaunchKernelGGL(mega, dim3(grid), dim3(256), 0, stream, a);
    }
#endif
}
```

```cpp
#include <hip/hip_runtime.h>
#include <hip/hip_cooperative_groups.h>
#include <cstdio>
#include <cstdint>
namespace cg = cooperative_groups;

#ifndef ONE_LAUNCH
#define ONE_LAUNCH 1
#endif

#define DEV __device__ __forceinline__
typedef unsigned short bf16_t;
typedef float f32x4 __attribute__((ext_vector_type(4)));
typedef unsigned u32x2 __attribute__((ext_vector_type(2)));
typedef unsigned u32x4 __attribute__((ext_vector_type(4)));
typedef short bf16x8 __attribute__((ext_vector_type(8)));
typedef float f32x16 __attribute__((ext_vector_type(16)));
typedef long i64x2 __attribute__((ext_vector_type(2)));
typedef int i32x4 __attribute__((ext_vector_type(4)));
typedef int i32x8 __attribute__((ext_vector_type(8)));

constexpr int D = 1024, NB = 16, SEQ = 2048, CTXL = 256;
constexpr int TL = NB * SEQ, TC = NB * CTXL, TA = TL + TC;
constexpr int DIN = 2592, OFF_AU = 0, OFF_AV = 512, OFF_BQ = 1024, OFF_BR = 1280, OFF_BK = 1792, OFF_BV = 2048, OFF_BG = 2560;
constexpr int NE = 64, DE = 512, LCAP = 2 * TA;
constexpr float EPS = 1e-6f;

constexpr size_t MiB = 1u << 20;
constexpr size_t WS_CTL = 0, WS_MOD = 1 * MiB, WS_WRT = 2 * MiB, WS_WSP = 2 * MiB + 512 * 1024, WS_WINT = 3 * MiB, WS_WOUTT = 14 * MiB,
                 WS_W1T = 18 * MiB, WS_W3T = 82 * MiB, WS_W2T = 146 * MiB, WS_H = 210 * MiB, WS_HN = 354 * MiB, WS_Z = 426 * MiB, WS_MIX = 609 * MiB,
                 WS_KV = 681 * MiB, WS_DECAY = 844 * MiB, WS_HN8 = 846 * MiB, WS_LIST = 884 * MiB, WS_END = 921 * MiB;
static_assert(WS_WINT + (size_t)2 * DIN * D * 2 <= WS_WOUTT && WS_WOUTT + (size_t)2 * D * D * 2 <= WS_W1T && WS_W1T + (size_t)NE * DE * D * 2 <= WS_W3T && WS_W2T + (size_t)NE * DE * D * 2 <= WS_H, "ws map (weights)");
static_assert(WS_H + (size_t)TA * D * 4 <= WS_HN && WS_HN + (size_t)TA * D * 2 <= WS_Z && WS_Z + (size_t)TA * DIN * 2 <= WS_MIX &&
              WS_MIX + (size_t)TA * D * 2 <= WS_KV && WS_KV + (size_t)2 * TA * 512 * 4 <= WS_DECAY && WS_LIST + (size_t)NE * LCAP * 8 <= WS_END, "ws map");

struct KArgs { const float* in[25]; float* out; unsigned char* ws; int ph_lo, ph_hi; };
enum { I_X = 0, I_C, I_CTX, I_CCTX, I_WMOD, I_BMOD, I_GN1, I_WIN, I_LNG, I_LNB, I_WSP, I_BSP, I_WGU, I_BG, I_GGLA, I_WOUT, I_GN2, I_WRG, I_BRG, I_WRE, I_BRE, I_W1, I_W3, I_W2, I_GF };

DEV float bf2f(bf16_t v) { return __uint_as_float((unsigned)v << 16); }
typedef __bf16 bf16x2_t __attribute__((ext_vector_type(2)));
DEV bf16_t f2bf(float f) { return __builtin_bit_cast(bf16_t, (__bf16)f); }
DEV unsigned pk2(float lo, float hi) { bf16x2_t v; v.x = (__bf16)lo; v.y = (__bf16)hi; return __builtin_bit_cast(unsigned, v); }
DEV u32x4 widen_pair(u32x2 a, u32x2 b) {
    auto r0 = __builtin_amdgcn_permlane32_swap(a.x, b.x, false, false); auto r1 = __builtin_amdgcn_permlane32_swap(a.y, b.y, false, false);
    u32x4 o; o.x = r0[0]; o.y = r1[0]; o.z = r0[1]; o.w = r1[1]; return o;
}
constexpr float W8_SCALE = 32.f, W8_INV = 1.f / 32.f, YS_SCALE = 16.f, YS_INV = 1.f / 16.f;
DEV unsigned pk4_fp8(float a, float b, float c, float d) { int w = 0; w = __builtin_amdgcn_cvt_pk_fp8_f32(a, b, w, false); w = __builtin_amdgcn_cvt_pk_fp8_f32(c, d, w, true); return (unsigned)w; }
DEV float silu_f(float x) { return x * __builtin_amdgcn_rcpf(1.f + __expf(-x)); }
DEV float gelu_f(float x) { const float x2 = x * x; const float u2 = x * (1.5957691216057308f + 0.07135481627f * x2); return x * __builtin_amdgcn_rcpf(1.f + __expf(-u2)); }
DEV float logsigmoid_f(float x) { return fminf(x, 0.f) - __logf(1.f + __expf(-fabsf(x))); }
DEV float wave_sum(float v) {
#pragma unroll
    for (int o = 1; o < 64; o <<= 1) v += __shfl_xor(v, o);
    return v;
}
DEV int get_tid() { int t = threadIdx.x; asm volatile("" : "+v"(t)); return t; }
DEV int mod_index(int row) { return row < TL ? (row >> 11) : 16; }

DEV void ph_prep(const KArgs& a, unsigned char* lds) {
    const int tid = get_tid(), lane = tid & 63, wid = tid >> 6;
    float* slab = (float*)lds + wid * 17 * 64;
    float* red = (float*)lds + 4 * 17 * 64;
    float* mod = (float*)(a.ws + WS_MOD);
    const float* c = a.in[I_C]; const float* cctx = a.in[I_CCTX];
    for (int item = blockIdx.x; item < 2 * 96 * 2; item += gridDim.x) {
        const int kh = item & 1, it2 = item >> 1, l = it2 / 96, j0 = (it2 % 96) * 64, j = j0 + lane;
        const float* W = a.in[I_WMOD] + (size_t)l * D * 6144;
        float acc[17];
#pragma unroll
        for (int i = 0; i < 17; ++i) acc[i] = 0.f;
#pragma unroll 1
        for (int ks = 0; ks < 2; ++ks) {
            const int kb = kh * 512 + wid * 128 + ks * 64;
#pragma unroll
            for (int bi = 0; bi < 17; ++bi) { const float x = (bi < 16) ? c[bi * D + kb + lane] : cctx[kb + lane]; slab[bi * 64 + lane] = silu_f(x); }
            __syncthreads();
#pragma unroll 1
            for (int k8 = 0; k8 < 64; k8 += 16) {
                float w[16];
#pragma unroll
                for (int u = 0; u < 16; ++u) w[u] = __builtin_nontemporal_load(W + (size_t)(kb + k8 + u) * 6144 + j);
#pragma unroll
                for (int u = 0; u < 16; ++u)
#pragma unroll
                    for (int bi = 0; bi < 17; ++bi) acc[bi] += slab[bi * 64 + k8 + u] * w[u];
            }
            __syncthreads();
        }
#pragma unroll
        for (int bi = 0; bi < 17; ++bi) red[(wid * 17 + bi) * 64 + lane] = acc[bi];
        __syncthreads();
        for (int idx = tid; idx < 17 * 64; idx += 256) {
            const int bi = idx >> 6, ln = idx & 63;
            const float sv = red[(0 * 17 + bi) * 64 + ln] + red[(1 * 17 + bi) * 64 + ln] + red[(2 * 17 + bi) * 64 + ln] + red[(3 * 17 + bi) * 64 + ln] + (kh == 0 ? a.in[I_BMOD][l * 6144 + j0 + ln] : 0.f);
            atomicAdd(mod + (size_t)(l * 17 + bi) * 6144 + j0 + ln, sv);
        }
        __syncthreads();
    }
}

DEV void ph_norm(const KArgs& a, int layer, int which  , bool combine, int comb_layer, bool from_input, int nrows) {
    const int tid = get_tid(), lane = tid & 63, wid = tid >> 6;
    float* hws = (float*)(a.ws + WS_H);
    bf16_t* hn = (bf16_t*)(a.ws + WS_HN);
    const unsigned char* ys = a.ws + WS_KV;
    const float* mod = (const float*)(a.ws + WS_MOD);
    const float* g = which == 0 ? a.in[I_GN1] + layer * D : (which == 1 ? a.in[I_GN2] + layer * D : a.in[I_GF]);
    const int nw = gridDim.x * 4, gw = blockIdx.x * 4 + wid, R = (nrows + nw - 1) / nw;
    const int r0 = gw * R, r1 = r0 + R < nrows ? r0 + R : nrows;
    if (r0 >= r1) return;
    f32x4 v[4], vn[4], A[4], B[4], G2[4];
    unsigned y0v[4], y1v[4], y0n[4], y1n[4];
#pragma unroll
    for (int j = 0; j < 4; ++j) { A[j] = B[j] = G2[j] = f32x4{0.f, 0.f, 0.f, 0.f}; y0v[j] = y1v[j] = y0n[j] = y1n[j] = 0u; }
    auto src_of = [&](int r) { return from_input ? (r < TL ? a.in[I_X] + (size_t)r * D : a.in[I_CTX] + (size_t)(r - TL) * D) : hws + (size_t)r * D; };
    {
        const float* src = src_of(r0);
#pragma unroll
        for (int j = 0; j < 4; ++j) v[j] = __builtin_nontemporal_load((const f32x4*)(src + (lane + 64 * j) * 4));
        if (combine) {
#pragma unroll
            for (int j = 0; j < 4; ++j) { const int k = (lane + 64 * j) * 4; y0v[j] = __builtin_nontemporal_load((const unsigned*)(ys + (size_t)(2 * r0) * D + k)); y1v[j] = __builtin_nontemporal_load((const unsigned*)(ys + (size_t)(2 * r0 + 1) * D + k)); }
        }
    }
    int cur_bi = -1;
#pragma unroll 1
    for (int r = r0; r < r1; ++r) {
        const bool more = r + 1 < r1;
        if (more) {
            const float* src = src_of(r + 1);
#pragma unroll
            for (int j = 0; j < 4; ++j) vn[j] = __builtin_nontemporal_load((const f32x4*)(src + (lane + 64 * j) * 4));
            if (combine) {
#pragma unroll
                for (int j = 0; j < 4; ++j) { const int k = (lane + 64 * j) * 4; y0n[j] = __builtin_nontemporal_load((const unsigned*)(ys + (size_t)(2 * r + 2) * D + k)); y1n[j] = __builtin_nontemporal_load((const unsigned*)(ys + (size_t)(2 * r + 3) * D + k)); }
            }
        }
        const int bi = mod_index(r);
        if (bi != cur_bi) {
            cur_bi = bi;
            const float* sh = mod + (size_t)(layer * 17 + bi) * 6144 + (which == 0 ? 0 : 3 * D);
            const float* sc = sh + D;
            const float* g2 = mod + (size_t)(comb_layer * 17 + bi) * 6144 + 5 * D;
#pragma unroll
            for (int j = 0; j < 4; ++j) {
                const int k = (lane + 64 * j) * 4;
                const f32x4 gg = *(const f32x4*)(g + k);
                if (which == 2) A[j] = gg; else { A[j] = gg * (1.f + *(const f32x4*)(sc + k)); B[j] = *(const f32x4*)(sh + k); }
                if (combine) G2[j] = *(const f32x4*)(g2 + k) * YS_INV;
            }
        }
        if (combine) {
#pragma unroll
            for (int j = 0; j < 4; ++j) {
                const int k = (lane + 64 * j) * 4;
                const int y0 = (int)y0v[j], y1 = (int)y1v[j];
                v[j].x += G2[j].x * (__builtin_amdgcn_cvt_f32_fp8(y0, 0) + __builtin_amdgcn_cvt_f32_fp8(y1, 0));
                v[j].y += G2[j].y * (__builtin_amdgcn_cvt_f32_fp8(y0, 1) + __builtin_amdgcn_cvt_f32_fp8(y1, 1));
                v[j].z += G2[j].z * (__builtin_amdgcn_cvt_f32_fp8(y0, 2) + __builtin_amdgcn_cvt_f32_fp8(y1, 2));
                v[j].w += G2[j].w * (__builtin_amdgcn_cvt_f32_fp8(y0, 3) + __builtin_amdgcn_cvt_f32_fp8(y1, 3));
                if (which != 2) __builtin_nontemporal_store(v[j], (f32x4*)(hws + (size_t)r * D + k));
            }
        }
        float ss = 0.f;
#pragma unroll
        for (int j = 0; j < 4; ++j) ss += v[j].x * v[j].x + v[j].y * v[j].y + v[j].z * v[j].z + v[j].w * v[j].w;
        const float rstd = rsqrtf(wave_sum(ss) * (1.f / D) + EPS);
        if (which == 2) {
#pragma unroll
            for (int j = 0; j < 4; ++j) { const int k = (lane + 64 * j) * 4; f32x4 o = v[j] * rstd * A[j]; __builtin_nontemporal_store(o, (f32x4*)(a.out + (size_t)r * D + k)); }
        } else {
#pragma unroll
            for (int j = 0; j < 4; ++j) {
                const int k = (lane + 64 * j) * 4;
                const f32x4 o = v[j] * rstd * A[j] + B[j];
                u32x2 w; w.x = pk2(o.x, o.y); w.y = pk2(o.z, o.w);
                *(u32x2*)(hn + (size_t)r * D + k) = w;
                if (which == 1) *(unsigned*)(a.ws + WS_HN8 + (size_t)r * D + k) = pk4_fp8(o.x, o.y, o.z, o.w);
            }
        }
        if (more) {
#pragma unroll
            for (int j = 0; j < 4; ++j) { v[j] = vn[j]; y0v[j] = y0n[j]; y1v[j] = y1n[j]; }
        }
    }
}


DEV void transpose_item(const float* W, int K, int N, bf16_t* WT, float* scr, int kb, int nb, int lane) {
    const int k0 = kb * 64, n0 = nb * 32;
    float wv[32];
#pragma unroll
    for (int i = 0; i < 32; ++i) wv[i] = __builtin_nontemporal_load(W + (size_t)(k0 + 2 * i + (lane >> 5)) * N + n0 + (lane & 31));
#pragma unroll
    for (int i = 0; i < 32; ++i) scr[(2 * i + (lane >> 5)) * 33 + (lane & 31)] = wv[i];
    asm volatile("s_waitcnt lgkmcnt(0)" ::: "memory");
    const int c = lane & 7;
#pragma unroll
    for (int j = 0; j < 4; ++j) {
        const int n = (lane >> 3) + 8 * j; const float* sp = scr + (8 * c) * 33 + n;
        u32x4 o; o.x = pk2(sp[0 * 33], sp[1 * 33]); o.y = pk2(sp[2 * 33], sp[3 * 33]); o.z = pk2(sp[4 * 33], sp[5 * 33]); o.w = pk2(sp[6 * 33], sp[7 * 33]);
        *(u32x4*)(WT + (size_t)(n0 + n) * K + k0 + 8 * c) = o;
    }
    asm volatile("s_waitcnt lgkmcnt(0)" ::: "memory");
}
DEV void transpose_item8(const float* W, int K, int N, unsigned char* WT, float* scr, int kb, int nb, int lane) {
    const int k0 = kb * 64, n0 = nb * 32;
    float wv[32];
#pragma unroll
    for (int i = 0; i < 32; ++i) wv[i] = __builtin_nontemporal_load(W + (size_t)(k0 + 2 * i + (lane >> 5)) * N + n0 + (lane & 31));
#pragma unroll
    for (int i = 0; i < 32; ++i) scr[(2 * i + (lane >> 5)) * 33 + (lane & 31)] = wv[i] * W8_SCALE;
    asm volatile("s_waitcnt lgkmcnt(0)" ::: "memory");
    const int n = lane & 31, kh = (lane >> 5) * 32;
    const float* sp = scr + kh * 33 + n;
    u32x4 o0, o1;
    o0.x = pk4_fp8(sp[0 * 33], sp[1 * 33], sp[2 * 33], sp[3 * 33]); o0.y = pk4_fp8(sp[4 * 33], sp[5 * 33], sp[6 * 33], sp[7 * 33]);
    o0.z = pk4_fp8(sp[8 * 33], sp[9 * 33], sp[10 * 33], sp[11 * 33]); o0.w = pk4_fp8(sp[12 * 33], sp[13 * 33], sp[14 * 33], sp[15 * 33]);
    o1.x = pk4_fp8(sp[16 * 33], sp[17 * 33], sp[18 * 33], sp[19 * 33]); o1.y = pk4_fp8(sp[20 * 33], sp[21 * 33], sp[22 * 33], sp[23 * 33]);
    o1.z = pk4_fp8(sp[24 * 33], sp[25 * 33], sp[26 * 33], sp[27 * 33]); o1.w = pk4_fp8(sp[28 * 33], sp[29 * 33], sp[30 * 33], sp[31 * 33]);
    unsigned char* dp = WT + (size_t)(n0 + n) * K + k0 + kh;
    __builtin_nontemporal_store(o0, (u32x4*)dp); __builtin_nontemporal_store(o1, (u32x4*)(dp + 16));
    asm volatile("s_waitcnt lgkmcnt(0)" ::: "memory");
}
DEV void convert_experts(const KArgs& a, int layer, unsigned char* lds) {
    const int tid = get_tid(), lane = tid & 63, wid = tid >> 6;
    float* scr = (float*)lds + wid * (64 * 33);
    const int gw = blockIdx.x * 4 + wid, ngw = gridDim.x * 4;
    for (int it = gw; it < NE * 3 * 256; it += ngw) {
        const int mat = it >> 8, sub = it & 255, e = mat / 3, which = mat % 3;
        if (which < 2) {
            const float* W = a.in[which == 0 ? I_W1 : I_W3] + ((size_t)layer * NE + e) * D * DE;
            unsigned char* WT = a.ws + (which == 0 ? WS_W1T : WS_W3T) + (size_t)e * DE * D;
            transpose_item8(W, D, DE, WT, scr, sub >> 4, sub & 15, lane);
        } else {
            const float* W = a.in[I_W2] + ((size_t)layer * NE + e) * DE * D;
            unsigned char* WT = a.ws + WS_W2T + (size_t)e * D * DE;
            transpose_item8(W, DE, D, WT, scr, sub >> 5, sub & 31, lane);
        }
    }
}
DEV void convert_shared(const KArgs& a, unsigned char* lds) {
    const int tid = get_tid(), lane = tid & 63, wid = tid >> 6;
    float* scr = (float*)lds + wid * (64 * 33);
    const int gw = blockIdx.x * 4 + wid, ngw = gridDim.x * 4;
    constexpr int I_IN = 16 * 81, I_OUT = 16 * 32;
    for (int it = gw; it < 2 * I_IN + 2 * I_OUT; it += ngw) {
        if (it < 2 * I_IN) { const int l = it / I_IN, sub = it % I_IN; transpose_item(a.in[I_WIN] + (size_t)l * D * DIN, D, DIN, (bf16_t*)(a.ws + WS_WINT) + (size_t)l * DIN * D, scr, sub / 81, sub % 81, lane); }
        else { const int r = it - 2 * I_IN, l = r / I_OUT, sub = r % I_OUT; transpose_item(a.in[I_WOUT] + (size_t)l * D * D, D, D, (bf16_t*)(a.ws + WS_WOUTT) + (size_t)l * D * D, scr, sub >> 5, sub & 31, lane); }
    }
    bf16_t* wrt = (bf16_t*)(a.ws + WS_WRT); bf16_t* wsp = (bf16_t*)(a.ws + WS_WSP);
    const int gt = blockIdx.x * 256 + tid, ngt = gridDim.x * 256;
    for (int i = gt; i < 2 * 128 * D; i += ngt) {
        const int l = i >> 17, n = (i >> 10) & 127, k = i & 1023;
        float v = 0.f;
        if (n < 8) v = a.in[I_WRG][((size_t)l * D + k) * 8 + n]; else if (n < 72) v = a.in[I_WRE][((size_t)l * D + k) * 64 + (n - 8)];
        wrt[i] = f2bf(v);
    }
    for (int i = gt; i < 2 * 4 * 128 * 128; i += ngt) wsp[i] = f2bf(a.in[I_WSP][i]);
}

DEV void glds16(const bf16_t* src, unsigned char* dst) { __builtin_amdgcn_global_load_lds((const unsigned*)src, (__attribute__((address_space(3))) unsigned*)dst, 16, 0, 0); }
template <class ARow, class BRow>
DEV void gemm_core(unsigned char* lds, int nk, ARow arow, BRow brow, f32x16 (&acc)[2][2]) {
    const int tid = get_tid(), lane = tid & 63, wid = tid >> 6, wr = wid >> 1, wc = wid & 1;
    const int srow = tid >> 3, sch = (tid & 7) ^ ((tid >> 4) & 7);
    const bf16_t* ap[4]; const bf16_t* bp[4];
#pragma unroll
    for (int i = 0; i < 4; ++i) { ap[i] = arow(i * 32 + srow) + sch * 8; bp[i] = brow(i * 32 + srow) + sch * 8; }
#pragma unroll
    for (int mi = 0; mi < 2; ++mi)
#pragma unroll
        for (int ni = 0; ni < 2; ++ni)
#pragma unroll
            for (int r = 0; r < 16; ++r) acc[mi][ni][r] = 0.f;
    unsigned char* dst = lds + __builtin_amdgcn_readfirstlane(tid & ~63) * 16;
    const int fr = lane & 31, fh = lane >> 5, g = (fr >> 1) & 7;
    const unsigned char* ra = lds + (wr * 64 + fr) * 128;
    const unsigned char* rb = lds + 16384 + (wc * 64 + fr) * 128;
#pragma unroll
    for (int i = 0; i < 4; ++i) { glds16(ap[i], dst + i * 4096); glds16(bp[i], dst + 16384 + i * 4096); }
    if (nk > 1) {
#pragma unroll
        for (int i = 0; i < 4; ++i) { glds16(ap[i] + 64, dst + 32768 + i * 4096); glds16(bp[i] + 64, dst + 32768 + 16384 + i * 4096); }
    }
    for (int kt = 0; kt < nk; ++kt) {
        const int cur = (kt & 1) * 32768;
        if (kt + 1 < nk) asm volatile("s_waitcnt vmcnt(8)" ::: "memory"); else asm volatile("s_waitcnt vmcnt(0)" ::: "memory");
        __builtin_amdgcn_s_barrier();
        asm volatile("" ::: "memory");
        bf16x8 af[4][2], bfr[4][2];
#pragma unroll
        for (int ks = 0; ks < 4; ++ks) {
            const int co = ((ks * 2 + fh) ^ g) << 4;
#pragma unroll
            for (int mi = 0; mi < 2; ++mi) af[ks][mi] = *(const bf16x8*)(ra + cur + mi * 4096 + co);
#pragma unroll
            for (int ni = 0; ni < 2; ++ni) bfr[ks][ni] = *(const bf16x8*)(rb + cur + ni * 4096 + co);
        }
        asm volatile("s_waitcnt lgkmcnt(0)" ::: "memory");
        __builtin_amdgcn_s_barrier();
        asm volatile("" ::: "memory");
        if (kt + 2 < nk) {
            const int ko = (kt + 2) * 64;
#pragma unroll
            for (int i = 0; i < 4; ++i) { glds16(ap[i] + ko, dst + cur + i * 4096); glds16(bp[i] + ko, dst + cur + 16384 + i * 4096); }
        }
#pragma unroll
        for (int ks = 0; ks < 4; ++ks)
#pragma unroll
            for (int mi = 0; mi < 2; ++mi)
#pragma unroll
                for (int ni = 0; ni < 2; ++ni) acc[mi][ni] = __builtin_amdgcn_mfma_f32_32x32x16_bf16(af[ks][mi], bfr[ks][ni], acc[mi][ni], 0, 0, 0);
    }
    __builtin_amdgcn_s_barrier();
    asm volatile("" ::: "memory");
}
template <bool FP8 = false, class Prep, class ARow, class Fetch, class BRow, class Pre, class Epi>
DEV void gemm_stream_x(unsigned char* lds, int nk, int t0, int tstep, int tend, Prep prep, ARow arow, Fetch fetch, BRow brow, Pre pre, Epi epi) {
    const int tid = get_tid(), lane = tid & 63, wid = tid >> 6, wr = wid >> 1, wc = wid & 1;
    const int srow = tid >> 3, sch = (tid & 7) ^ ((tid >> 4) & 7);
    if (t0 >= tend) return;
    auto cx = prep(t0);
    auto nx = cx;
    const bf16_t* ap[4]; const bf16_t* bp[4];
    unsigned raw[4];
#pragma unroll
    for (int i = 0; i < 4; ++i) raw[i] = fetch(cx, i * 32 + srow);
#pragma unroll
    for (int i = 0; i < 4; ++i) { ap[i] = arow(cx, i * 32 + srow) + sch * 8; bp[i] = brow(cx, i * 32 + srow, raw[i]) + sch * 8; }
    unsigned char* dst = lds + __builtin_amdgcn_readfirstlane(tid & ~63) * 16;
    const int fr = lane & 31, fh = lane >> 5, g = (fr >> 1) & 7;
    const unsigned char* ra = lds + (wr * 64 + fr) * 128;
    const unsigned char* rb = lds + 16384 + (wc * 64 + fr) * 128;
#pragma unroll
    for (int i = 0; i < 4; ++i) { glds16(ap[i], dst + i * 4096); glds16(bp[i], dst + 16384 + i * 4096); }
#pragma unroll
    for (int i = 0; i < 4; ++i) { glds16(ap[i] + 64, dst + 32768 + i * 4096); glds16(bp[i] + 64, dst + 32768 + 16384 + i * 4096); }
    for (int t = t0; t < tend; t += tstep) {
        const bool has_next = t + tstep < tend;
        const auto pv = pre(cx);
        if (has_next) {
            nx = prep(t + tstep);
#pragma unroll
            for (int i = 0; i < 4; ++i) raw[i] = fetch(nx, i * 32 + srow);
        }
        f32x16 acc[2][2];
#pragma unroll
        for (int mi = 0; mi < 2; ++mi)
#pragma unroll
            for (int ni = 0; ni < 2; ++ni)
#pragma unroll
                for (int r = 0; r < 16; ++r) acc[mi][ni][r] = 0.f;
        for (int kt = 0; kt < nk; ++kt) {
            const int cur = (kt & 1) * 32768;
            if (kt + 1 < nk || has_next) asm volatile("s_waitcnt vmcnt(8)" ::: "memory"); else asm volatile("s_waitcnt vmcnt(0)" ::: "memory");
            __builtin_amdgcn_s_barrier();
            asm volatile("" ::: "memory");
            bf16x8 af[4][2], bfr[4][2];
            i32x8 a8[2][2], b8[2][2];
            if (!FP8) {
#pragma unroll
            for (int ks = 0; ks < 4; ++ks) {
                const int co = ((ks * 2 + fh) ^ g) << 4;
#pragma unroll
                for (int mi = 0; mi < 2; ++mi) af[ks][mi] = *(const bf16x8*)(ra + cur + mi * 4096 + co);
#pragma unroll
                for (int ni = 0; ni < 2; ++ni) bfr[ks][ni] = *(const bf16x8*)(rb + cur + ni * 4096 + co);
            }
            } else {
#pragma unroll
            for (int m = 0; m < 2; ++m) {
                const int c0 = ((m * 4 + fh) ^ g) << 4, c1 = ((m * 4 + 2 + fh) ^ g) << 4;
#pragma unroll
                for (int mi = 0; mi < 2; ++mi) { a8[m][mi].lo = *(const i32x4*)(ra + cur + mi * 4096 + c0); a8[m][mi].hi = *(const i32x4*)(ra + cur + mi * 4096 + c1); }
#pragma unroll
                for (int ni = 0; ni < 2; ++ni) { b8[m][ni].lo = *(const i32x4*)(rb + cur + ni * 4096 + c0); b8[m][ni].hi = *(const i32x4*)(rb + cur + ni * 4096 + c1); }
            }
            }
            asm volatile("s_waitcnt lgkmcnt(0)" ::: "memory");
            __builtin_amdgcn_sched_barrier(0);
            __builtin_amdgcn_s_barrier();
            asm volatile("" ::: "memory");
            __builtin_amdgcn_sched_barrier(0);
            int ko = -1;
            if (kt + 2 < nk) ko = (kt + 2) * 64;
            else if (has_next) {
                if (kt + 2 == nk) {
#pragma unroll
                    for (int i = 0; i < 4; ++i) { ap[i] = arow(nx, i * 32 + srow) + sch * 8; bp[i] = brow(nx, i * 32 + srow, raw[i]) + sch * 8; }
                }
                ko = (kt + 2 - nk) * 64;
            }
            if (FP8) {
#pragma unroll
                for (int ks = 0; ks < 8; ++ks) {
                    if (ko >= 0) { if (ks & 1) glds16(bp[ks >> 1] + ko, dst + cur + 16384 + (ks >> 1) * 4096); else glds16(ap[ks >> 1] + ko, dst + cur + (ks >> 1) * 4096); }
                    const int m = ks >> 2, mi = (ks >> 1) & 1, ni = ks & 1;
                    acc[mi][ni] = __builtin_amdgcn_mfma_scale_f32_32x32x64_f8f6f4(a8[m][mi], b8[m][ni], acc[mi][ni], 0, 0, 0, 0x7f7f7f7f, 0, 0x7f7f7f7f);
                    __builtin_amdgcn_sched_barrier(0);
                }
                asm volatile("" : "+v"(acc[0][0]), "+v"(acc[0][1]), "+v"(acc[1][0]), "+v"(acc[1][1]));
            } else
#pragma unroll
            for (int ks = 0; ks < 4; ++ks) {
                if (ko >= 0) { glds16(ap[ks] + ko, dst + cur + ks * 4096); }
                acc[0][0] = __builtin_amdgcn_mfma_f32_32x32x16_bf16(af[ks][0], bfr[ks][0], acc[0][0], 0, 0, 0);
                acc[0][1] = __builtin_amdgcn_mfma_f32_32x32x16_bf16(af[ks][0], bfr[ks][1], acc[0][1], 0, 0, 0);
                __builtin_amdgcn_sched_barrier(0);
                if (ko >= 0) { glds16(bp[ks] + ko, dst + cur + 16384 + ks * 4096); }
                acc[1][0] = __builtin_amdgcn_mfma_f32_32x32x16_bf16(af[ks][1], bfr[ks][0], acc[1][0], 0, 0, 0);
                acc[1][1] = __builtin_amdgcn_mfma_f32_32x32x16_bf16(af[ks][1], bfr[ks][1], acc[1][1], 0, 0, 0);
                __builtin_amdgcn_sched_barrier(0);
            }
        }
        epi(cx, acc, pv);
        cx = nx;
    }
    __builtin_amdgcn_s_barrier();
    asm volatile("" ::: "memory");
}
template <bool FP8 = false, class Prep, class ARow, class BRow, class Epi>
DEV void gemm_stream(unsigned char* lds, int nk, int t0, int tstep, int tend, Prep prep, ARow arow, BRow brow, Epi epi) {
    gemm_stream_x<FP8>(lds, nk, t0, tstep, tend, prep, arow, [](const auto&, int) { return 0u; }, [&](const auto& cx, int r, unsigned) { return brow(cx, r); },
                       [](const auto&) { return 0; }, [&](const auto& cx, const f32x16 (&acc)[2][2], int) { epi(cx, acc); });
}
DEV int vblock() { const int G = gridDim.x, bx = blockIdx.x; return (G % 8 == 0) ? (bx % 8) * (G / 8) + bx / 8 : bx; }
#define ACC_FOREACH(mi, ni, r, row, col) \
    _Pragma("unroll") for (int mi = 0; mi < 2; ++mi) _Pragma("unroll") for (int ni = 0; ni < 2; ++ni) _Pragma("unroll") for (int r = 0; r < 16; ++r) \
        for (int row = (tid >> 7) * 64 + mi * 32 + (r & 3) + 8 * (r >> 2) + 4 * ((tid & 63) >> 5), col = ((tid >> 6) & 1) * 64 + ni * 32 + (tid & 31), once_ = 1; once_; once_ = 0)

template <class ARow, class Epi>
DEV void gemm_naive_tile(float* lds, int K, ARow arow, const float* W, int ldw, int col0, int ncols, Epi epi) {
    const int tid = get_tid(), ty = tid >> 4, tx = tid & 15;
    float* sA = lds;
    float* sB = lds + 16 * 68;
    const int ar = tid >> 2, kq = (tid & 3) * 4;
    const bf16_t* ap = arow(ar);
    const int kr = tid >> 4, c4 = (tid & 15) * 4;
    const bool cok = (col0 + c4) < ncols;
    float acc[4][4];
#pragma unroll
    for (int i = 0; i < 4; ++i)
#pragma unroll
        for (int j = 0; j < 4; ++j) acc[i][j] = 0.f;
    for (int k0 = 0; k0 < K; k0 += 16) {
        const u32x2 av = *(const u32x2*)(ap + k0 + kq);
        f32x4 wv = {0.f, 0.f, 0.f, 0.f};
        if (cok) wv = *(const f32x4*)(W + (size_t)(k0 + kr) * ldw + col0 + c4);
        sA[(kq + 0) * 68 + ar] = __uint_as_float(av.x << 16);
        sA[(kq + 1) * 68 + ar] = __uint_as_float(av.x & 0xffff0000u);
        sA[(kq + 2) * 68 + ar] = __uint_as_float(av.y << 16);
        sA[(kq + 3) * 68 + ar] = __uint_as_float(av.y & 0xffff0000u);
        *(f32x4*)(sB + kr * 64 + c4) = wv;
        __syncthreads();
#pragma unroll 4
        for (int k = 0; k < 16; ++k) {
            const f32x4 a4 = *(const f32x4*)(sA + k * 68 + ty * 4), b4 = *(const f32x4*)(sB + k * 64 + tx * 4);
            const float aa[4] = {a4.x, a4.y, a4.z, a4.w}, bb[4] = {b4.x, b4.y, b4.z, b4.w};
#pragma unroll
            for (int i = 0; i < 4; ++i)
#pragma unroll
                for (int j = 0; j < 4; ++j) acc[i][j] += aa[i] * bb[j];
        }
        __syncthreads();
    }
#pragma unroll
    for (int i = 0; i < 4; ++i)
#pragma unroll
        for (int j = 0; j < 4; ++j) { const int col = col0 + tx * 4 + j; if (col < ncols) epi(ty * 4 + i, col, acc[i][j]); }
}

DEV void ph_inproj(const KArgs& a, int layer, unsigned char* lds) {
    const int tid = get_tid();
    const bf16_t* hn = (const bf16_t*)(a.ws + WS_HN);
    bf16_t* z = (bf16_t*)(a.ws + WS_Z);
    const bf16_t* WT = (const bf16_t*)(a.ws + WS_WINT) + (size_t)layer * DIN * D;
    constexpr int ntn = (DIN + 127) / 128, nlat = (TL / 128) * ntn, ncn = ntn - OFF_BK / 128;
    const int ntiles = layer == 0 ? (TA / 128) * ntn : nlat + (TC / 128) * ncn;
    struct Cx { int row0, col0; };
    auto prep = [&](int t) { Cx c;
        if (layer == 0 || t < nlat) { c.row0 = (t / ntn) * 128; c.col0 = (t % ntn) * 128; }
        else { const int u = t - nlat; c.row0 = TL + (u / ncn) * 128; c.col0 = OFF_BK + (u % ncn) * 128; }
        return c; };
    gemm_stream(lds, D / 64, vblock(), gridDim.x, ntiles, prep,
        [&](const Cx& c, int r) { int n = c.col0 + r; n = n < DIN ? n : DIN - 1; return WT + (size_t)n * D; },
        [&](const Cx& c, int r) { return hn + (size_t)(c.row0 + r) * D; },
        [&](const Cx& c, const f32x16 (&acc)[2][2]) {
            const int row0 = c.row0, col0 = c.col0;
            const int wr = tid >> 7, wc = (tid >> 6) & 1, lane = tid & 63;
#pragma unroll
            for (int ni = 0; ni < 2; ++ni) {
                bf16_t* zr = z + (size_t)(row0 + wc * 64 + ni * 32 + (lane & 31)) * DIN + col0;
#pragma unroll
                for (int mi = 0; mi < 2; ++mi)
#pragma unroll
                    for (int kp = 0; kp < 2; ++kp) {
                        u32x2 wa, wb;
                        wa.x = pk2(acc[mi][ni][8 * kp], acc[mi][ni][8 * kp + 1]); wa.y = pk2(acc[mi][ni][8 * kp + 2], acc[mi][ni][8 * kp + 3]);
                        wb.x = pk2(acc[mi][ni][8 * kp + 4], acc[mi][ni][8 * kp + 5]); wb.y = pk2(acc[mi][ni][8 * kp + 6], acc[mi][ni][8 * kp + 7]);
                        const u32x4 w = widen_pair(wa, wb);
                        const int n = wr * 64 + mi * 32 + 16 * kp + 8 * (lane >> 5);
                        if (col0 + n < DIN) *(u32x4*)(zr + n) = w;
                    }
            }
        });
}

DEV void ph_outproj(const KArgs& a, int layer, int nrows, unsigned char* lds) {
    const int tid = get_tid();
    const bf16_t* mix = (const bf16_t*)(a.ws + WS_MIX);
    float* hws = (float*)(a.ws + WS_H);
    const float* mod = (const float*)(a.ws + WS_MOD);
    const bf16_t* WT = (const bf16_t*)(a.ws + WS_WOUTT) + (size_t)layer * D * D;
    constexpr int ntn = D / 128;
    gemm_stream(lds, D / 64, vblock(), gridDim.x, (nrows / 128) * ntn, [](int t) { return t; },
        [&](int t, int r) { return mix + (size_t)((t / ntn) * 128 + r) * D; },
        [&](int t, int r) { return WT + (size_t)((t % ntn) * 128 + r) * D; },
        [&](int t, const f32x16 (&acc)[2][2]) {
            const int row0 = (t / ntn) * 128, col0 = (t % ntn) * 128;
            const int bi = mod_index(row0);
            const float* g1 = mod + (size_t)(layer * 17 + bi) * 6144 + 2 * D + col0;
            const int wr = tid >> 7, wc = (tid >> 6) & 1, lane = tid & 63;
            const float g1a = g1[wc * 64 + (lane & 31)], g1b = g1[wc * 64 + 32 + (lane & 31)];
            const float* resb = (layer == 0 ? (row0 < TL ? a.in[I_X] + (size_t)row0 * D : a.in[I_CTX] + (size_t)(row0 - TL) * D) : hws + (size_t)row0 * D) + col0 + wc * 64 + (lane & 31);
            float* outb = hws + (size_t)row0 * D + col0 + wc * 64 + (lane & 31);
            float resc[8], resn[8];
#define OP_RO(b) ((size_t)(wr * 64 + ((b) >> 2) * 32 + 16 * ((b) & 1) + 4 * (lane >> 5)) * D + (((b) >> 1) & 1) * 32)
#pragma unroll
            for (int r = 0; r < 8; ++r) resc[r] = __builtin_nontemporal_load(resb + OP_RO(0) + (size_t)((r & 3) + 8 * (r >> 2)) * D);
#pragma unroll
            for (int b = 0; b < 8; ++b) {
                const int mi = b >> 2, ni = (b >> 1) & 1, hq = b & 1;
                if (b + 1 < 8) {
#pragma unroll
                    for (int r = 0; r < 8; ++r) resn[r] = __builtin_nontemporal_load(resb + OP_RO(b + 1) + (size_t)((r & 3) + 8 * (r >> 2)) * D);
                }
                asm volatile("" ::: "memory");
#pragma unroll
                for (int r = 0; r < 8; ++r) outb[OP_RO(b) + (size_t)((r & 3) + 8 * (r >> 2)) * D] = resc[r] + (ni ? g1b : g1a) * acc[mi][ni][8 * hq + r];
                asm volatile("" ::: "memory");
#pragma unroll
                for (int r = 0; r < 8; ++r) resc[r] = resn[r];
            }
#undef OP_RO
        });
}

DEV bf16x8 tr_frag_at(unsigned base, int RS, int c, int ks, int lane);
DEV void unpack8(const u32x4 v, float* f);
DEV void ph_spatial(const KArgs& a, int layer, int nrows, unsigned char* lds) {
    const int tid = get_tid(), lane = tid & 63, wid = tid >> 6, wr = wid >> 1, wc = wid & 1, fr = lane & 31, fh = lane >> 5;
    const bf16_t* z = (const bf16_t*)(a.ws + WS_Z);
    bf16_t* mix = (bf16_t*)(a.ws + WS_MIX);
    unsigned char* vs = lds;
    const unsigned vs_a = (unsigned)(size_t)vs;
    const int nitems = (nrows / 128) * 4;
    for (int item = vblock(); item < nitems; item += gridDim.x) {
        const int ci = item >> 2, g = item & 3, row0 = ci * 128;
        const int l8 = tid & 7, tk = tid >> 3;
        float lgv[16], lbv[16];
#pragma unroll
        for (int j = 0; j < 4; ++j) {
            const f32x4 g4 = *(const f32x4*)(a.in[I_LNG] + layer * 512 + g * 128 + l8 * 16 + 4 * j), b4 = *(const f32x4*)(a.in[I_LNB] + layer * 512 + g * 128 + l8 * 16 + 4 * j);
            lgv[4 * j] = g4.x; lgv[4 * j + 1] = g4.y; lgv[4 * j + 2] = g4.z; lgv[4 * j + 3] = g4.w; lbv[4 * j] = b4.x; lbv[4 * j + 1] = b4.y; lbv[4 * j + 2] = b4.z; lbv[4 * j + 3] = b4.w;
        }
#pragma unroll 2
        for (int pass = 0; pass < 4; ++pass) {
            const int tok = pass * 32 + tk;
            const bf16_t* zp = z + (size_t)(row0 + tok) * DIN + OFF_AV + g * 128 + l8 * 16;
            float x[16];
            unpack8(*(const u32x4*)zp, x); unpack8(*(const u32x4*)(zp + 8), x + 8);
            float sm = 0.f;
#pragma unroll
            for (int j = 0; j < 16; ++j) { x[j] = gelu_f(x[j]); sm += x[j]; }
            sm += __shfl_xor(sm, 1); sm += __shfl_xor(sm, 2); sm += __shfl_xor(sm, 4);
            const float mu = sm * (1.f / 128.f);
            float q = 0.f;
#pragma unroll
            for (int j = 0; j < 16; ++j) { x[j] -= mu; q += x[j] * x[j]; }
            q += __shfl_xor(q, 1); q += __shfl_xor(q, 2); q += __shfl_xor(q, 4);
            const float rs = rsqrtf(q * (1.f / 128.f) + EPS);
            u32x4 w0, w1;
            w0.x = pk2(x[0] * rs * lgv[0] + lbv[0], x[1] * rs * lgv[1] + lbv[1]); w0.y = pk2(x[2] * rs * lgv[2] + lbv[2], x[3] * rs * lgv[3] + lbv[3]);
            w0.z = pk2(x[4] * rs * lgv[4] + lbv[4], x[5] * rs * lgv[5] + lbv[5]); w0.w = pk2(x[6] * rs * lgv[6] + lbv[6], x[7] * rs * lgv[7] + lbv[7]);
            w1.x = pk2(x[8] * rs * lgv[8] + lbv[8], x[9] * rs * lgv[9] + lbv[9]); w1.y = pk2(x[10] * rs * lgv[10] + lbv[10], x[11] * rs * lgv[11] + lbv[11]);
            w1.z = pk2(x[12] * rs * lgv[12] + lbv[12], x[13] * rs * lgv[13] + lbv[13]); w1.w = pk2(x[14] * rs * lgv[14] + lbv[14], x[15] * rs * lgv[15] + lbv[15]);
            *(u32x4*)(vs + tok * 320 + l8 * 32) = w0; *(u32x4*)(vs + tok * 320 + l8 * 32 + 16) = w1;
        }
        __syncthreads();
        const bf16_t* wsp = (const bf16_t*)(a.ws + WS_WSP) + (size_t)(layer * 4 + g) * 128 * 128;
        f32x16 acc[2][2];
#pragma unroll
        for (int mi = 0; mi < 2; ++mi)
#pragma unroll
            for (int ni = 0; ni < 2; ++ni)
#pragma unroll
                for (int r = 0; r < 16; ++r) acc[mi][ni][r] = 0.f;
#pragma unroll 2
        for (int ks = 0; ks < 8; ++ks) {
            bf16x8 af[2], bfr[2];
#pragma unroll
            for (int mi = 0; mi < 2; ++mi) af[mi] = *(const bf16x8*)(wsp + (wr * 64 + mi * 32 + fr) * 128 + ks * 16 + fh * 8);
#pragma unroll
            for (int ni = 0; ni < 2; ++ni) bfr[ni] = tr_frag_at(vs_a, 320, wc * 2 + ni, ks, lane);
#pragma unroll
            for (int mi = 0; mi < 2; ++mi)
#pragma unroll
                for (int ni = 0; ni < 2; ++ni) acc[mi][ni] = __builtin_amdgcn_mfma_f32_32x32x16_bf16(af[mi], bfr[ni], acc[mi][ni], 0, 0, 0);
        }
        __syncthreads();
        ACC_FOREACH(mi, ni, r, row, col) { *(bf16_t*)(vs + row * 272 + col * 2) = f2bf(acc[mi][ni][r]); }
        __syncthreads();
        {
            const int p = tid >> 1, c0 = (tid & 1) * 64;
            const float bs = a.in[I_BSP][(layer * 4 + g) * 128 + p];
            const bf16_t* zu = z + (size_t)(row0 + p) * DIN + OFF_AU + g * 128 + c0;
            bf16_t* mo = mix + (size_t)(row0 + p) * D + g * 128 + c0;
            u32x4 zuv[8];
#pragma unroll
            for (int j = 0; j < 8; ++j) zuv[j] = *(const u32x4*)(zu + 8 * j);
#pragma unroll 2
            for (int j = 0; j < 8; ++j) {
                float uf[8], sf[8];
                unpack8(zuv[j], uf); unpack8(*(const u32x4*)(vs + p * 272 + (c0 + 8 * j) * 2), sf);
                u32x4 w;
                w.x = pk2(gelu_f(uf[0]) * (sf[0] + bs), gelu_f(uf[1]) * (sf[1] + bs)); w.y = pk2(gelu_f(uf[2]) * (sf[2] + bs), gelu_f(uf[3]) * (sf[3] + bs));
                w.z = pk2(gelu_f(uf[4]) * (sf[4] + bs), gelu_f(uf[5]) * (sf[5] + bs)); w.w = pk2(gelu_f(uf[6]) * (sf[6] + bs), gelu_f(uf[7]) * (sf[7] + bs));
                *(u32x4*)(mo + 8 * j) = w;
            }
        }
        __syncthreads();
    }
}

constexpr int GLA_LA_STRIDE = 65, GLA_VT_RS = 320, GLA_KD_RS = 192, GLA_QK_RS = 144;
constexpr int GLA_OFF_LA = 0, GLA_OFF_QE = 16896, GLA_OFF_KE = 16896 + 9216, GLA_OFF_VT = 16896 + 2 * 9216, GLA_OFF_WU = GLA_OFF_VT + 64 * GLA_VT_RS, GLA_OFF_TOT = GLA_OFF_WU + 2 * 4352, GLA_OFF_END = GLA_OFF_TOT + 1280;
static_assert(64 * GLA_LA_STRIDE * 4 <= GLA_OFF_QE && GLA_OFF_END <= 65536 + 768 && 64 * 132 * 4 <= GLA_OFF_VT && 64 * GLA_KD_RS <= 2 * 9216, "GLA LDS map");
DEV void gla_chunk_coords(int ci, int& row0, int& b, int& slot) {
    if (ci < 512) { row0 = ci * 64; b = ci >> 5; slot = 4 + (ci & 31); } else { const int c = ci - 512; row0 = TL + c * 64; b = c >> 2; slot = c & 3; }
}
DEV bf16x8 tr_frag(unsigned a0, unsigned a1) {
    u32x2 lo, hi;
    asm volatile("ds_read_b64_tr_b16 %0, %2\n\tds_read_b64_tr_b16 %1, %3\n\ts_waitcnt lgkmcnt(0)" : "=&v"(lo), "=&v"(hi) : "v"(a0), "v"(a1) : "memory");
    u32x4 w; w.x = lo.x; w.y = lo.y; w.z = hi.x; w.w = hi.y;
    return __builtin_bit_cast(bf16x8, w);
}
DEV bf16x8 tr_frag_at(unsigned base, int RS, int c, int ks, int lane) {
    const int h = lane >> 5, blk = (lane >> 4) & 1, q = (lane & 15) >> 2, p = lane & 3;
    const unsigned a0 = base + (unsigned)((16 * ks + 8 * h + q) * RS + (32 * c + 16 * blk + 4 * p) * 2);
    return tr_frag(a0, a0 + 4u * (unsigned)RS);
}
DEV void unpack8(const u32x4 v, float* f) {
    f[0] = __uint_as_float(v.x << 16); f[1] = __uint_as_float(v.x & 0xffff0000u); f[2] = __uint_as_float(v.y << 16); f[3] = __uint_as_float(v.y & 0xffff0000u);
    f[4] = __uint_as_float(v.z << 16); f[5] = __uint_as_float(v.z & 0xffff0000u); f[6] = __uint_as_float(v.w << 16); f[7] = __uint_as_float(v.w & 0xffff0000u);
}
DEV void gla_stage_gate(const KArgs& a, int layer, int dir, int h, float* swu, int tid) {
    bf16_t* hi = (bf16_t*)swu; bf16_t* lo = hi + 1024; float* bias = swu + 1024;
    for (int i = tid; i < 16 * 64; i += 256) {
        const int k = i >> 6, d = i & 63;
        const float w = a.in[I_WGU][((size_t)(layer * 2 + dir) * 16 + k) * 256 + h * 64 + d];
        const bf16_t wh = f2bf(w);
        hi[d * 16 + k] = wh; lo[d * 16 + k] = f2bf(w - bf2f(wh));
    }
    if (tid < 64) bias[tid] = a.in[I_BG][(layer * 2 + dir) * 256 + h * 64 + tid];
}
DEV void gla_logdecay(const bf16x8 zfrag, const float* swu, float* la, int tid) {
    const int lane = tid & 63, wid = tid >> 6, fr = lane & 31, fh = lane >> 5, dt = (wid & 1) * 32, tt = (wid >> 1) * 32;
    const bf16_t* hi = (const bf16_t*)swu; const bf16_t* lo = hi + 1024; const float* bias = swu + 1024;
    const bf16x8 bh = *(const bf16x8*)(hi + (dt + fr) * 16 + fh * 8), bl = *(const bf16x8*)(lo + (dt + fr) * 16 + fh * 8);
    f32x16 acc;
#pragma unroll
    for (int r = 0; r < 16; ++r) acc[r] = 0.f;
    acc = __builtin_amdgcn_mfma_f32_32x32x16_bf16(zfrag, bl, acc, 0, 0, 0);
    acc = __builtin_amdgcn_mfma_f32_32x32x16_bf16(zfrag, bh, acc, 0, 0, 0);
    const float bb = bias[dt + fr];
#pragma unroll
    for (int r = 0; r < 16; ++r) la[(tt + (r & 3) + 8 * (r >> 2) + 4 * fh) * GLA_LA_STRIDE + dt + fr] = logsigmoid_f(acc[r] + bb) * (1.f / 16.f);
}
DEV void gla_cumsum(float* la, float* tot, int dir, int tid) {
    const int d = tid & 63, sg = tid >> 6;
    float v[16];
#pragma unroll
    for (int t = 0; t < 16; ++t) v[t] = la[(sg * 16 + t) * GLA_LA_STRIDE + d];
    if (dir == 0) {
#pragma unroll
        for (int t = 1; t < 16; ++t) v[t] += v[t - 1];
        tot[sg * 64 + d] = v[15];
    } else {
#pragma unroll
        for (int t = 14; t >= 0; --t) v[t] += v[t + 1];
        tot[sg * 64 + d] = v[0];
    }
    __syncthreads();
    const float t0 = tot[d], t1 = tot[64 + d], t2 = tot[128 + d], t3 = tot[192 + d];
    float off;
    if (dir == 0) off = (sg > 0 ? t0 : 0.f) + (sg > 1 ? t1 : 0.f) + (sg > 2 ? t2 : 0.f);
    else off = (sg < 3 ? t3 : 0.f) + (sg < 2 ? t2 : 0.f) + (sg < 1 ? t1 : 0.f);
    if (sg == 0) tot[256 + d] = (t0 + t1) + (t2 + t3);
#pragma unroll
    for (int t = 0; t < 16; ++t) la[(sg * 16 + t) * GLA_LA_STRIDE + d] = v[t] + off;
    __syncthreads();
}
DEV void gla_store_v(const u32x4 (&vr)[4], unsigned char* vt, int tid) {
    const int i = tid >> 2, e0 = (tid & 3) * 32;
#pragma unroll
    for (int j = 0; j < 4; ++j) *(u32x4*)(vt + i * GLA_VT_RS + (e0 + 8 * j) * 2) = vr[j];
}

DEV void ph_gla_kv(const KArgs& a, int layer, unsigned char* lds) {
    const int tid = get_tid(), lane = tid & 63, wid = tid >> 6;
    const bf16_t* z = (const bf16_t*)(a.ws + WS_Z);
    bf16_t* kvo = (bf16_t*)(a.ws + WS_KV);
    float* dco = (float*)(a.ws + WS_DECAY);
    float* la = (float*)(lds + GLA_OFF_LA); unsigned char* kdt = lds + GLA_OFF_QE; unsigned char* vt = lds + GLA_OFF_VT;
    float* swu = (float*)(lds + GLA_OFF_WU); float* tot = (float*)(lds + GLA_OFF_TOT);
    const unsigned vt_a = (unsigned)(size_t)vt, kd_a = (unsigned)(size_t)kdt;
    const int vb = vblock(), h = vb & 3;
    gla_stage_gate(a, layer, 0, h, swu, tid); gla_stage_gate(a, layer, 1, h, swu + 1088, tid);
    __syncthreads();
    const int i = tid >> 2, d0 = (tid & 3) * 16, e0 = (tid & 3) * 32;
    for (int item = vb; item < 576 * 4; item += gridDim.x) {
        const int ci = item >> 2;
        int row0, b, slot; gla_chunk_coords(ci, row0, b, slot);
        const bf16_t* zr = z + (size_t)(row0 + i) * DIN;
        const bf16_t* zgp = z + (size_t)(row0 + (wid >> 1) * 32 + (lane & 31)) * DIN + OFF_BG + (lane >> 5) * 8;
        const bf16x8 zf0 = *(const bf16x8*)zgp, zf1 = *(const bf16x8*)(zgp + 16);
        const u32x4 kr0 = *(const u32x4*)(zr + OFF_BK + h * 64 + d0), kr1 = *(const u32x4*)(zr + OFF_BK + h * 64 + d0 + 8);
        u32x4 vr[4];
#pragma unroll
        for (int j = 0; j < 4; ++j) vr[j] = *(const u32x4*)(zr + OFF_BV + h * 128 + e0 + 8 * j);
        gla_store_v(vr, vt, tid);
#pragma unroll 1
        for (int dir = 0; dir < 2; ++dir) {
            gla_logdecay(dir ? zf1 : zf0, swu + dir * 1088, la, tid);
            __syncthreads();
            gla_cumsum(la, tot, dir, tid);
            const size_t tile = (size_t)(((dir * NB + b) * 4 + h) * 36 + slot);
            {
                float kf[16];
                unpack8(kr0, kf); unpack8(kr1, kf + 8);
#pragma unroll
                for (int dd = 0; dd < 16; ++dd) kf[dd] *= __expf(tot[256 + d0 + dd] - la[i * GLA_LA_STRIDE + d0 + dd]);
                u32x4 w0, w1;
                w0.x = pk2(kf[0], kf[1]); w0.y = pk2(kf[2], kf[3]); w0.z = pk2(kf[4], kf[5]); w0.w = pk2(kf[6], kf[7]);
                w1.x = pk2(kf[8], kf[9]); w1.y = pk2(kf[10], kf[11]); w1.z = pk2(kf[12], kf[13]); w1.w = pk2(kf[14], kf[15]);
                *(u32x4*)(kdt + i * GLA_KD_RS + d0 * 2) = w0; *(u32x4*)(kdt + i * GLA_KD_RS + d0 * 2 + 16) = w1;
                if (tid < 64) dco[tile * 64 + tid] = __expf(tot[256 + tid]);
            }
            __syncthreads();
            f32x16 acc[2];
#pragma unroll
            for (int nt = 0; nt < 2; ++nt)
#pragma unroll
                for (int r = 0; r < 16; ++r) acc[nt][r] = 0.f;
#pragma unroll
            for (int ks = 0; ks < 4; ++ks) {
                const bf16x8 af = tr_frag_at(vt_a, GLA_VT_RS, wid, ks, lane);
#pragma unroll
                for (int nt = 0; nt < 2; ++nt) { const bf16x8 bfr = tr_frag_at(kd_a, GLA_KD_RS, nt, ks, lane); acc[nt] = __builtin_amdgcn_mfma_f32_32x32x16_bf16(af, bfr, acc[nt], 0, 0, 0); }
            }
            bf16_t* out = kvo + tile * 8192;
#pragma unroll
            for (int nt = 0; nt < 2; ++nt)
#pragma unroll
                for (int r = 0; r < 16; ++r) { const int e = wid * 32 + (r & 3) + 8 * (r >> 2) + 4 * (lane >> 5); out[e * 64 + nt * 32 + (lane & 31)] = f2bf(acc[nt][r]); }
            __syncthreads();
        }
    }
}

DEV void ph_gla_scan(const KArgs& a) {
    const int tid = get_tid();
    const bf16_t* kv = (const bf16_t*)(a.ws + WS_KV);
    const float* dc = (const float*)(a.ws + WS_DECAY);
    bf16_t* sp = (bf16_t*)(a.ws + WS_HN);
    for (int item = blockIdx.x; item < 2 * NB * 4 * 8; item += gridDim.x) {
        const int dbh = item >> 3, sub = item & 7, dir = dbh >> 6;
        const int e = sub * 16 + (tid >> 4), dq = (tid & 15) * 4;
        f32x4 S = {0.f, 0.f, 0.f, 0.f};
#pragma unroll 1
        for (int s0 = 0; s0 < 36; s0 += 12) {
            u32x2 kvr[12]; f32x4 dcv[12];
#pragma unroll
            for (int q = 0; q < 12; ++q) {
                const int step = s0 + q, slot = dir == 0 ? step : (step < 4 ? 3 - step : 39 - step);
                const size_t tile = (size_t)dbh * 36 + slot;
                kvr[q] = __builtin_nontemporal_load((const u32x2*)(kv + tile * 8192 + e * 64 + dq)); dcv[q] = *(const f32x4*)(dc + tile * 64 + dq);
            }
#pragma unroll
            for (int q = 0; q < 12; ++q) {
                const int step = s0 + q, slot = dir == 0 ? step : (step < 4 ? 3 - step : 39 - step);
                const size_t tile = (size_t)dbh * 36 + slot;
                const f32x4 kvv = {__uint_as_float(kvr[q].x << 16), __uint_as_float(kvr[q].x & 0xffff0000u), __uint_as_float(kvr[q].y << 16), __uint_as_float(kvr[q].y & 0xffff0000u)};
                u32x2 w; w.x = pk2(S.x, S.y); w.y = pk2(S.z, S.w);
                *(u32x2*)(sp + tile * 8192 + e * 64 + dq) = w;
                S = dcv[q] * S + kvv;
            }
        }
    }
}

DEV void ph_gla_out(const KArgs& a, int layer, unsigned char* lds) {
    const int tid = get_tid(), lane = tid & 63, wid = tid >> 6, ih = wid >> 1, eh = wid & 1, fr = lane & 31, fh = lane >> 5;
    const bf16_t* z = (const bf16_t*)(a.ws + WS_Z);
    const bf16_t* sp = (const bf16_t*)(a.ws + WS_HN);
    bf16_t* mix = (bf16_t*)(a.ws + WS_MIX);
    float* la = (float*)(lds + GLA_OFF_LA); unsigned char* att = lds + GLA_OFF_LA; unsigned char* qet = lds + GLA_OFF_QE; unsigned char* ket = lds + GLA_OFF_KE; unsigned char* vt = lds + GLA_OFF_VT;
    float* swu = (float*)(lds + GLA_OFF_WU); float* tot = (float*)(lds + GLA_OFF_TOT); float* ob = (float*)lds;
    const unsigned vt_a = (unsigned)(size_t)vt;
    const int nchunks = layer == 0 ? 576 : 512;
    const int vb = vblock(), h = vb & 3;
    gla_stage_gate(a, layer, 0, h, swu, tid); gla_stage_gate(a, layer, 1, h, swu + 1088, tid);
    __syncthreads();
    const int i = tid >> 2, d0 = (tid & 3) * 16, e0 = (tid & 3) * 32;
    for (int item = vb; item < nchunks * 4; item += gridDim.x) {
        const int ci = item >> 2;
        int row0, b, slot; gla_chunk_coords(ci, row0, b, slot);
        const bf16_t* zr = z + (size_t)(row0 + i) * DIN;
        const bf16_t* zgp = z + (size_t)(row0 + (wid >> 1) * 32 + (lane & 31)) * DIN + OFF_BG + (lane >> 5) * 8;
        const bf16x8 zf0 = *(const bf16x8*)zgp, zf1 = *(const bf16x8*)(zgp + 16);
        const u32x4 qr0 = *(const u32x4*)(zr + OFF_BQ + h * 64 + d0), qr1 = *(const u32x4*)(zr + OFF_BQ + h * 64 + d0 + 8);
        const u32x4 kr0 = *(const u32x4*)(zr + OFF_BK + h * 64 + d0), kr1 = *(const u32x4*)(zr + OFF_BK + h * 64 + d0 + 8);
        u32x4 vr[4], rr4[4];
#pragma unroll
        for (int j = 0; j < 4; ++j) vr[j] = *(const u32x4*)(zr + OFF_BV + h * 128 + e0 + 8 * j);
#pragma unroll
        for (int j = 0; j < 4; ++j) rr4[j] = *(const u32x4*)(zr + OFF_BR + h * 128 + e0 + 8 * j);
        gla_store_v(vr, vt, tid);
        f32x16 acc[2];
#pragma unroll
        for (int nt = 0; nt < 2; ++nt)
#pragma unroll
            for (int r = 0; r < 16; ++r) acc[nt][r] = 0.f;
#pragma unroll 1
        for (int dir = 0; dir < 2; ++dir) {
            gla_logdecay(dir ? zf1 : zf0, swu + dir * 1088, la, tid);
            __syncthreads();
            gla_cumsum(la, tot, dir, tid);
            {
                float qf[16], kf[16];
                unpack8(qr0, qf); unpack8(qr1, qf + 8); unpack8(kr0, kf); unpack8(kr1, kf + 8);
#pragma unroll
                for (int dd = 0; dd < 16; ++dd) { const float bb = la[i * GLA_LA_STRIDE + d0 + dd]; qf[dd] *= 0.125f * __expf(bb); kf[dd] *= __expf(-bb); }
                u32x4 w0, w1;
                w0.x = pk2(qf[0], qf[1]); w0.y = pk2(qf[2], qf[3]); w0.z = pk2(qf[4], qf[5]); w0.w = pk2(qf[6], qf[7]);
                w1.x = pk2(qf[8], qf[9]); w1.y = pk2(qf[10], qf[11]); w1.z = pk2(qf[12], qf[13]); w1.w = pk2(qf[14], qf[15]);
                *(u32x4*)(qet + i * GLA_QK_RS + d0 * 2) = w0; *(u32x4*)(qet + i * GLA_QK_RS + d0 * 2 + 16) = w1;
                w0.x = pk2(kf[0], kf[1]); w0.y = pk2(kf[2], kf[3]); w0.z = pk2(kf[4], kf[5]); w0.w = pk2(kf[6], kf[7]);
                w1.x = pk2(kf[8], kf[9]); w1.y = pk2(kf[10], kf[11]); w1.z = pk2(kf[12], kf[13]); w1.w = pk2(kf[14], kf[15]);
                *(u32x4*)(ket + i * GLA_QK_RS + d0 * 2) = w0; *(u32x4*)(ket + i * GLA_QK_RS + d0 * 2 + 16) = w1;
            }
            const bf16_t* st = sp + (size_t)(((dir * NB + b) * 4 + h) * 36 + slot) * 8192;
            bf16x8 bs[4][2];
#pragma unroll
            for (int ks = 0; ks < 4; ++ks)
#pragma unroll
                for (int nt = 0; nt < 2; ++nt) bs[ks][nt] = *(const bf16x8*)(st + (eh * 64 + nt * 32 + fr) * 64 + ks * 16 + fh * 8);
            __syncthreads();
            bf16x8 aq[4];
#pragma unroll
            for (int ks = 0; ks < 4; ++ks) aq[ks] = *(const bf16x8*)(qet + (ih * 32 + fr) * GLA_QK_RS + (ks * 16 + fh * 8) * 2);
            {
                f32x16 sa;
#pragma unroll
                for (int r = 0; r < 16; ++r) sa[r] = 0.f;
#pragma unroll
                for (int ks = 0; ks < 4; ++ks) { const bf16x8 bk = *(const bf16x8*)(ket + (eh * 32 + fr) * GLA_QK_RS + (ks * 16 + fh * 8) * 2); sa = __builtin_amdgcn_mfma_f32_32x32x16_bf16(aq[ks], bk, sa, 0, 0, 0); }
                const int j = eh * 32 + fr;
#pragma unroll
                for (int r = 0; r < 16; ++r) {
                    const int ii = ih * 32 + (r & 3) + 8 * (r >> 2) + 4 * fh;
                    const bool keep = dir == 0 ? (j <= ii) : (j >= ii);
                    *(bf16_t*)(att + ii * GLA_QK_RS + j * 2) = f2bf(keep ? sa[r] : 0.f);
                }
            }
            __syncthreads();
#pragma unroll
            for (int ks = 0; ks < 4; ++ks) {
                const bf16x8 aa = *(const bf16x8*)(att + (ih * 32 + fr) * GLA_QK_RS + (ks * 16 + fh * 8) * 2);
#pragma unroll
                for (int nt = 0; nt < 2; ++nt) {
                    const bf16x8 bv = tr_frag_at(vt_a, GLA_VT_RS, eh * 2 + nt, ks, lane);
                    acc[nt] = __builtin_amdgcn_mfma_f32_32x32x16_bf16(aa, bv, acc[nt], 0, 0, 0);
                    acc[nt] = __builtin_amdgcn_mfma_f32_32x32x16_bf16(aq[ks], bs[ks][nt], acc[nt], 0, 0, 0);
                }
            }
            __syncthreads();
        }
#pragma unroll
        for (int nt = 0; nt < 2; ++nt)
#pragma unroll
            for (int r = 0; r < 16; ++r) ob[(ih * 32 + (r & 3) + 8 * (r >> 2) + 4 * fh) * 132 + eh * 64 + nt * 32 + fr] = acc[nt][r];
        __syncthreads();
        {
            float o[32]; float ss = 0.f;
#pragma unroll
            for (int j = 0; j < 8; ++j) { const f32x4 v = *(const f32x4*)(ob + i * 132 + e0 + 4 * j); o[4 * j] = v.x; o[4 * j + 1] = v.y; o[4 * j + 2] = v.z; o[4 * j + 3] = v.w; ss += v.x * v.x + v.y * v.y + v.z * v.z + v.w * v.w; }
            ss += __shfl_xor(ss, 1); ss += __shfl_xor(ss, 2);
            const float rstd = rsqrtf(ss * (1.f / 128.f) + EPS);
            const float* gg = a.in[I_GGLA] + layer * 512 + h * 128 + e0;
            bf16_t* mo = mix + (size_t)(row0 + i) * D + 512 + h * 128 + e0;
#pragma unroll
            for (int j = 0; j < 4; ++j) {
                float rf[8]; unpack8(rr4[j], rf);
                const f32x4 g0 = *(const f32x4*)(gg + 8 * j), g1 = *(const f32x4*)(gg + 8 * j + 4);
                u32x4 w;
                w.x = pk2(o[8 * j + 0] * rstd * g0.x * silu_f(rf[0]), o[8 * j + 1] * rstd * g0.y * silu_f(rf[1]));
                w.y = pk2(o[8 * j + 2] * rstd * g0.z * silu_f(rf[2]), o[8 * j + 3] * rstd * g0.w * silu_f(rf[3]));
                w.z = pk2(o[8 * j + 4] * rstd * g1.x * silu_f(rf[4]), o[8 * j + 5] * rstd * g1.y * silu_f(rf[5]));
                w.w = pk2(o[8 * j + 6] * rstd * g1.z * silu_f(rf[6]), o[8 * j + 7] * rstd * g1.w * silu_f(rf[7]));
                *(u32x4*)(mo + 8 * j) = w;
            }
        }
        __syncthreads();
    }
}

DEV void ph_router(const KArgs& a, int layer, int nrows, unsigned char* lds) {
    const int tid = get_tid();
    const bf16_t* hn = (const bf16_t*)(a.ws + WS_HN);
    const bf16_t* WT = (const bf16_t*)(a.ws + WS_WRT) + (size_t)layer * 128 * D;
    unsigned* cnt = (unsigned*)(a.ws + WS_CTL) + layer * NE;
    u32x2* list = (u32x2*)(a.ws + WS_LIST);
    float* lgs = (float*)lds;
    int* s_cnt = (int*)(lds + 49152);
    for (int t = vblock(); t < nrows / 128; t += gridDim.x) {
        const int row0 = t * 128;
        f32x16 acc[2][2];
        gemm_core(lds, D / 64, [&](int r) { return hn + (size_t)(row0 + r) * D; }, [&](int r) { return WT + (size_t)r * D; }, acc);
        ACC_FOREACH(mi, ni, r, row, col) { if (col < 72) lgs[row * 73 + col] = acc[mi][ni][r]; }
        if (tid < 64) s_cnt[tid] = 0;
        __syncthreads();
        int ex1 = 0, ex2 = 0, lp1 = 0, lp2 = 0; float gt1 = 0.f, gt2 = 0.f;
        if (tid < 128) {
            const float* lr = lgs + tid * 73;
            float lg[8];
#pragma unroll
            for (int j = 0; j < 8; ++j) lg[j] = lr[j] + a.in[I_BRG][layer * 8 + j];
            float m = lg[0]; int gi = 0;
#pragma unroll
            for (int j = 1; j < 8; ++j) if (lg[j] > m) { m = lg[j]; gi = j; }
            float sum = 0.f;
#pragma unroll
            for (int j = 0; j < 8; ++j) sum += __expf(lg[j] - m);
            const float ptop = 1.f / sum;
            float le[8];
#pragma unroll
            for (int j = 0; j < 8; ++j) le[j] = lr[8 + gi * 8 + j] + a.in[I_BRE][layer * 64 + gi * 8 + j];
            float l1 = le[0]; int i1 = 0;
#pragma unroll
            for (int j = 1; j < 8; ++j) if (le[j] > l1) { l1 = le[j]; i1 = j; }
            float l2 = -3.0e38f; int i2 = 0;
#pragma unroll
            for (int j = 0; j < 8; ++j) if (j != i1 && le[j] > l2) { l2 = le[j]; i2 = j; }
            const float e2 = __expf(l2 - l1), w1 = 1.f / (1.f + e2), w2 = e2 / (1.f + e2);
            ex1 = gi * 8 + i1; ex2 = gi * 8 + i2; gt1 = ptop * w1; gt2 = ptop * w2;
            lp1 = atomicAdd(&s_cnt[ex1], 1); lp2 = atomicAdd(&s_cnt[ex2], 1);
        }
        __syncthreads();
        if (tid < 64) { const int c = s_cnt[tid]; s_cnt[64 + tid] = c ? (int)atomicAdd(cnt + tid, (unsigned)c) : 0; }
        __syncthreads();
        if (tid < 128) {
            const int r = row0 + tid;
            const unsigned p1 = (unsigned)(s_cnt[64 + ex1] + lp1), p2 = (unsigned)(s_cnt[64 + ex2] + lp2);
            u32x2 e1v, e2v; e1v.x = (unsigned)(2 * r); e1v.y = __float_as_uint(gt1); e2v.x = (unsigned)(2 * r + 1); e2v.y = __float_as_uint(gt2);
            list[(size_t)ex1 * LCAP + p1] = e1v; list[(size_t)ex2 * LCAP + p2] = e2v;
        }
        __syncthreads();
    }
}

DEV void ph_moe(const KArgs& a, int layer, int sub, unsigned char* lds) {
    const int tid = get_tid();
    const unsigned* cnt = (const unsigned*)(a.ws + WS_CTL) + layer * NE;
    const u32x2* list = (const u32x2*)(a.ws + WS_LIST);
    bf16_t* ys = (bf16_t*)(a.ws + WS_KV);
    int (*s_off)[80] = (int (*)[80])(lds + 65536);
    constexpr int ntn = 8;
    if (tid < NE) s_off[0][tid] = (int)cnt[tid];
    __syncthreads();
    if (tid == 0) { int o = 0, t = 0; for (int e = 0; e < NE; ++e) { const int c = s_off[0][e]; s_off[0][e] = o; s_off[1][e] = t; o += c; t += ((c + 127) / 128) * ntn; } s_off[0][NE] = o; s_off[1][NE] = t; }
    __syncthreads();
    const int ntiles = s_off[1][NE];
    struct Cx { int e, p0, nt, c, ro; };
    auto prep = [&](int t) { Cx x; int e = 0;
#pragma unroll
        for (int st = 32; st >= 1; st >>= 1) if (s_off[1][e + st] <= t) e += st;
        const int local = t - s_off[1][e]; x.e = e; x.p0 = (local / ntn) * 128; x.nt = local % ntn; x.ro = s_off[0][e]; x.c = s_off[0][e + 1] - x.ro;
        return x; };
    const int wr = tid >> 7, wc = (tid >> 6) & 1, lane = tid & 63;
    const unsigned char* hn8 = a.ws + WS_HN8;
    unsigned char* H8 = a.ws + WS_Z;
    if (sub == 0) {
        gemm_stream_x<true>(lds, D / 128, vblock(), gridDim.x, ntiles, prep,
            [&](const Cx& x, int r) { const int n = x.nt * 64 + (r >> 6) * 32 + (r & 31);
                                return (const bf16_t*)(a.ws + ((r >> 5) & 1 ? WS_W3T : WS_W1T) + ((size_t)x.e * DE + n) * D); },
            [&](const Cx& x, int r) { const int p = x.p0 + r; return list[(size_t)x.e * LCAP + (p < x.c ? p : 0)].x; },
            [&](const Cx& x, int r, unsigned slot) { return (const bf16_t*)(hn8 + (size_t)(slot >> 1) * D); },
            [](const Cx&) { return 0; },
            [&](const Cx& x, const f32x16 (&acc)[2][2], int) {
                const int p0 = x.p0, nt = x.nt, c = x.c, ro = x.ro;
#pragma unroll
                for (int ni = 0; ni < 2; ++ni) {
                    const int p = p0 + wc * 64 + ni * 32 + (lane & 31);
                    unsigned char* hr = H8 + (size_t)(ro + (p < c ? p : 0)) * DE + nt * 64 + wr * 32 + 8 * (lane >> 5);
#pragma unroll
                    for (int kp = 0; kp < 2; ++kp) {
                        float hv[8];
#pragma unroll
                        for (int q = 0; q < 8; ++q) hv[q] = silu_f(acc[0][ni][8 * kp + q] * W8_INV) * (acc[1][ni][8 * kp + q] * W8_INV);
                        const unsigned wa = pk4_fp8(hv[0], hv[1], hv[2], hv[3]), wb = pk4_fp8(hv[4], hv[5], hv[6], hv[7]);
                        auto rsw = __builtin_amdgcn_permlane32_swap(wa, wb, false, false);
                        u32x2 w; w.x = rsw[0]; w.y = rsw[1];
                        if (p < c) *(u32x2*)(hr + 16 * kp) = w;
                    }
                }
            });
    } else {
        struct Pv { u32x2 e[2]; };
        gemm_stream_x<true>(lds, DE / 128, vblock(), gridDim.x, ntiles, prep,
            [&](const Cx& x, int r) { return (const bf16_t*)(a.ws + WS_W2T + ((size_t)x.e * D + x.nt * 128 + r) * DE); },
            [](const Cx&, int) { return 0u; },
            [&](const Cx& x, int r, unsigned) { const int p = x.p0 + r; return (const bf16_t*)(H8 + (size_t)(x.ro + (p < x.c ? p : 0)) * DE); },
            [&](const Cx& x) { Pv v;
#pragma unroll
                for (int ni = 0; ni < 2; ++ni) { const int p = x.p0 + wc * 64 + ni * 32 + (lane & 31); v.e[ni] = list[(size_t)x.e * LCAP + (p < x.c ? p : 0)]; }
                return v; },
            [&](const Cx& x, const f32x16 (&acc)[2][2], const Pv& pv) {
                const int p0 = x.p0, nt = x.nt, c = x.c;
#pragma unroll
                for (int ni = 0; ni < 2; ++ni) {
                    const int p = p0 + wc * 64 + ni * 32 + (lane & 31);
                    const unsigned slot = pv.e[ni].x; const float gt = __uint_as_float(pv.e[ni].y) * (W8_INV * YS_SCALE);
                    unsigned char* yo = (unsigned char*)ys + (size_t)slot * D + nt * 128 + wr * 64 + 8 * (lane >> 5);
#pragma unroll
                    for (int mi = 0; mi < 2; ++mi)
#pragma unroll
                        for (int kp = 0; kp < 2; ++kp) {
                            const unsigned wa = pk4_fp8(gt * acc[mi][ni][8 * kp], gt * acc[mi][ni][8 * kp + 1], gt * acc[mi][ni][8 * kp + 2], gt * acc[mi][ni][8 * kp + 3]);
                            const unsigned wb = pk4_fp8(gt * acc[mi][ni][8 * kp + 4], gt * acc[mi][ni][8 * kp + 5], gt * acc[mi][ni][8 * kp + 6], gt * acc[mi][ni][8 * kp + 7]);
                            auto rsw = __builtin_amdgcn_permlane32_swap(wa, wb, false, false);
                            u32x2 w; w.x = rsw[0]; w.y = rsw[1];
                            if (p < c) *(u32x2*)(yo + mi * 32 + 16 * kp) = w;
                        }
                }
            });
    }
}

#define XB_TMO      128
#define XB_XCNT(j)  (256  + 64 * (j))
#define XB_XSUB(j)  (1280 + 64 * (j))
#define XB_XGEN(j)  (2304 + 64 * (j))
#define XB_TOP      3328
#define XB_TOPGEN   3392
#define XCD_BAR_WORDS 3456
#define XB_SPIN_CAP (1u << 18)
#define LAS __attribute__((address_space(3)))
DEV unsigned xb_ld(unsigned* p)              { return __hip_atomic_load(p, __ATOMIC_RELAXED, __HIP_MEMORY_SCOPE_AGENT); }
DEV unsigned xb_add(unsigned* p, unsigned v) { return __hip_atomic_fetch_add(p, v, __ATOMIC_RELAXED, __HIP_MEMORY_SCOPE_AGENT); }
DEV unsigned xb_xcc_id() { return (unsigned)__builtin_amdgcn_s_getreg((3 << 11) | 20) & 0xFu; }
#define XB_SPIN(cond, bar) do { unsigned _sp = 0; while (cond) { __builtin_amdgcn_s_sleep(1); \
    if ((++_sp & 255u) == 0u) { if (xb_ld(&(bar)[XB_TMO])) break; if (_sp > XB_SPIN_CAP) { atomicAdd(&(bar)[XB_TMO], 1u); break; } } } } while (0)
struct XcdBarrier { unsigned* bar; unsigned x; volatile LAS unsigned* st; };
DEV XcdBarrier xcd_barrier_post(unsigned* bar, volatile LAS unsigned* st) {
    XcdBarrier b; b.bar = bar; b.x = xb_xcc_id(); b.st = st;
    if (threadIdx.x == 0) (void)xb_add(&bar[XB_XCNT(b.x)], 1u);
    return b;
}
DEV void xcd_barrier_complete(unsigned* bar, unsigned x, unsigned& nloc, unsigned& nx) {
    const unsigned G = gridDim.x * gridDim.y * gridDim.z;
    unsigned sum, cnt, mine, sp = 0u;
    for (;;) {
        sum = 0u; cnt = 0u; mine = 0u;
#pragma unroll
        for (unsigned j = 0; j < 16; ++j) { const unsigned c = xb_ld(&bar[XB_XCNT(j)]); sum += c; cnt += (c > 0u) ? 1u : 0u; mine = (j == x) ? c : mine; }
        if (sum == G) break;
        __builtin_amdgcn_s_sleep(1);
        if ((++sp & 255u) == 0u) { if (xb_ld(&bar[XB_TMO])) break; if (sp > XB_SPIN_CAP) { atomicAdd(&bar[XB_TMO], 1u); break; } }
    }
    nloc = mine > 0u ? mine : 1u; nx = cnt > 0u ? cnt : 1u;
}
DEV void xcd_barrier(const XcdBarrier& b) {
    asm volatile("s_waitcnt vmcnt(0)" ::: "memory");
    __syncthreads();
    if (threadIdx.x == 0) {
        unsigned* bar = b.bar;
        __builtin_amdgcn_s_waitcnt(0);
        unsigned nloc = b.st[0], nx = b.st[1];
        if (nloc == 0u) { xcd_barrier_complete(bar, b.x, nloc, nx); b.st[0] = nloc; b.st[1] = nx; }
        const unsigned old = xb_add(&bar[XB_XSUB(b.x)], 1u);
        const unsigned gen = old / nloc;
        if (old + 1u == (gen + 1u) * nloc) {
            __builtin_amdgcn_fence(__ATOMIC_RELEASE, "agent");
            asm volatile("s_waitcnt vmcnt(0)" ::: "memory");
            const unsigned og = xb_add(&bar[XB_TOP], 1u);
            const unsigned tg = og / nx;
            if (og + 1u == (tg + 1u) * nx) xb_add(&bar[XB_TOPGEN], 1u);
            else XB_SPIN(xb_ld(&bar[XB_TOPGEN]) == tg, bar);
            __builtin_amdgcn_fence(__ATOMIC_ACQUIRE, "agent");
            xb_add(&bar[XB_XGEN(b.x)], 1u);
            asm volatile("s_waitcnt vmcnt(0)" ::: "memory");
        } else {
            XB_SPIN(xb_ld(&bar[XB_XGEN(b.x)]) == gen, bar);
            __builtin_amdgcn_fence(__ATOMIC_ACQUIRE, "agent");
            asm volatile("s_waitcnt vmcnt(0)" ::: "memory");
        }
    }
    __syncthreads();
}

constexpr int NPH_LAYER = 10, NPH = 1 + 2 * NPH_LAYER + 1;
__global__ void __launch_bounds__(256, 2) mega(KArgs a) {
    __shared__ __attribute__((aligned(16))) unsigned char lds[65536 + 1024];
    uint4& xb_words = *(uint4*)(lds + 65536 + 768);
    cg::grid_group grid = cg::this_grid();
    const int lo = a.ph_lo, hi = a.ph_hi;
    if (threadIdx.x == 0) xb_words = make_uint4(0u, 0u, 0u, 0u);
    __syncthreads();
    const XcdBarrier xb = xcd_barrier_post((unsigned*)(a.ws + WS_CTL + 65536), (volatile LAS unsigned*)&xb_words);
    if (threadIdx.x == 0) {
        const unsigned hwid = (unsigned)__builtin_amdgcn_s_getreg((31 << 11) | 4), key = xb.x * 256u + ((hwid >> 8) & 0xffu);
        ((volatile unsigned*)&xb_words)[2] = atomicAdd((unsigned*)(a.ws + WS_CTL + 16384) + key, 1u);
    }
    __syncthreads();
    const int cu_role = __builtin_amdgcn_readfirstlane((int)(((volatile unsigned*)&xb_words)[2] & 1u));
#define GEMM_PRIO_ON()  (cu_role ? __builtin_amdgcn_s_setprio(2) : (void)0)
#define GEMM_PRIO_OFF() __builtin_amdgcn_s_setprio(0)
    if (hi < 0) grid.sync();
#define PHASE(k, call) do { const int k_ = (k); if (lo <= k_ && k_ < hi) { call; if (k_ + 1 < hi) xcd_barrier(xb); } } while (0)
    PHASE(0, (ph_prep(a, lds), convert_shared(a, lds)));
#pragma unroll 1
    for (int l = 0; l < 2; ++l) {
        const int base = 1 + l * NPH_LAYER;
        const int nrows = l == 0 ? TA : TL;
        PHASE(base + 0, ph_norm(a, l, 0, l > 0, l - 1, l == 0, TA));
        PHASE(base + 1, (GEMM_PRIO_ON(), ph_inproj(a, l, lds), GEMM_PRIO_OFF()));
        PHASE(base + 2, (blockIdx.x < (gridDim.x >> 1) ? (convert_experts(a, l, lds), __syncthreads(), ph_spatial(a, l, nrows, lds), ph_gla_kv(a, l, lds))
                                                        : (ph_spatial(a, l, nrows, lds), ph_gla_kv(a, l, lds), __syncthreads(), convert_experts(a, l, lds))));
        PHASE(base + 3, ph_gla_scan(a));
        PHASE(base + 4, ph_gla_out(a, l, lds));
        PHASE(base + 5, (GEMM_PRIO_ON(), ph_outproj(a, l, nrows, lds), GEMM_PRIO_OFF()));
        PHASE(base + 6, ph_norm(a, l, 1, false, 0, false, nrows));
        PHASE(base + 7, ph_router(a, l, nrows, lds));
        PHASE(base + 8, (GEMM_PRIO_ON(), ph_moe(a, l, 0, lds), GEMM_PRIO_OFF()));
        PHASE(base + 9, (GEMM_PRIO_ON(), ph_moe(a, l, 1, lds), GEMM_PRIO_OFF()));
    }
    PHASE(NPH - 1, ph_norm(a, 0, 2, true, 1, false, TL));
#undef PHASE
}

extern "C" void kernel_launch(void* const* d_in, const int* in_sizes, int n_in, void* d_out, int out_size, void* d_ws, size_t ws_size, hipStream_t stream) {
    static int grid = 0;
    if (grid == 0) {
        int dev = 0, cus = 0, per_cu = 0;
        hipGetDevice(&dev);
        hipDeviceGetAttribute(&cus, hipDeviceAttributeMultiprocessorCount, dev);
        hipOccupancyMaxActiveBlocksPerMultiprocessor(&per_cu, (const void*)mega, 256, 0);
        if (per_cu < 1) per_cu = 1;
        if (per_cu > 2) per_cu = 2;
        grid = cus * per_cu;
        if (n_in != 25 || ws_size < WS_END) { fprintf(stderr, "kernel_launch: unexpected n_in %d or ws_size %zu (need %zu)\n", n_in, ws_size, (size_t)WS_END); }
    }
    KArgs a{};
    for (int i = 0; i < 25; ++i) a.in[i] = (const float*)d_in[i];
    a.out = (float*)d_out; a.ws = (unsigned char*)d_ws;
    hipMemsetAsync(d_ws, 0, WS_MOD + 2 * 17 * 6144 * 4, stream);
#if ONE_LAUNCH
    a.ph_lo = 0; a.ph_hi = NPH;
    void* args[] = {&a};
    hipError_t e = hipLaunchCooperativeKernel((const void*)mega, dim3(grid), dim3(256), args, 0, stream);
    if (e != hipSuccess) fprintf(stderr, "cooperative launch failed: %s (grid %d)\n", hipGetErrorString(e), grid);
#else
    for (int ph = 0; ph < NPH; ++ph) {
        a.ph_lo = ph; a.ph_hi = ph + 1;
        hipLaunchKernelGGL(mega, dim3(grid), dim3(256), 0, stream, a);
    }
#endif
}
```
